# Optimizing an MI355X kernel written in HIP

```python
import math
import jax, jax.numpy as jnp
from jax import lax
import numpy as np

D_MODEL = 1024
BATCH = 16
SEQ = 2048
DEPTH = 4

N_MIXERS = 3
PLE_DIM = 256
D_FF = 4 * D_MODEL
EPS = 1e-6
NEG_INF = -1e30
S5_GROUP = 16
S5_GROUPS = D_MODEL // S5_GROUP
S5_STATE = 64
S5_CHUNK = 128
FOX_HEADS = 16
FOX_HEAD_DIM = D_MODEL // FOX_HEADS
FOX_IN = 3 * D_MODEL + FOX_HEADS
Q_BLOCK = 128
GLA_HEADS = 4
GLA_KD = D_MODEL // 2
GLA_VD = D_MODEL
GLA_DK = GLA_KD // GLA_HEADS
GLA_DV = GLA_VD // GLA_HEADS
GLA_RANK = 16
GLA_GATE_NORM = 16.0
GLA_CHUNK = 64
GLA_IN = 2 * GLA_KD + 2 * GLA_VD + GLA_RANK
N_A = (DEPTH + 2) // 3
N_B = (DEPTH + 1) // 3
N_C = DEPTH // 3

kernel_name = "hybrid_s5_fox_gla_trunk"


def rmsnorm(x, g):
    xf = x.astype(jnp.float32)
    y = xf * lax.rsqrt(jnp.mean(xf * xf, axis=-1, keepdims=True) + EPS)
    return (y * g.astype(jnp.float32)).astype(x.dtype)


def _cplx_combine(e1, e2):
    a1r, a1i, b1r, b1i = e1
    a2r, a2i, b2r, b2i = e2
    ar = a2r * a1r - a2i * a1i
    ai = a2r * a1i + a2i * a1r
    br = a2r * b1r - a2i * b1i + b2r
    bi = a2r * b1i + a2i * b1r + b2i
    return ar, ai, br, bi


def s5_mixer(xn, w_in, lam_re, lam_im, log_dt, b_re, b_im, c_re, c_im, d_skip, w_glu, w_out):
    bsz, t, _ = xn.shape
    f32 = jnp.float32
    n_chunks = t // S5_CHUNK
    u = (xn @ w_in).astype(f32)
    dt = jnp.exp(log_dt.astype(f32))[:, None]
    lr, li = lam_re.astype(f32), lam_im.astype(f32)
    mag = jnp.exp(lr * dt)
    ab_re, ab_im = mag * jnp.cos(li * dt), mag * jnp.sin(li * dt)
    den = lr * lr + li * li
    nr = ab_re - 1.0
    coef_re = (nr * lr + ab_im * li) / den
    coef_im = (ab_im * lr - nr * li) / den
    br, bi = b_re.astype(f32), b_im.astype(f32)
    bbar_re = coef_re[..., None] * br - coef_im[..., None] * bi
    bbar_im = coef_re[..., None] * bi + coef_im[..., None] * br
    cr, ci = c_re.astype(f32), c_im.astype(f32)
    shape = (bsz, S5_CHUNK, S5_GROUPS, S5_STATE)
    a_re = jnp.broadcast_to(ab_re, shape)
    a_im = jnp.broadcast_to(ab_im, shape)
    uc = u.reshape(bsz, n_chunks, S5_CHUNK, S5_GROUPS, S5_GROUP).swapaxes(0, 1)

    def chunk_step(carry, u_blk):
        h_re, h_im = carry
        x_re = jnp.einsum('bsgc,gnc->bsgn', u_blk, bbar_re)
        x_im = jnp.einsum('bsgc,gnc->bsgn', u_blk, bbar_im)
        pa_re, pa_im, s_re, s_im = lax.associative_scan(
            _cplx_combine, (a_re, a_im, x_re, x_im), axis=1)
        s_re = s_re + pa_re * h_re[:, None] - pa_im * h_im[:, None]
        s_im = s_im + pa_re * h_im[:, None] + pa_im * h_re[:, None]
        y = jnp.einsum('bsgn,gcn->bsgc', s_re, cr) - jnp.einsum('bsgn,gcn->bsgc', s_im, ci)
        return (s_re[:, -1], s_im[:, -1]), y

    h0 = (jnp.zeros((bsz, S5_GROUPS, S5_STATE), f32), jnp.zeros((bsz, S5_GROUPS, S5_STATE), f32))
    _, y = lax.scan(chunk_step, h0, uc)
    y = y.swapaxes(0, 1).reshape(bsz, t, D_MODEL) + d_skip.astype(f32) * u
    z = jax.nn.gelu(y).astype(xn.dtype) @ w_glu
    z1, z2 = jnp.split(z, 2, axis=-1)
    return (z1 * jax.nn.sigmoid(z2)) @ w_out


def fox_mixer(xn, w_in, b_f, w_out):
    bsz, t, _ = xn.shape
    n_blocks = t // Q_BLOCK
    proj = xn @ w_in
    q, k, v = (proj[..., i * D_MODEL:(i + 1) * D_MODEL]
               .reshape(bsz, t, FOX_HEADS, FOX_HEAD_DIM).transpose(0, 2, 1, 3) for i in range(3))
    log_f = jax.nn.log_sigmoid((proj[..., 3 * D_MODEL:] + b_f).astype(jnp.float32))
    cum_f = jnp.cumsum(log_f, axis=1).transpose(0, 2, 1)
    scale = FOX_HEAD_DIM ** -0.5
    qb = q.reshape(bsz, FOX_HEADS, n_blocks, Q_BLOCK, FOX_HEAD_DIM).transpose(2, 0, 1, 3, 4)
    fb = cum_f.reshape(bsz, FOX_HEADS, n_blocks, Q_BLOCK).transpose(2, 0, 1, 3)
    q_pos = jnp.arange(t).reshape(n_blocks, Q_BLOCK)
    k_pos = jnp.arange(t)

    def block(args):
        q_blk, f_blk, pos = args
        s = jnp.einsum('bhqd,bhkd->bhqk', q_blk, k).astype(jnp.float32) * scale
        s = s + (f_blk[..., :, None] - cum_f[:, :, None, :])
        s = jnp.where(pos[:, None] >= k_pos[None, :], s, NEG_INF)
        pr = jax.nn.softmax(s, axis=-1)
        return jnp.einsum('bhqk,bhkd->bhqd', pr.astype(v.dtype), v)

    o = lax.map(block, (qb, fb, q_pos))
    o = o.transpose(1, 0, 3, 2, 4).reshape(bsz, t, D_MODEL)
    return o @ w_out


def gla_mixer(xn, w_in, w_g2, b_g, gn_g, w_out):
    bsz, t, _ = xn.shape
    f32 = jnp.float32
    n_chunks = t // GLA_CHUNK
    proj = xn @ w_in
    q = proj[..., :GLA_KD]
    k = proj[..., GLA_KD:2 * GLA_KD]
    v = proj[..., 2 * GLA_KD:2 * GLA_KD + GLA_VD]
    r = proj[..., 2 * GLA_KD + GLA_VD:2 * GLA_KD + 2 * GLA_VD]
    g_lr = proj[..., 2 * GLA_KD + 2 * GLA_VD:]
    log_a = jax.nn.log_sigmoid((g_lr @ w_g2 + b_g).astype(f32)) / GLA_GATE_NORM

    def to_chunks(z, d):
        return z.reshape(bsz, n_chunks, GLA_CHUNK, GLA_HEADS, d).transpose(1, 0, 3, 2, 4)

    qc = to_chunks(q.astype(f32) * GLA_DK ** -0.5, GLA_DK)
    kc = to_chunks(k.astype(f32), GLA_DK)
    vc = to_chunks(v.astype(f32), GLA_DV)
    gc = to_chunks(log_a, GLA_DK)
    causal = jnp.tril(jnp.ones((GLA_CHUNK, GLA_CHUNK), dtype=bool))

    def chunk_step(state, xs):
        q_blk, k_blk, v_blk, g_blk = xs
        bcum = jnp.cumsum(g_blk, axis=2)
        b_last = bcum[:, :, -1:]
        q_dec = q_blk * jnp.exp(bcum)
        k_inv = k_blk * jnp.exp(-bcum)
        k_upd = k_blk * jnp.exp(b_last - bcum)
        att = jnp.where(causal, jnp.einsum('bhtk,bhsk->bhts', q_dec, k_inv), 0.0)
        o = jnp.einsum('bhts,bhsv->bhtv', att, v_blk) + jnp.einsum('bhtk,bhkv->bhtv', q_dec, state)
        state = jnp.exp(b_last).swapaxes(-1, -2) * state + jnp.einsum('bhsk,bhsv->bhkv', k_upd, v_blk)
        return state, o

    s0 = jnp.zeros((bsz, GLA_HEADS, GLA_DK, GLA_DV), f32)
    _, o = lax.scan(chunk_step, s0, (qc, kc, vc, gc))
    o = o.transpose(1, 0, 3, 2, 4).reshape(bsz, t, GLA_HEADS, GLA_DV)
    o = o * lax.rsqrt(jnp.mean(o * o, axis=-1, keepdims=True) + EPS)
    o = o.reshape(bsz, t, GLA_VD) * gn_g.astype(f32)
    o = (o * jax.nn.silu(r.astype(f32))).astype(xn.dtype)
    return o @ w_out


def sqrelu_mlp(xn, w1, w2):
    return jnp.square(jax.nn.relu(xn @ w1)) @ w2


def setup_inputs(seed: int = 0) -> dict:
    key = jax.random.key(seed)
    ks = iter(jax.random.split(key, 40))
    f32 = jnp.float32

    def nrm(shape, scale):
        return jax.random.normal(next(ks), shape, f32) * scale

    def gain(shape):
        return 1.0 + nrm(shape, 0.02)

    D = D_MODEL
    inputs = {}
    inputs['x'] = nrm((BATCH, SEQ, D), 1.0)
    inputs['p'] = nrm((DEPTH, BATCH, SEQ, PLE_DIM), 1.0)
    inputs['norm_mix'] = gain((DEPTH, D))
    inputs['norm_mlp'] = gain((DEPTH, D))
    inputs['norm_ple'] = gain((DEPTH, D))
    inputs['s5_w_in'] = nrm((N_A, D, D), D ** -0.5)
    inputs['s5_lam_re'] = -0.5 + nrm((N_A, S5_GROUPS, S5_STATE), 0.01)
    inputs['s5_lam_im'] = (math.pi * jnp.arange(S5_STATE, dtype=f32))[None, None, :] + nrm((N_A, S5_GROUPS, S5_STATE), 0.01)
    inputs['s5_log_dt'] = jax.random.uniform(next(ks), (N_A, S5_GROUPS), f32, minval=math.log(1e-3), maxval=math.log(1e-1))
    inputs['s5_b_re'] = nrm((N_A, S5_GROUPS, S5_STATE, S5_GROUP), (2 * S5_GROUP) ** -0.5)
    inputs['s5_b_im'] = nrm((N_A, S5_GROUPS, S5_STATE, S5_GROUP), (2 * S5_GROUP) ** -0.5)
    inputs['s5_c_re'] = nrm((N_A, S5_GROUPS, S5_GROUP, S5_STATE), (S5_STATE) ** -0.5)
    inputs['s5_c_im'] = nrm((N_A, S5_GROUPS, S5_GROUP, S5_STATE), (S5_STATE) ** -0.5)
    inputs['s5_d'] = nrm((N_A, D), 1.0)
    inputs['s5_w_glu'] = nrm((N_A, D, 2 * D), D ** -0.5)
    inputs['s5_w_out'] = nrm((N_A, D, D), D ** -0.5)
    inputs['fox_w_in'] = nrm((N_B, D, FOX_IN), D ** -0.5)
    inputs['fox_b_f'] = jax.random.uniform(next(ks), (N_B, FOX_HEADS), f32, minval=1.0, maxval=5.0)
    inputs['fox_w_out'] = nrm((N_B, D, D), D ** -0.5)
    inputs['gla_w_in'] = nrm((N_C, D, GLA_IN), D ** -0.5)
    inputs['gla_w_g2'] = nrm((N_C, GLA_RANK, GLA_KD), GLA_RANK ** -0.5)
    inputs['gla_b_g'] = nrm((N_C, GLA_KD), 0.1)
    inputs['gla_norm'] = gain((N_C, GLA_VD))
    inputs['gla_w_out'] = nrm((N_C, GLA_VD, D), GLA_VD ** -0.5)
    inputs['mlp_w1'] = nrm((DEPTH, D, D_FF), D ** -0.5)
    inputs['mlp_w2'] = nrm((DEPTH, D_FF, D), D_FF ** -0.5)
    inputs['ple_proj'] = nrm((DEPTH, PLE_DIM, D), PLE_DIM ** -0.5)
    inputs['ple_gate'] = nrm((DEPTH, D, D), D ** -0.5)
    inputs['final_norm'] = gain((D,))
    return inputs


def reference(x, p, norm_mix, norm_mlp, norm_ple,
              s5_w_in, s5_lam_re, s5_lam_im, s5_log_dt, s5_b_re, s5_b_im, s5_c_re, s5_c_im,
              s5_d, s5_w_glu, s5_w_out,
              fox_w_in, fox_b_f, fox_w_out,
              gla_w_in, gla_w_g2, gla_b_g, gla_norm, gla_w_out,
              mlp_w1, mlp_w2, ple_proj, ple_gate, final_norm):
    h = x
    for i in range(DEPTH):
        mixer, j = i % N_MIXERS, i // N_MIXERS
        xn = rmsnorm(h, norm_mix[i])
        if mixer == 0:
            y = s5_mixer(xn, s5_w_in[j], s5_lam_re[j], s5_lam_im[j], s5_log_dt[j], s5_b_re[j], s5_b_im[j],
                         s5_c_re[j], s5_c_im[j], s5_d[j], s5_w_glu[j], s5_w_out[j])
        elif mixer == 1:
            y = fox_mixer(xn, fox_w_in[j], fox_b_f[j], fox_w_out[j])
        else:
            y = gla_mixer(xn, gla_w_in[j], gla_w_g2[j], gla_b_g[j], gla_norm[j], gla_w_out[j])
        h = h + y.astype(h.dtype)
        h = h + sqrelu_mlp(rmsnorm(h, norm_mlp[i]), mlp_w1[i], mlp_w2[i])
        gate = jax.nn.sigmoid(rmsnorm(h, norm_ple[i]) @ ple_gate[i])
        h = h + (p[i] @ ple_proj[i]) * gate
    return rmsnorm(h, final_norm)
```

```cpp
#include <hip/hip_runtime.h>
#include <hip/hip_cooperative_groups.h>
#include <cstdio>
#include <cstdint>
#include <hip/hip_bf16.h>
#include <cmath>
namespace pg8 {
#define PG8_LAS __attribute__((address_space(3)))
typedef unsigned short bf16_t;
typedef short bf16x8 __attribute__((ext_vector_type(8)));
typedef float f32x4 __attribute__((ext_vector_type(4)));
typedef unsigned u32x4 __attribute__((ext_vector_type(4)));
constexpr int BM = 256, BK = 64, HALF = 128, HTB = HALF * BK * 2  , STAGE_BYTES = 8 * HTB, NXCD = 8, WGM = 8;

__host__ __device__ __forceinline__ int lds_byte(int r, int c) { const int st = (r >> 4) * 2 + (c >> 5), rr = r & 15, cc = c & 31, ob = rr * 64 + cc * 2; return st * 1024 + (ob ^ (((ob >> 9) & 1) << 5)); }
__host__ __device__ __forceinline__ void stage_rc(int b, int& R, int& C) { const int st = b / 1024, sb = b % 1024, swz = sb ^ (((sb >> 9) & 1) << 5); R = (st >> 1) * 16 + swz / 64; C = (st & 1) * 32 + (swz % 64) / 2; }
__host__ __device__ __forceinline__ int perm32(int rho) { const int n = rho >> 4, i = rho & 15; return 8 * (i >> 2) + 4 * n + (i & 3); }

struct Unit { int pm, pn; };
struct Gemm { const bf16_t* A; const bf16_t* Bt; int M, N, K; };

struct StaticOrder {
    int nM, nN, nwg, G, c;
    __host__ __device__ void init(int M, int N, int G_, int c_) { nM = M / BM; nN = N / BM; nwg = nM * nN; G = G_; c = c_; }
    __host__ __device__ bool next(int i, Unit& u) const {
        const long L = (long)i * G + c; if (L >= nwg) return false;
        int wgid = (int)L; { const int q = nwg / NXCD, r = nwg % NXCD, xcd = wgid % NXCD, off = wgid / NXCD; wgid = (xcd < r ? xcd * (q + 1) : r * (q + 1) + (xcd - r) * q) + off; }
        const int nig = WGM * nN, gid = wgid / nig, fm = gid * WGM, gsz = (nM - fm) < WGM ? (nM - fm) : WGM;
        u.pm = fm + ((wgid % nig) % gsz); u.pn = (wgid % nig) / gsz; return true;
    }
    __device__ __forceinline__ void a_ready(const Unit&) const {}
    __device__ __forceinline__ void done(const Unit&) const {}
};

__device__ __forceinline__ unsigned cvt_pk_bf16(float lo, float hi) { unsigned r; asm volatile("v_cvt_pk_bf16_f32 %0, %1, %2" : "=v"(r) : "v"(lo), "v"(hi)); return r; }
typedef float f32x2 __attribute__((ext_vector_type(2)));
typedef unsigned u32x2 __attribute__((ext_vector_type(2)));
__device__ __forceinline__ float sigm(float x) { return 1.0f / (1.0f + __expf(-x)); }
__device__ __forceinline__ float row_rstd(const float* ssq, size_t row) {
    const f32x4* s = (const f32x4*)(ssq + row * 16); const f32x4 a = (s[0] + s[1]) + (s[2] + s[3]);
    return rsqrtf(((a[0] + a[1]) + (a[2] + a[3])) * (1.0f / 1024.0f) + 1e-6f);
}
template <int MODE> struct EpiAct {
    static constexpr bool PERM = true, AFTER_DRAIN = false;
    bf16_t* O; int ldc; const float* ssq; int split_cols; size_t split_stride; float scale0; float* ftile; int fcol0;
    __device__ __forceinline__ void operator()(const f32x4 (&acc)[2][2][4][2], const Unit& u, int wr, int wc, int fr, int fq) const {
        const int row0 = u.pm * BM + wr * 64 + fr; int colt = u.pn * BM; bf16_t* base = O;
        float rs[2][4];
#pragma unroll
        for (int ai = 0; ai < 2; ++ai)
#pragma unroll
            for (int m = 0; m < 4; ++m) rs[ai][m] = ssq ? row_rstd(ssq, (size_t)(row0 + ai * HALF + m * 16)) : 1.0f;
        if (MODE == 0 && ftile != nullptr && colt >= fcol0) {
            if (wc == 0 && fq < 2) {
#pragma unroll
                for (int ai = 0; ai < 2; ++ai)
#pragma unroll
                    for (int m = 0; m < 4; ++m) { float* dst = ftile + (size_t)(row0 + ai * HALF + m * 16) * 16 + 8 * fq;
                        *(f32x4*)dst = acc[ai][0][m][0] * rs[ai][m]; *(f32x4*)(dst + 4) = acc[ai][0][m][1] * rs[ai][m]; }
            }
            return;
        }
        if (MODE == 2) {
            const int col0 = u.pn * HALF + wc * 32 + 8 * fq;
#pragma unroll
            for (int ai = 0; ai < 2; ++ai)
#pragma unroll
                for (int m = 0; m < 4; ++m) { bf16_t* rowp = base + (size_t)(row0 + ai * HALF + m * 16) * ldc + col0;
                    const f32x4 a0 = acc[ai][0][m][0], a1 = acc[ai][0][m][1], g0 = acc[ai][1][m][0], g1 = acc[ai][1][m][1];
                    u32x4 w; w.x = cvt_pk_bf16(a0[0] * sigm(g0[0]), a0[1] * sigm(g0[1])); w.y = cvt_pk_bf16(a0[2] * sigm(g0[2]), a0[3] * sigm(g0[3]));
                    w.z = cvt_pk_bf16(a1[0] * sigm(g1[0]), a1[1] * sigm(g1[1])); w.w = cvt_pk_bf16(a1[2] * sigm(g1[2]), a1[3] * sigm(g1[3]));
                    *(u32x4*)rowp = w; }
            return;
        }
        float sc = 1.f; if (split_cols) { const int t = colt / split_cols; base += (size_t)t * split_stride; colt -= t * split_cols; if (t == 0) sc = scale0; }
        const int col0 = colt + wc * 32 + 8 * fq;
#pragma unroll
        for (int ai = 0; ai < 2; ++ai)
#pragma unroll
            for (int m = 0; m < 4; ++m) { bf16_t* rowp = base + (size_t)(row0 + ai * HALF + m * 16) * ldc + col0; const float s = rs[ai][m] * sc;
#pragma unroll
                for (int bj = 0; bj < 2; ++bj) { f32x4 v0 = acc[ai][bj][m][0] * s, v1 = acc[ai][bj][m][1] * s;
                    if (MODE == 1) {
#pragma unroll
                        for (int e = 0; e < 4; ++e) { const float a = fmaxf(v0[e], 0.f), b = fmaxf(v1[e], 0.f); v0[e] = a * a; v1[e] = b * b; } }
                    u32x4 w; w.x = cvt_pk_bf16(v0[0], v0[1]); w.y = cvt_pk_bf16(v0[2], v0[3]); w.z = cvt_pk_bf16(v1[0], v1[1]); w.w = cvt_pk_bf16(v1[2], v1[3]);
                    *(u32x4*)(rowp + bj * HALF) = w; } }
    }
};
template <int MODE> struct EpiRes {
    static constexpr bool PERM = false, AFTER_DRAIN = false;
    const float* base; float* out; bf16_t* hb; const float* ssq_in; float* ssq_out; const bf16_t* pp; int ldc;
    __device__ __forceinline__ void operator()(const f32x4 (&acc)[2][2][4][2], const Unit& u, int wr, int wc, int fr, int fq) const {
        const int col0 = u.pn * BM + wc * 32 + 4 * fq;
#pragma unroll
        for (int ai = 0; ai < 2; ++ai)
#pragma unroll
            for (int m = 0; m < 4; ++m) { const int r = u.pm * BM + ai * HALF + wr * 64 + m * 16 + fr; const size_t off = (size_t)r * ldc + col0;
                float rs = 1.f; if (MODE == 1) rs = row_rstd(ssq_in, (size_t)r);
                float q = 0.f;
#pragma unroll
                for (int bj = 0; bj < 2; ++bj)
#pragma unroll
                    for (int n = 0; n < 2; ++n) { const size_t o2 = off + bj * HALF + n * 16; const f32x4 b = *(const f32x4*)(base + o2); const f32x4 a = acc[ai][bj][m][n]; f32x4 v;
                        if (MODE == 1) { const u32x2 pw = *(const u32x2*)(pp + o2);
                            const float p0 = __uint_as_float(pw.x << 16), p1 = __uint_as_float(pw.x & 0xffff0000u), p2 = __uint_as_float(pw.y << 16), p3 = __uint_as_float(pw.y & 0xffff0000u);
                            v[0] = b[0] + p0 * sigm(a[0] * rs); v[1] = b[1] + p1 * sigm(a[1] * rs); v[2] = b[2] + p2 * sigm(a[2] * rs); v[3] = b[3] + p3 * sigm(a[3] * rs); }
                        else v = b + a;
                        *(f32x4*)(out + o2) = v; u32x2 w; w.x = cvt_pk_bf16(v[0], v[1]); w.y = cvt_pk_bf16(v[2], v[3]); *(u32x2*)(hb + o2) = w;
                        q += (v[0] * v[0] + v[1] * v[1]) + (v[2] * v[2] + v[3] * v[3]); }
                q += __shfl_xor(q, 16); q += __shfl_xor(q, 32);
                if (fq == 0) ssq_out[(size_t)r * 16 + u.pn * 4 + wc] = q;
                asm volatile("" ::: "memory"); }
    }
};
template <class Epi, class Sched, bool ALIGN_EPI = false, bool SP2 = false>
__device__ __forceinline__ void gemm_phase(PG8_LAS unsigned char* lds, const Gemm g, const Sched& S, const Epi& E) {
    int tid_ = threadIdx.x; asm volatile("" : "+v"(tid_)); const int tid = tid_, wid = __builtin_amdgcn_readfirstlane(tid >> 6), lane = tid & 63, wr = wid >> 2, wc = wid & 3, fr = lane & 15, fq = lane >> 4;
    const int K = g.K, nt = K / BK;
    unsigned voffA[2], voffB[2];
#pragma unroll
    for (int i = 0; i < 2; ++i) { int R, C; stage_rc(tid * 16 + i * 8192, R, C); const int Rb = Epi::PERM ? ((R & ~31) + perm32(R & 31)) : R;
        voffA[i] = (unsigned)(R * K + C) * 2u; voffB[i] = (unsigned)(Rb * K + C) * 2u; }
    const size_t kstep = (size_t)(BK * 2);
    const size_t hstep = (size_t)HALF * K * 2;
    const size_t tstep = 2 * hstep;
    const unsigned ldsw = (unsigned)wid * 1024u;
    const int aoff = lds_byte(wr * 64 + fr, fq * 8), boff = lds_byte(wc * 32 + fr, fq * 8);
#define PG8_SA(b, h) (((b) * 2 + (h)) * HTB)
#define PG8_SB(b, h) ((4 + (b) * 2 + (h)) * HTB)
#define PG8_STAGE(bufoff, gbase, voff) do { _Pragma("unroll") for (int _i = 0; _i < 2; ++_i) \
        __builtin_amdgcn_global_load_lds((const unsigned*)((const char*)(gbase) + (voff)[_i]), (PG8_LAS unsigned*)(lds + (bufoff) + ldsw + _i * 8192), 16, 0, 0); } while (0)
#define PG8_LDA(dst, b, h) do { _Pragma("unroll") for (int m = 0; m < 4; ++m) _Pragma("unroll") for (int k = 0; k < 2; ++k) dst[m][k] = *(const PG8_LAS bf16x8*)(lds + PG8_SA(b, h) + aoff + m * 2048 + k * 1024); } while (0)
#define PG8_LDB(dst, b, h) do { _Pragma("unroll") for (int n = 0; n < 2; ++n) _Pragma("unroll") for (int k = 0; k < 2; ++k) dst[n][k] = *(const PG8_LAS bf16x8*)(lds + PG8_SB(b, h) + boff + n * 2048 + k * 1024); } while (0)
#define PG8_MMA(ai, bj, At, Bt) do { __builtin_amdgcn_s_setprio(1); _Pragma("unroll") for (int m = 0; m < 4; ++m) _Pragma("unroll") for (int n = 0; n < 2; ++n) _Pragma("unroll") for (int k = 0; k < 2; ++k) \
        acc[ai][bj][m][n] = __builtin_amdgcn_mfma_f32_16x16x32_bf16(Bt[n][k], At[m][k], acc[ai][bj][m][n], 0, 0, 0); __builtin_amdgcn_s_setprio(0); } while (0)
#define PG8_WAIT_V(n) asm volatile("s_waitcnt vmcnt(" #n ")" ::: "memory")
#define PG8_WAIT_L(n) asm volatile("s_waitcnt lgkmcnt(" #n ")" ::: "memory")
#define PG8_BAR __builtin_amdgcn_s_barrier()
#define PG8_SCHED __builtin_amdgcn_sched_barrier(0)
    Unit cur, nxt; int ui = 0;
    if (!S.next(0, cur)) return;
    f32x4 acc[2][2][4][2];
#pragma unroll
    for (int a = 0; a < 2; ++a)
#pragma unroll
        for (int b = 0; b < 2; ++b)
#pragma unroll
            for (int m = 0; m < 4; ++m)
#pragma unroll
                for (int n = 0; n < 2; ++n) acc[a][b][m][n] = (f32x4){0.f, 0.f, 0.f, 0.f};
    bf16x8 At[4][2], B0[2][2], B1[2][2];
    const char* cA = (const char*)g.A + (size_t)cur.pm * tstep; const char* cB = (const char*)g.Bt + (size_t)cur.pn * tstep;
    S.a_ready(cur);
    if constexpr (SP2) {
        PG8_STAGE(PG8_SB(0, 0), cB, voffB); PG8_STAGE(PG8_SB(0, 1), cB + hstep, voffB); PG8_STAGE(PG8_SA(0, 0), cA, voffA); PG8_STAGE(PG8_SA(0, 1), cA + hstep, voffA);
        if (wr == 1) PG8_BAR;
        PG8_WAIT_V(2); PG8_BAR;
        PG8_STAGE(PG8_SB(1, 0), cB + kstep, voffB); PG8_STAGE(PG8_SA(1, 0), cA + kstep, voffA); PG8_STAGE(PG8_SB(1, 1), cB + hstep + kstep, voffB);
        PG8_WAIT_V(6); PG8_BAR;
    } else {
        PG8_STAGE(PG8_SB(0, 0), cB, voffB); PG8_STAGE(PG8_SA(0, 0), cA, voffA); PG8_STAGE(PG8_SB(0, 1), cB + hstep, voffB); PG8_STAGE(PG8_SA(0, 1), cA + hstep, voffA);
        if (wr == 1) PG8_BAR;
        PG8_WAIT_V(4); PG8_BAR;
        PG8_STAGE(PG8_SB(1, 0), cB + kstep, voffB); PG8_STAGE(PG8_SA(1, 0), cA + kstep, voffA); PG8_STAGE(PG8_SB(1, 1), cB + hstep + kstep, voffB);
        PG8_WAIT_V(6); PG8_BAR;
    }
    for (;;) {
        const bool has_next = S.next(ui + 1, nxt);
        const char* nA = has_next ? (const char*)g.A + (size_t)nxt.pm * tstep : cA; const char* nB = has_next ? (const char*)g.Bt + (size_t)nxt.pn * tstep : cB;
        for (int t = 0; t < nt; t += 2) {
            const bool last = (t == nt - 2);
            const char* a1 = cA + (size_t)(t + 1) * kstep;
            const char* a2 = last ? nA : cA + (size_t)(t + 2) * kstep; const char* b2 = last ? nB : cB + (size_t)(t + 2) * kstep;
            const char* a3 = a2 + kstep; const char* b3 = b2 + kstep;
            if (last && has_next) S.a_ready(nxt);
            if constexpr (SP2) {
            PG8_LDB(B0, 0, 0); PG8_LDB(B1, 0, 1); PG8_SCHED; PG8_LDA(At, 0, 0); PG8_STAGE(PG8_SA(1, 1), a1 + hstep, voffA);
            PG8_WAIT_V(8); PG8_WAIT_L(0); PG8_BAR; PG8_MMA(0, 0, At, B0); PG8_MMA(0, 1, At, B1); PG8_BAR; PG8_SCHED;
            PG8_LDA(At, 0, 1); PG8_STAGE(PG8_SB(0, 0), b2, voffB); PG8_STAGE(PG8_SB(0, 1), b2 + hstep, voffB); PG8_STAGE(PG8_SA(0, 0), a2, voffA);
            PG8_WAIT_V(8); PG8_WAIT_L(0); PG8_BAR; PG8_MMA(1, 0, At, B0); PG8_MMA(1, 1, At, B1); PG8_BAR; PG8_SCHED;
            PG8_LDB(B0, 1, 0); PG8_LDB(B1, 1, 1); PG8_SCHED; PG8_LDA(At, 1, 0); PG8_STAGE(PG8_SA(0, 1), a2 + hstep, voffA);
            PG8_WAIT_V(8); PG8_WAIT_L(0); PG8_BAR; PG8_MMA(0, 0, At, B0); PG8_MMA(0, 1, At, B1); PG8_BAR; PG8_SCHED;
            PG8_LDA(At, 1, 1); PG8_STAGE(PG8_SB(1, 0), b3, voffB); PG8_STAGE(PG8_SB(1, 1), b3 + hstep, voffB); PG8_STAGE(PG8_SA(1, 0), a3, voffA);
            PG8_WAIT_V(8); PG8_WAIT_L(0); PG8_BAR; PG8_MMA(1, 0, At, B0); PG8_MMA(1, 1, At, B1); PG8_BAR; PG8_SCHED;
            } else {
            PG8_LDB(B0, 0, 0); PG8_SCHED; PG8_LDA(At, 0, 0); PG8_STAGE(PG8_SA(1, 1), a1 + hstep, voffA);
            PG8_WAIT_L(8); PG8_BAR; PG8_WAIT_L(0); PG8_MMA(0, 0, At, B0); PG8_BAR; PG8_SCHED;
            PG8_LDB(B1, 0, 1); PG8_STAGE(PG8_SB(0, 0), b2, voffB);
            PG8_BAR; PG8_WAIT_L(0); PG8_MMA(0, 1, At, B1); PG8_BAR;
            PG8_LDA(At, 0, 1); PG8_STAGE(PG8_SA(0, 0), a2, voffA);
            PG8_BAR; PG8_WAIT_L(0); PG8_MMA(1, 0, At, B0); PG8_BAR; PG8_SCHED;
            PG8_STAGE(PG8_SB(0, 1), b2 + hstep, voffB);
            PG8_WAIT_V(6); PG8_BAR; PG8_MMA(1, 1, At, B1); PG8_BAR;
            PG8_LDB(B0, 1, 0); PG8_SCHED; PG8_LDA(At, 1, 0); PG8_STAGE(PG8_SA(0, 1), a2 + hstep, voffA);
            PG8_WAIT_L(8); PG8_BAR; PG8_WAIT_L(0); PG8_MMA(0, 0, At, B0); PG8_BAR; PG8_SCHED;
            PG8_LDB(B1, 1, 1); PG8_STAGE(PG8_SB(1, 0), b3, voffB);
            PG8_BAR; PG8_WAIT_L(0); PG8_MMA(0, 1, At, B1); PG8_BAR;
            PG8_LDA(At, 1, 1); PG8_STAGE(PG8_SA(1, 0), a3, voffA);
            PG8_BAR; PG8_WAIT_L(0); PG8_MMA(1, 0, At, B0); PG8_BAR; PG8_SCHED;
            PG8_STAGE(PG8_SB(1, 1), b3 + hstep, voffB);
            PG8_WAIT_V(6); PG8_BAR; PG8_MMA(1, 1, At, B1); PG8_BAR;
            }
        }
        if constexpr (ALIGN_EPI) { if (wr == 0) PG8_BAR; }
        if constexpr (!Epi::AFTER_DRAIN) { E(acc, cur, wr, wc, fr, fq); S.done(cur); }
        if (!has_next) break;
#pragma unroll
        for (int a = 0; a < 2; ++a)
#pragma unroll
            for (int b = 0; b < 2; ++b)
#pragma unroll
                for (int m = 0; m < 4; ++m)
#pragma unroll
                    for (int n = 0; n < 2; ++n) acc[a][b][m][n] = (f32x4){0.f, 0.f, 0.f, 0.f};
        cur = nxt; cA = nA; cB = nB; ++ui;
        if constexpr (ALIGN_EPI) { if (wr == 1) PG8_BAR; }
    }
    PG8_WAIT_V(0);
    if constexpr (!ALIGN_EPI) { if (wr == 0) PG8_BAR; }
    PG8_BAR;
    if constexpr (Epi::AFTER_DRAIN) { E.fused(acc, cur, wr, wc, fr, fq, lds, wid, lane); S.done(cur); }
#undef PG8_SA
#undef PG8_SB
#undef PG8_STAGE
#undef PG8_LDA
#undef PG8_LDB
#undef PG8_MMA
#undef PG8_WAIT_V
#undef PG8_WAIT_L
#undef PG8_BAR
#undef PG8_SCHED
}
}
#include <hip/hip_bf16.h>
#include <cmath>
namespace attn_body {
using bf16=__hip_bfloat16;
using bf16x8=__attribute__((ext_vector_type(8)))short;
using s16x4=__attribute__((ext_vector_type(4)))short;
using f32x16=__attribute__((ext_vector_type(16)))float;
using u32x4=__attribute__((ext_vector_type(4)))unsigned;
constexpr int BATCH=16,NHEAD=16,SEQ=2048,D=64,DM=NHEAD*D;
constexpr int NW=8,QBLK=32,QB=QBLK*NW,KVBLK=64,NQB=SEQ/QB;
constexpr int ATTN_PITCH=DM, ATTN_UNIT_ROWS=QB;
__device__ __forceinline__ int crow(int r,int hi){return (r&3)+8*(r>>2)+4*hi;}
#define SBAR() __builtin_amdgcn_sched_barrier(0)
__device__ __forceinline__ void cmask(f32x16&p0,f32x16&p1,int jb,int qrel,int hi){
  const float NEG=-INFINITY; int kb=64*jb+4*hi;
  #pragma unroll
  for(int r=0;r<16;++r){int kv=kb+(r&3)+8*(r>>2); if(kv>qrel)p0[r]=NEG; if(kv+32>qrel)p1[r]=NEG;}
}

constexpr int NSLOT=3, SLOTB=8192;
constexpr int LDS_K=0, LDS_V=NSLOT*SLOTB, LDS_WS=2*NSLOT*SLOTB, LDS_OST=LDS_WS+NW*64*4, LDS_BIAS=LDS_OST+NW*4096, LDS_BYTES=LDS_BIAS+SEQ*4;
constexpr float C2=0.125f*1.4426950408889634f;
__device__ __forceinline__ void glds16(const void*gsrc,unsigned lds_dst){unsigned keep;
  asm volatile("s_mov_b32 %0, m0\n\ts_mov_b32 m0, %2\n\ts_nop 0\n\tglobal_load_lds_dwordx4 %1, off\n\ts_mov_b32 m0, %0":"=&s"(keep):"v"(gsrc),"s"(lds_dst):"memory");}
__device__ __forceinline__ float max3f(float a,float b,float c){float r;asm("v_max3_f32 %0, %1, %2, %3":"=v"(r):"v"(a),"v"(b),"v"(c));return r;}
__device__ __forceinline__ float max2f(float a,float b){float r;asm("v_max_f32_e32 %0, %1, %2":"=v"(r):"v"(a),"v"(b));return r;}
__device__ __forceinline__ float fadd_s(float a,float b){float r;asm("v_add_f32_e32 %0, %1, %2":"=v"(r):"v"(a),"v"(b));return r;}
__device__ __forceinline__ float fsub_s(float a,float b){float r;asm("v_sub_f32_e32 %0, %1, %2":"=v"(r):"v"(a),"v"(b));return r;}
typedef float f32x2_t __attribute__((ext_vector_type(2))); typedef __bf16 bf16x2_t __attribute__((ext_vector_type(2)));
__device__ __forceinline__ unsigned cvtpk_s(float lo,float hi){f32x2_t v={lo,hi};bf16x2_t b=__builtin_convertvector(v,bf16x2_t);return __builtin_bit_cast(unsigned,b);}
#define WAIT_BAR(N) asm volatile("s_waitcnt vmcnt(" #N ") lgkmcnt(0)\n\ts_barrier":::"memory")

__device__ __forceinline__ void qkt(f32x16&p0,f32x16&p1,const char*Kslot,const bf16x8*qr,const f32x16&negm,int r32,int hi){
  const char*kb=Kslot+hi*1024+r32*16;
  #pragma unroll
  for(int d0=0;d0<4;++d0){
    const bf16x8 b0=*reinterpret_cast<const bf16x8*>(kb+d0*2048);
    const bf16x8 b1=*reinterpret_cast<const bf16x8*>(kb+d0*2048+512);
    if(d0==0){p0=__builtin_amdgcn_mfma_f32_32x32x16_bf16(b0,qr[0],negm,0,0,0);p1=__builtin_amdgcn_mfma_f32_32x32x16_bf16(b1,qr[0],negm,0,0,0);}
    else{p0=__builtin_amdgcn_mfma_f32_32x32x16_bf16(b0,qr[d0],p0,0,0,0);p1=__builtin_amdgcn_mfma_f32_32x32x16_bf16(b1,qr[d0],p1,0,0,0);}}
}
typedef __attribute__((address_space(3))) const char* lds_cptr;
typedef short v4i16_t __attribute__((ext_vector_type(4)));
__device__ __forceinline__ void kload8(bf16x8*kf,lds_cptr kp){
  kf[0]=*(const __attribute__((address_space(3))) bf16x8*)(kp);      kf[1]=*(const __attribute__((address_space(3))) bf16x8*)(kp+512);
  kf[2]=*(const __attribute__((address_space(3))) bf16x8*)(kp+2048); kf[3]=*(const __attribute__((address_space(3))) bf16x8*)(kp+2560);
  kf[4]=*(const __attribute__((address_space(3))) bf16x8*)(kp+4096); kf[5]=*(const __attribute__((address_space(3))) bf16x8*)(kp+4608);
  kf[6]=*(const __attribute__((address_space(3))) bf16x8*)(kp+6144); kf[7]=*(const __attribute__((address_space(3))) bf16x8*)(kp+6656);
}
__device__ __forceinline__ void kload2(bf16x8*kf,lds_cptr kp,int j){ kf[2*j]=*(const __attribute__((address_space(3))) bf16x8*)(kp+j*2048); kf[2*j+1]=*(const __attribute__((address_space(3))) bf16x8*)(kp+j*2048+512); }
__device__ __forceinline__ s16x4 vtr(lds_cptr p){ return __builtin_bit_cast(s16x4,__builtin_amdgcn_ds_read_tr16_b64_v4i16((__attribute__((address_space(3))) v4i16_t*)p)); }
__device__ __forceinline__ float rowmax(const f32x16&p0,const f32x16&p1){
  float a=max3f(p0[0],p0[1],p1[0]),b=max3f(p0[2],p0[3],p1[1]);a=max3f(a,p1[2],p1[3]);
  #pragma unroll
  for(int r=4;r<16;r+=4){a=max3f(a,p0[r],p0[r+1]);b=max3f(b,p0[r+2],p0[r+3]);a=max3f(a,p1[r],p1[r+1]);b=max3f(b,p1[r+2],p1[r+3]);}
  const float m=max2f(a,b);
  auto rr=__builtin_amdgcn_permlane32_swap(__float_as_uint(m),__float_as_uint(m),false,false);
  return max2f(__uint_as_float(rr[0]),__uint_as_float(rr[1]));
}
__device__ __forceinline__ void pv(f32x16*o,int vb,bf16x8 pa0,bf16x8 pa1,bf16x8 pa2,bf16x8 pa3){
  #pragma unroll
  for(int d0=0;d0<2;++d0){s16x4 lo[4],hi[4];
    #pragma unroll
    for(int ks=0;ks<4;++ks){
      asm volatile("ds_read_b64_tr_b16 %0,%1 offset:%c2":"=&v"(lo[ks]):"v"(vb),"i"(d0*4096+ks*1024):"memory");
      asm volatile("ds_read_b64_tr_b16 %0,%1 offset:%c2":"=&v"(hi[ks]):"v"(vb),"i"(d0*4096+ks*1024+512):"memory");}
    asm volatile("s_waitcnt lgkmcnt(0)":::"memory");SBAR();
    #define PK(k) (bf16x8){lo[k][0],lo[k][1],lo[k][2],lo[k][3],hi[k][0],hi[k][1],hi[k][2],hi[k][3]}
    o[d0]=__builtin_amdgcn_mfma_f32_32x32x16_bf16(pa0,PK(0),o[d0],0,0,0);
    o[d0]=__builtin_amdgcn_mfma_f32_32x32x16_bf16(pa1,PK(1),o[d0],0,0,0);
    o[d0]=__builtin_amdgcn_mfma_f32_32x32x16_bf16(pa2,PK(2),o[d0],0,0,0);
    o[d0]=__builtin_amdgcn_mfma_f32_32x32x16_bf16(pa3,PK(3),o[d0],0,0,0);
    #undef PK
  }
}

#ifndef ATTN_STORE16
#define ATTN_STORE16(p,v) (*(u32x4*)(p)=(v))
#endif
typedef float f32x4_t __attribute__((ext_vector_type(4)));
template<int THRL> __device__ __forceinline__ void attn_unit(int b,int h,int qb,const bf16*Q,const bf16*__restrict__ K,const bf16*__restrict__ V,bf16*O,const float*NEGF,char*shm){
  int tid_=threadIdx.x; asm volatile("":"+v"(tid_)); const int tid=tid_,lane=tid&63,r32=lane&31,hi=lane>>5; const int wid=__builtin_amdgcn_readfirstlane(tid>>6);
  const long rowbase=(long)b*SEQ; const int q0=qb*QB;
  const bf16*Qw=Q+(rowbase+q0+wid*QBLK)*DM+h*D;
  const bf16*Kh=K+rowbase*DM+h*D,*Vh=V+rowbase*DM+h*D;
  const unsigned lds0=(unsigned)(uintptr_t)shm;
  float*wsf=(float*)(shm+LDS_WS)+wid*64;
  const bf16*ksrc=Kh+(long)lane*DM+wid*8;
  const bf16*vsrc=Vh+(long)(16*(wid&3)+(lane>>2))*DM+(wid>>2)*32+(lane&3)*8;
  const unsigned kdst=lds0+LDS_K+wid*1024, vdst=lds0+LDS_V+wid*1024;
  #define DMA_K(t,slot) glds16(ksrc+(long)(t)*KVBLK*DM,(unsigned)__builtin_amdgcn_readfirstlane(kdst+(slot)))
  #define DMA_V(t,slot) glds16(vsrc+(long)(t)*KVBLK*DM,(unsigned)__builtin_amdgcn_readfirstlane(vdst+(slot)))
  const int vb0=(int)(lds0+LDS_V)+((lane>>4)&1)*32+(lane&3)*8+(4*hi+((lane&15)>>2))*64;
  const char*Kbase=shm+LDS_K; bf16x8 kf[8];
  const lds_cptr shm3=(lds_cptr)shm; const lds_cptr kp0=shm3+LDS_K+hi*1024+r32*16; const lds_cptr vp0=shm3+LDS_V+((lane>>4)&1)*32+(lane&3)*8+(4*hi+((lane&15)>>2))*64;
  const int NT=(q0+QB)/KVBLK;
  { const f32x4_t bv_=*(const f32x4_t*)(NEGF+(long)(b*NHEAD+h)*SEQ+tid*4); *(__attribute__((address_space(3))) f32x4_t*)((__attribute__((address_space(3))) char*)shm+LDS_BIAS+tid*16)=bv_; }
  #define KBIAS(P0,P1,t) do{ const lds_cptr bq_=shm3+LDS_BIAS+((t)*64+4*hi)*4; \
    _Pragma("unroll") for(int j_=0;j_<4;++j_){ { const f32x4_t x0_=*(const __attribute__((address_space(3))) f32x4_t*)(bq_+32*j_); \
      P0[4*j_]+=x0_[0];P0[4*j_+1]+=x0_[1];P0[4*j_+2]+=x0_[2];P0[4*j_+3]+=x0_[3]; } asm volatile("":::"memory"); \
      { const f32x4_t x1_=*(const __attribute__((address_space(3))) f32x4_t*)(bq_+32*j_+128); \
      P1[4*j_]+=x1_[0];P1[4*j_+1]+=x1_[1];P1[4*j_+2]+=x1_[2];P1[4*j_+3]+=x1_[3]; } asm volatile("":::"memory"); } }while(0)
  DMA_K(0,0);DMA_V(0,0);DMA_K(1,SLOTB);
  bf16x8 qr[4];
  #pragma unroll
  for(int d0=0;d0<4;++d0)qr[d0]=*reinterpret_cast<const bf16x8*>(&Qw[(long)r32*DM+d0*16+hi*8]);
  float mhat=0.f,l_reg=0.f;f32x16 o[2];o[0]=f32x16{};o[1]=f32x16{};f32x16 negm=f32x16{};asm volatile("":"+v"(negm));
  const int qrel=wid*QBLK+r32;
  #define CMASK(P0,P1,t) do{int jb_=(t)-(NT-4); if(jb_>=0)cmask(P0,P1,jb_,qrel,hi);}while(0)
  bool resc=false;
  #define START(P0,P1) do{ const float rm=rowmax(P0,P1); resc=false; \
    { const float dl=rm; mhat=fadd_s(mhat,dl); \
      _Pragma("unroll") for(int r=0;r<16;++r){P0[r]=fsub_s(P0[r],dl);P1[r]=fsub_s(P1[r],dl);} \
      _Pragma("unroll") for(int r=0;r<16;++r)negm[r]=-mhat; asm volatile("":"+v"(negm)); } \
    _Pragma("unroll") for(int r=0;r<16;++r)P0[r]=__builtin_amdgcn_exp2f(P0[r]); }while(0)
  #define RESC() do{ if(resc){ asm volatile("s_waitcnt lgkmcnt(0)":::"memory"); \
      _Pragma("unroll") for(int d_=0;d_<2;++d_) _Pragma("unroll") for(int r=0;r<16;++r)o[d_][r]*=wsf[crow(r,hi)]; } }while(0)
  f32x16 pA0,pA1,pB0,pB1;
  int sl_prev=0,sl_cur=0,sl_next=SLOTB;
  #define ROT() do{sl_prev=sl_cur;sl_cur=sl_next;sl_next=(sl_next==(NSLOT-1)*SLOTB)?0:sl_next+SLOTB;}while(0)
  DMA_K(2,2*SLOTB);
  WAIT_BAR(3);
  qkt(pA0,pA1,Kbase,qr,negm,r32,hi);asm volatile("s_nop 15\n\ts_nop 7":"+v"(pA0),"+v"(pA1));KBIAS(pA0,pA1,0);CMASK(pA0,pA1,0);
  START(pA0,pA1);
  _Pragma("unroll") for(int r=0;r<16;++r)pA1[r]=__builtin_amdgcn_exp2f(pA1[r]);
  WAIT_BAR(0);
  DMA_K(3,0);DMA_V(1,SLOTB);
  ROT();
  kload8(kf,kp0+sl_cur);
  WAIT_BAR(2);
  s16x4 vlo[8],vhi[8]; u32x4 pw0,pw1,pw2,pw3;
  #define PKW(P,B) cvtpk_s(P[B],P[B+1])
  #define PAF(k) __builtin_bit_cast(bf16x8,pw##k)
  #define VFR(i) (bf16x8){vlo[i][0],vlo[i][1],vlo[i][2],vlo[i][3],vhi[i][0],vhi[i][1],vhi[i][2],vhi[i][3]}
  #define PIN(x) asm volatile("":"+v"(x))
  #define MX3(a,b,c) __builtin_fmaxf(__builtin_fmaxf((a),(b)),(c))
  #define GAPA(MF,A0,A1,A2,A3,W0,W1,PW) do{ MF; sacc+=A0; sacc+=A1; sacc+=A2; sacc+=A3; PIN(sacc); W0; W1; PIN(PW); SBAR(); }while(0)
  #define EX(v) __builtin_amdgcn_exp2f(v)
  #define GAPB(MF,X,B) do{ MF; X[B]=EX(X[B]); X[B+1]=EX(X[B+1]); X[B+2]=EX(X[B+2]); X[B+3]=EX(X[B+3]); PIN(X); SBAR(); }while(0)
  #define VRD(i) do{ vlo[i]=vtr(vp_+(((i)>>2)*4096+((i)&3)*1024)); vhi[i]=vtr(vp_+(((i)>>2)*4096+((i)&3)*1024+512)); }while(0)
  #define KRD(G,j) do{ if(G){ kload2(kf,kp0+sl_next,j); SBAR(); } }while(0)
  #define STEP(C0,C1,P0,P1,t,GK,GV,GL) do{ SBAR(); \
    const lds_cptr vp_=vp0+sl_prev; \
    VRD(0); SBAR(); float sacc=(P0[0]+P0[1]); \
    GAPA(C0=__builtin_amdgcn_mfma_f32_32x32x16_bf16(kf[0],qr[0],negm,0,0,0), P0[2],P0[3],P0[4],P0[5],     pw0[0]=PKW(P0,0), pw0[1]=PKW(P0,2), pw0); \
    VRD(4); SBAR(); GAPA(C1=__builtin_amdgcn_mfma_f32_32x32x16_bf16(kf[1],qr[0],negm,0,0,0), P0[6],P0[7],P0[8],P0[9],     pw0[2]=PKW(P0,4), pw0[3]=PKW(P0,6), pw0); \
    VRD(1); SBAR(); GAPA(C0=__builtin_amdgcn_mfma_f32_32x32x16_bf16(kf[2],qr[1],C0,0,0,0),   P0[10],P0[11],P0[12],P0[13], pw1[0]=PKW(P0,8), pw1[1]=PKW(P0,10), pw1); \
    VRD(5); SBAR(); GAPA(C1=__builtin_amdgcn_mfma_f32_32x32x16_bf16(kf[3],qr[1],C1,0,0,0),   P0[14],P0[15],P1[0],P1[1],   pw1[2]=PKW(P0,12),pw1[3]=PKW(P0,14), pw1); \
    VRD(2); SBAR(); GAPA(C0=__builtin_amdgcn_mfma_f32_32x32x16_bf16(kf[4],qr[2],C0,0,0,0),   P1[2],P1[3],P1[4],P1[5],     pw2[0]=PKW(P1,0), pw2[1]=PKW(P1,2), pw2); \
    VRD(6); SBAR(); GAPA(C1=__builtin_amdgcn_mfma_f32_32x32x16_bf16(kf[5],qr[2],C1,0,0,0),   P1[6],P1[7],P1[8],P1[9],     pw2[2]=PKW(P1,4), pw2[3]=PKW(P1,6), pw2); \
    VRD(3); SBAR(); GAPA(C0=__builtin_amdgcn_mfma_f32_32x32x16_bf16(kf[6],qr[3],C0,0,0,0),   P1[10],P1[11],P1[12],P1[13], pw3[0]=PKW(P1,8), pw3[1]=PKW(P1,10), pw3); \
    VRD(7); SBAR(); GAPA(C1=__builtin_amdgcn_mfma_f32_32x32x16_bf16(kf[7],qr[3],C1,0,0,0),   P1[14],P1[15],0.f,0.f,       pw3[2]=PKW(P1,12),pw3[3]=PKW(P1,14), pw3); \
    l_reg+=sacc; \
    if(GK){DMA_K((t)+3,sl_cur);} if(GV){DMA_V((t)+1,sl_next);} \
    KBIAS(C0,C1,t); CMASK(C0,C1,t); \
    { float a=MX3(C0[0],C0[1],C1[0]),b=MX3(C0[2],C0[3],C1[1]); a=MX3(a,C1[2],C1[3]); \
      _Pragma("unroll") for(int r=4;r<16;r+=4){a=MX3(a,C0[r],C0[r+1]);b=MX3(b,C0[r+2],C0[r+3]);a=MX3(a,C1[r],C1[r+1]);b=MX3(b,C1[r+2],C1[r+3]);} \
      float rm=__builtin_fmaxf(a,b); { auto rr=__builtin_amdgcn_permlane32_swap(__float_as_uint(rm),__float_as_uint(rm),false,false); rm=__builtin_fmaxf(__uint_as_float(rr[0]),__uint_as_float(rr[1])); } \
      resc=false; \
      if(__builtin_expect(__any(rm>(float)THRL),0)){ const float dl=__builtin_fmaxf(rm,0.f); mhat+=dl; \
        _Pragma("unroll") for(int r=0;r<16;++r){C0[r]-=dl;C1[r]-=dl;} \
        _Pragma("unroll") for(int r=0;r<16;++r)negm[r]=-mhat; asm volatile("":"+v"(negm)); \
        const float f=__builtin_amdgcn_exp2f(-dl); l_reg*=f; if(hi==0)wsf[r32]=f; resc=true; } } \
    SBAR(); \
    GAPB(o[0]=__builtin_amdgcn_mfma_f32_32x32x16_bf16(PAF(0),VFR(0),o[0],0,0,0), C0,0); \
    GAPB(o[1]=__builtin_amdgcn_mfma_f32_32x32x16_bf16(PAF(0),VFR(4),o[1],0,0,0), C0,4); \
    KRD(GL,0); GAPB(o[0]=__builtin_amdgcn_mfma_f32_32x32x16_bf16(PAF(1),VFR(1),o[0],0,0,0), C0,8); \
    KRD(GL,1); GAPB(o[1]=__builtin_amdgcn_mfma_f32_32x32x16_bf16(PAF(1),VFR(5),o[1],0,0,0), C0,12); \
    KRD(GL,2); GAPB(o[0]=__builtin_amdgcn_mfma_f32_32x32x16_bf16(PAF(2),VFR(2),o[0],0,0,0), C1,0); \
    KRD(GL,3); GAPB(o[1]=__builtin_amdgcn_mfma_f32_32x32x16_bf16(PAF(2),VFR(6),o[1],0,0,0), C1,4); \
    GAPB(o[0]=__builtin_amdgcn_mfma_f32_32x32x16_bf16(PAF(3),VFR(3),o[0],0,0,0), C1,8); \
    GAPB(o[1]=__builtin_amdgcn_mfma_f32_32x32x16_bf16(PAF(3),VFR(7),o[1],0,0,0), C1,12); \
    }while(0)
  int t=1;
  #undef CMASK
  #define CMASK(P0,P1,t) do{}while(0)
  for(;t+5<NT;t+=2){
    STEP(pB0,pB1,pA0,pA1,t,true,true,true);     WAIT_BAR(2); RESC(); ROT();
    STEP(pA0,pA1,pB0,pB1,t+1,true,true,true);   WAIT_BAR(2); RESC(); ROT();
  }
  #undef CMASK
  #define CMASK(P0,P1,t) do{int jb_=(t)-(NT-4); if(jb_>=0)cmask(P0,P1,jb_,qrel,hi);}while(0)
  #define ENDW(tt) do{ if((tt)+3<NT){WAIT_BAR(2);} else if((tt)+2<NT){WAIT_BAR(1);} else {WAIT_BAR(0);} }while(0)
  for(;t+1<NT;t+=2){
    STEP(pB0,pB1,pA0,pA1,t,(t+3<NT),(t+1<NT),(t+1<NT));       ENDW(t);   RESC(); ROT();
    STEP(pA0,pA1,pB0,pB1,t+1,(t+4<NT),(t+2<NT),(t+2<NT));     ENDW(t+1); RESC(); ROT();
  }
  STEP(pB0,pB1,pA0,pA1,NT-1,false,false,false); RESC();
  { float sacc=pB0[0]+pB0[1]; _Pragma("unroll") for(int r=2;r<16;++r)sacc+=pB0[r]; _Pragma("unroll") for(int r=0;r<16;++r)sacc+=pB1[r]; l_reg+=sacc;
    pw0=(u32x4){PKW(pB0,0),PKW(pB0,2),PKW(pB0,4),PKW(pB0,6)};pw1=(u32x4){PKW(pB0,8),PKW(pB0,10),PKW(pB0,12),PKW(pB0,14)};pw2=(u32x4){PKW(pB1,0),PKW(pB1,2),PKW(pB1,4),PKW(pB1,6)};pw3=(u32x4){PKW(pB1,8),PKW(pB1,10),PKW(pB1,12),PKW(pB1,14)};
    SBAR(); pv(o,vb0+sl_cur,PAF(0),PAF(1),PAF(2),PAF(3)); }
  #undef PKW
  #undef PAF
  #undef VFR
  #undef PIN
  #undef MX3
  #undef GAPA
  #undef GAPB
  #undef EX
  #undef VRD
  #undef KRD
  #undef STEP
  #undef ENDW
  {auto rr=__builtin_amdgcn_permlane32_swap(__float_as_uint(l_reg),__float_as_uint(l_reg),false,false);l_reg=__uint_as_float(rr[0])+__uint_as_float(rr[1]);}
  if(hi==0)wsf[32+r32]=l_reg;asm volatile("s_waitcnt lgkmcnt(0)":::"memory");
  float rli[16];
  #pragma unroll
  for(int r=0;r<16;++r)rli[r]=__builtin_amdgcn_rcpf(wsf[32+crow(r,hi)]);
  bf16*Ow=O+(rowbase+q0+wid*QBLK)*DM+h*D;
  { bf16*stg=(bf16*)(shm+LDS_OST)+wid*2048;
    #pragma unroll
    for(int r=0;r<16;++r){const int orow=crow(r,hi);
      #pragma unroll
      for(int d0=0;d0<2;++d0)stg[orow*64+d0*32+r32]=__float2bfloat16(o[d0][r]*rli[r]);}
    asm volatile("s_waitcnt lgkmcnt(0)":::"memory");
    #pragma unroll
    for(int i=0;i<4;++i){const int row=i*8+(lane>>3),ch=lane&7; const u32x4 v=*(const u32x4*)(stg+row*64+ch*8); ATTN_STORE16(Ow+(long)row*DM+ch*8,v);} }
  asm volatile("s_waitcnt lgkmcnt(0)\n\ts_barrier":::"memory");
  #undef KBIAS
  #undef DMA_K
  #undef DMA_V
  #undef CMASK
  #undef START
  #undef RESC
  #undef ROT
}
constexpr int ATTN_LDS_BYTES=LDS_BYTES;
struct AttnTensors { const bf16* Q; const bf16* K; const bf16* V; bf16* O; const float* NEGF; };
struct AttnUnit { int bh; int qb; };
struct StaticOrder {
  int c,G;
  __device__ __forceinline__ explicit StaticOrder(int grid,int block):c(block),G(grid){}
  __device__ __forceinline__ bool next(int i,AttnUnit&u)const{ const int bh=c+(i>>3)*G; if(bh>=BATCH*NHEAD)return false; u.bh=bh; u.qb=7-(i&7); return true; }
  __device__ __forceinline__ void a_ready(const AttnUnit&)const{}
  __device__ __forceinline__ void done(const AttnUnit&)const{}
};
template<class Sched,int THRL=8> __device__ __forceinline__ void attn_phase(char*lds,const AttnTensors&T,const Sched&S){
  AttnUnit u;
  for(int i=0;S.next(i,u);++i){ S.a_ready(u); attn_unit<THRL>(u.bh/NHEAD,u.bh%NHEAD,u.qb,T.Q,T.K,T.V,T.O,T.NEGF,lds); S.done(u); }
}
#undef SBAR
#undef WAIT_BAR
}
#define GAS __attribute__((address_space(1)))
#define LAS __attribute__((address_space(3)))
typedef unsigned short bf16;
typedef unsigned v4u __attribute__((ext_vector_type(4)));
typedef float f32x4 __attribute__((ext_vector_type(4)));
typedef short bf16x8 __attribute__((ext_vector_type(8)));
typedef GAS unsigned gu32;
typedef GAS unsigned long long gu64;
#define RLX_AGENT __ATOMIC_RELAXED, __HIP_MEMORY_SCOPE_AGENT
#define LDS_WAIT() asm volatile("s_waitcnt lgkmcnt(0)" ::: "memory")
#define VM_WAIT() asm volatile("s_waitcnt vmcnt(0)" ::: "memory")
__device__ __forceinline__ unsigned long long rt() { return __builtin_amdgcn_s_memrealtime(); }
__device__ __forceinline__ unsigned f2bf(float f) { unsigned u = __builtin_bit_cast(unsigned, f); return (u + 0x7fffu + ((u >> 16) & 1u)) >> 16; }
__device__ __forceinline__ unsigned pk2(float lo, float hi) { return f2bf(lo) | (f2bf(hi) << 16); }

#define XB_TMO      128
#define XB_XCNT(j)  (256  + 64 * (j))
#define XB_XSUB(j)  (1280 + 64 * (j))
#define XB_XGEN(j)  (2304 + 64 * (j))
#define XB_TOP      3328
#define XB_TOPGEN   3392
#define XCD_BAR_WORDS 3456
#define XB_SPIN_CAP (1u << 18)

__device__ __forceinline__ unsigned xb_ld(unsigned* p)              { return __hip_atomic_load(p, __ATOMIC_RELAXED, __HIP_MEMORY_SCOPE_AGENT); }
__device__ __forceinline__ unsigned xb_add(unsigned* p, unsigned v) { return __hip_atomic_fetch_add(p, v, __ATOMIC_RELAXED, __HIP_MEMORY_SCOPE_AGENT); }
__device__ __forceinline__ unsigned xb_xcc_id() { return (unsigned)__builtin_amdgcn_s_getreg((3 << 11) | 20) & 0xFu; }
#define XB_SPIN(cond, bar) do { unsigned _sp = 0; while (cond) { __builtin_amdgcn_s_sleep(1); \
    if ((++_sp & 255u) == 0u) { if (xb_ld(&(bar)[XB_TMO])) break; if (_sp > XB_SPIN_CAP) { atomicAdd(&(bar)[XB_TMO], 1u); break; } } } } while (0)

struct XcdBarrier {
    unsigned* bar; unsigned x;
    volatile LAS unsigned* st;
};

__device__ __forceinline__ XcdBarrier xcd_barrier_post(unsigned* bar, volatile LAS unsigned* st) {
    XcdBarrier b; b.bar = bar; b.x = xb_xcc_id(); b.st = st;
    if (threadIdx.x == 0) (void)xb_add(&bar[XB_XCNT(b.x)], 1u);
    return b;
}
__device__ __forceinline__ void xcd_barrier_complete(unsigned* bar, unsigned x, unsigned& nloc, unsigned& nx) {
    const unsigned G = gridDim.x * gridDim.y * gridDim.z;
    unsigned sum, cnt, mine, sp = 0u;
    for (;;) {
        sum = 0u; cnt = 0u; mine = 0u;
#pragma unroll
        for (unsigned j = 0; j < 16; ++j) { const unsigned c = xb_ld(&bar[XB_XCNT(j)]); sum += c; cnt += (c > 0u) ? 1u : 0u; mine = (j == x) ? c : mine; }
        if (sum == G) break;
        __builtin_amdgcn_s_sleep(1);
        if ((++sp & 255u) == 0u) { if (xb_ld(&bar[XB_TMO])) break; if (sp > XB_SPIN_CAP) { atomicAdd(&bar[XB_TMO], 1u); break; } }
    }
    nloc = mine > 0u ? mine : 1u; nx = cnt > 0u ? cnt : 1u;
}

__device__ __forceinline__ void xcd_barrier(const XcdBarrier& b) {
    asm volatile("s_waitcnt vmcnt(0)" ::: "memory");
    __syncthreads();
    if (threadIdx.x == 0) {
        unsigned* bar = b.bar;
        __builtin_amdgcn_s_waitcnt(0);
        unsigned nloc = b.st[0], nx = b.st[1];
        if (nloc == 0u) { xcd_barrier_complete(bar, b.x, nloc, nx); b.st[0] = nloc; b.st[1] = nx; }
        const unsigned old = xb_add(&bar[XB_XSUB(b.x)], 1u);
        const unsigned gen = old / nloc;
        if (old + 1u == (gen + 1u) * nloc) {
            __builtin_amdgcn_fence(__ATOMIC_RELEASE, "agent");
            asm volatile("s_waitcnt vmcnt(0)" ::: "memory");
            const unsigned og = xb_add(&bar[XB_TOP], 1u);
            const unsigned tg = og / nx;
            if (og + 1u == (tg + 1u) * nx) xb_add(&bar[XB_TOPGEN], 1u);
            else XB_SPIN(xb_ld(&bar[XB_TOPGEN]) == tg, bar);
            __builtin_amdgcn_fence(__ATOMIC_ACQUIRE, "agent");
            xb_add(&bar[XB_XGEN(b.x)], 1u);
            asm volatile("s_waitcnt vmcnt(0)" ::: "memory");
        } else {
            XB_SPIN(xb_ld(&bar[XB_XGEN(b.x)]) == gen, bar);
            __builtin_amdgcn_fence(__ATOMIC_ACQUIRE, "agent");
            asm volatile("s_waitcnt vmcnt(0)" ::: "memory");
        }
    }
    __syncthreads();
}
namespace cg = cooperative_groups;
constexpr int NWAVES = 8;
#ifndef MK_PER_PHASE
#define MK_PER_PHASE 1
#endif
#ifndef MK_USE_CG
#define MK_USE_CG 1
#endif
constexpr int BATCH = 16, T = 2048, D = 1024, FF = 4096, M = BATCH * T;
constexpr size_t MiB = 1u << 20;
constexpr size_t WS_CTL = 0, CTL_ZERO_BYTES = 1 * MiB, WS_SSQA = 1 * MiB, WS_SSQB = 3 * MiB, WS_FLOG = 5 * MiB, WS_NEGF = 7 * MiB, WS_SV = 9 * MiB, WS_W = 10 * MiB,
                 WS_HB = 118 * MiB, WS_PB = 182 * MiB, WS_PP = 246 * MiB, WS_BIG = 310 * MiB, WS_END = 510 * MiB;
constexpr size_t ME = 1u << 20;
constexpr size_t W_S5IN = 0, W_S5GLU = 1 * ME, W_S5OUT = 3 * ME, W_S5STRIDE = 4 * ME, W_FOXIN = 8 * ME, W_FOXOUT = W_FOXIN + 3328 * 1024, W_GLAIN = W_FOXOUT + ME, W_GLAOUT = W_GLAIN + 3328 * 1024,
                 W_MLP1 = W_GLAOUT + ME, W_MLP2 = W_MLP1 + 4 * ME, W_MLPSTRIDE = 8 * ME, W_PLEG = W_MLP1 + 32 * ME, W_PLEP = W_PLEG + ME, W_PLESTRIDE = ME + ME / 4, W_TOTAL = W_PLEG + 4 * W_PLESTRIDE;
static_assert(W_TOTAL * 2 <= 108 * MiB, "weights region");
constexpr int CW_BAR = 4096;
constexpr int RING_OFF = 0, RING_BYTES = 131072, LDSCTL_OFF = RING_BYTES, MISC_OFF = LDSCTL_OFF + 320, LDS_BYTES = 147456;
constexpr float LOG2E = 1.4426950408889634f;
typedef unsigned u32x2g __attribute__((ext_vector_type(2)));

__device__ __forceinline__ float wave_sum(float v) {
#pragma unroll
    for (int o = 1; o < 64; o <<= 1) v += __shfl_xor(v, o);
    return v;
}
__device__ __forceinline__ float sigmoid_f(float x) { return 1.0f / (1.0f + __expf(-x)); }
__device__ __forceinline__ float log_sigmoid_f(float x) { return fminf(x, 0.f) - log1pf(__expf(-fabsf(x))); }
__device__ __forceinline__ float gelu_tanh_f(float x) { const float uu = 0.7978845608028654f * (x + 0.044715f * x * x * x); const float th = 1.0f - 2.0f / (__expf(2.0f * uu) + 1.0f); return 0.5f * x * (1.0f + th); }
__device__ __forceinline__ float bf_lo(unsigned w) { return __uint_as_float(w << 16); }
__device__ __forceinline__ float bf_hi(unsigned w) { return __uint_as_float(w & 0xffff0000u); }

__device__ __forceinline__ void transpose_item(const float* W, int K, int ldw, const float* gain, bf16* WT, int n0, int drow0, int k0, LAS float* scr, int lane) {
#pragma unroll 8
    for (int i = 0; i < 32; ++i) { const int kk = 2 * i + (lane >> 5); float w = W[(size_t)(k0 + kk) * ldw + n0 + (lane & 31)]; if (gain) w *= gain[k0 + kk]; scr[kk * 33 + (lane & 31)] = w; }
    LDS_WAIT(); asm volatile("" ::: "memory");
    const int c = lane & 7;
#pragma unroll
    for (int j = 0; j < 4; ++j) { const int n = (lane >> 3) + 8 * j; const LAS float* s = scr + (8 * c) * 33 + n;
        v4u o; o.x = pk2(s[0 * 33], s[1 * 33]); o.y = pk2(s[2 * 33], s[3 * 33]); o.z = pk2(s[4 * 33], s[5 * 33]); o.w = pk2(s[6 * 33], s[7 * 33]);
        *(GAS v4u*)(WT + (size_t)(drow0 + n) * K + k0 + 8 * c) = o; }
    LDS_WAIT(); asm volatile("" ::: "memory");
}

__device__ __forceinline__ const float* ld_ptr(LAS unsigned long long* t, int i) { const unsigned long long v = t[i];
    const unsigned lo = __builtin_amdgcn_readfirstlane((unsigned)v), hi = __builtin_amdgcn_readfirstlane((unsigned)(v >> 32)); return (const float*)(const GAS float*)(((unsigned long long)hi << 32) | lo); }

__device__ __forceinline__ float reduce16(float (&v)[16], int lane) {
    { const bool hb5 = (lane & 32) != 0;
#pragma unroll
      for (int i = 0; i < 8; ++i) { const float snd = hb5 ? v[i] : v[i + 8], kp = hb5 ? v[i + 8] : v[i]; v[i] = kp + __shfl_xor(snd, 32); } }
    { const bool hb4 = (lane & 16) != 0;
#pragma unroll
      for (int i = 0; i < 4; ++i) { const float snd = hb4 ? v[i] : v[i + 4], kp = hb4 ? v[i + 4] : v[i]; v[i] = kp + __shfl_xor(snd, 16); } }
    { const bool hb3 = (lane & 8) != 0;
#pragma unroll
      for (int i = 0; i < 2; ++i) { const float snd = hb3 ? v[i] : v[i + 2], kp = hb3 ? v[i + 2] : v[i]; v[i] = kp + __shfl_xor(snd, 8); } }
    { const bool hb2 = (lane & 4) != 0; const float snd = hb2 ? v[0] : v[1], kp = hb2 ? v[1] : v[0]; v[0] = kp + __shfl_xor(snd, 4); }
    float tot = v[0]; tot += __shfl_xor(tot, 2); tot += __shfl_xor(tot, 1); return tot;
}
__device__ __forceinline__ void sv_pass(float (&acc)[16], LAS float* inT, const float* in, size_t in_stride, int K, const float* gain, const float* W, int ldw, int col, int tk, int KG, int lane, int wave) {
    for (int k0 = 0; k0 < K; k0 += 1024) {
        const int kc = (K - k0) < 1024 ? (K - k0) : 1024;
        __syncthreads();
        for (int rr = 0; rr < 2; ++rr) { const int r = 2 * wave + rr; const float* src = in + (size_t)r * in_stride + k0;
            f32x4 v[4]; float ss = 0.f;
#pragma unroll
            for (int i = 0; i < 4; ++i) { const int k4 = lane + 64 * i; v[i] = (f32x4){0.f, 0.f, 0.f, 0.f}; if (4 * k4 < kc) v[i] = *(const GAS f32x4*)(src + 4 * k4); ss += (v[i][0] * v[i][0] + v[i][1] * v[i][1]) + (v[i][2] * v[i][2] + v[i][3] * v[i][3]); }
            float sc = 1.f; if (gain) { ss = wave_sum(ss); sc = rsqrtf(ss * (1.0f / 1024.0f) + 1e-6f); }
#pragma unroll
            for (int i = 0; i < 4; ++i) { const int k4 = lane + 64 * i; if (4 * k4 < kc) { f32x4 g = (f32x4){1.f, 1.f, 1.f, 1.f}; if (gain) g = *(const GAS f32x4*)(gain + k0 + 4 * k4);
#pragma unroll
                for (int e = 0; e < 4; ++e) inT[(4 * k4 + e) * 16 + r] = v[i][e] * sc * g[e]; } } }
        __syncthreads();
#pragma unroll 4
        for (int k = tk; k < kc; k += KG) { const float w = W[(size_t)(k0 + k) * ldw + col]; const LAS f32x4* ip = (const LAS f32x4*)(inT + k * 16); const f32x4 a0 = ip[0], a1 = ip[1], a2 = ip[2], a3 = ip[3];
            acc[0] += w * a0[0]; acc[1] += w * a0[1]; acc[2] += w * a0[2]; acc[3] += w * a0[3]; acc[4] += w * a1[0]; acc[5] += w * a1[1]; acc[6] += w * a1[2]; acc[7] += w * a1[3];
            acc[8] += w * a2[0]; acc[9] += w * a2[1]; acc[10] += w * a2[2]; acc[11] += w * a2[3]; acc[12] += w * a3[0]; acc[13] += w * a3[1]; acc[14] += w * a3[2]; acc[15] += w * a3[3]; }
    }
}
__device__ __forceinline__ void sv_stage(LAS unsigned char* ldsl, int mode, int N, const float* in0, size_t st0, int K0, const float* gain0, const float* W0, int ldw0, int c00,
                                         const float* in1, size_t st1, int K1, const float* W1, int ldw1, int c01, const float* res, size_t rst, float* out, int ost, int tid, int lane, int wave, int G) {
    const int cw = N / 256, KG = 512 / cw, tc = tid % cw, tk = tid / cw;
    LAS float* inT = (LAS float*)ldsl; LAS float* red0 = inT + 16384; LAS float* red1 = inT + 24576;
    for (int cb = blockIdx.x; cb < 256; cb += G) { const int n0 = cb * cw;
        float a0[16], a1[16];
#pragma unroll
        for (int r = 0; r < 16; ++r) { a0[r] = 0.f; a1[r] = 0.f; }
        sv_pass(a0, inT, in0, st0, K0, gain0, W0, ldw0, c00 + n0 + tc, tk, KG, lane, wave);
        if (K1 > 0) sv_pass(a1, inT, in1, st1, K1, nullptr, W1, ldw1, c01 + n0 + tc, tk, KG, lane, wave);
        __syncthreads();
#pragma unroll
        for (int r = 0; r < 16; ++r) { red0[tid * 16 + r] = a0[r]; red1[tid * 16 + r] = a1[r]; }
        __syncthreads();
        if (tid < 16 * cw) { const int r = tid / cw, c = tid % cw; float s0 = 0.f, s1 = 0.f;
            for (int g = 0; g < KG; ++g) { s0 += red0[(g * cw + c) * 16 + r]; s1 += red1[(g * cw + c) * 16 + r]; }
            const int n = n0 + c; float o;
            if (mode == 0) o = s0; else if (mode == 1) o = res[(size_t)r * rst + n] + s0; else if (mode == 2) { const float t = fmaxf(s0, 0.f); o = t * t; }
            else if (mode == 3) o = s0 * sigmoid_f(s1); else o = res[(size_t)r * rst + n] + s1 * sigmoid_f(s0);
            out[(size_t)r * ost + n] = o; }
    }
    __syncthreads();
}
struct Args { const float* in[29]; float* out; unsigned char* ws; int ph_lo, ph_hi; };
constexpr int N_PHASES = 38;
enum { T_PROLOGUE = 0, T_INPROJ, T_MIX1, T_MIX2, T_OUTPROJ, T_UP0, T_DOWN0, T_UP1, T_DOWN1, T_PLE, T_FINAL };

__global__ void __launch_bounds__(NWAVES * 64, 2) trunk_fwd(Args args) {
    extern __shared__ __attribute__((aligned(16))) unsigned char lds[];
    LAS unsigned char* const ldsl = (LAS unsigned char*)lds;
    volatile LAS unsigned* MISC = (volatile LAS unsigned*)(ldsl + MISC_OFF);
    const int tid0 = threadIdx.x;
#define tid tid0
    for (int u = tid; u < (LDS_BYTES - LDSCTL_OFF) / 4; u += NWAVES * 64) ((LAS unsigned*)(ldsl + LDSCTL_OFF))[u] = 0u;
    __syncthreads();
    LAS unsigned long long* const ptab = (LAS unsigned long long*)(ldsl + LDSCTL_OFF + 64);
    if (tid == 0) {
#define PT_(i) ptab[i] = (unsigned long long)args.in[i];
        PT_(0) PT_(1) PT_(2) PT_(3) PT_(4) PT_(5) PT_(6) PT_(7) PT_(8) PT_(9) PT_(10) PT_(11) PT_(12) PT_(13) PT_(14) PT_(15) PT_(16) PT_(17) PT_(18) PT_(19) PT_(20) PT_(21) PT_(22) PT_(23) PT_(24) PT_(25) PT_(26) PT_(27) PT_(28)
        ptab[29] = (unsigned long long)args.ws; ptab[30] = (unsigned long long)args.out;
#undef PT_
    }
    __syncthreads();
#define INP(i) ld_ptr(ptab, (i))
#define ws ((unsigned char*)ld_ptr(ptab, 29))
#define h ((float*)ld_ptr(ptab, 30))
#define Wb ((bf16*)(ws + WS_W))
#define HB ((bf16*)(ws + WS_HB))
#define PB ((bf16*)(ws + WS_PB))
#define PP ((bf16*)(ws + WS_PP))
#define BIG ((bf16*)(ws + WS_BIG))
#define FLOG ((float*)(ws + WS_FLOG))
#define NEGF ((float*)(ws + WS_NEGF))
#if !MK_PER_PHASE
    cg::grid_group grid = cg::this_grid();
#if !MK_USE_CG
    XcdBarrier bar = xcd_barrier_post((unsigned*)(ws + WS_CTL) + CW_BAR, MISC + 8);
#endif
#endif
    (void)MISC;

#undef tid
    for (int ph = args.ph_lo; ph < args.ph_hi; ++ph) {
        int tid = tid0; asm volatile("" : "+v"(tid));
        const int lane = tid & 63, wave = __builtin_amdgcn_readfirstlane(tid >> 6);
        const int G = gridDim.x, gw = blockIdx.x * NWAVES + wave, NGW = G * NWAVES, gtid = blockIdx.x * (NWAVES * 64) + tid, NT = G * NWAVES * 64;
        int type, layer = 0;
        if (ph == 0) type = T_PROLOGUE; else if (ph >= 37) type = T_FINAL; else { layer = (ph - 1) / 9; type = T_INPROJ + (ph - 1) % 9; }
        const int mixer = layer % 3, jm = layer / 3;
#define SSQ_(k) ((float*)(ws + (((3 * layer + (k)) & 1) ? WS_SSQB : WS_SSQA)))
#define ssq0 SSQ_(0)
#define ssq1 SSQ_(1)
#define ssq2 SSQ_(2)
#define ssq3 SSQ_(3)


        { const int sk = ph - 1;
          if (sk >= 0 && sk < 12) {
            float* const SVH0 = (float*)(ws + WS_SV); float* const SVH1 = SVH0 + 16384; float* const SVA = SVH0 + 32768; float* const SVB = SVH0 + 98304;
            const size_t XS = (size_t)T * D, PS = (size_t)T * 256;
            if (sk == 0) sv_stage(ldsl, 0, 1024, INP(0), XS, 1024, INP(2), INP(5), 1024, 0, nullptr, 0, 0, nullptr, 0, 0, nullptr, 0, SVA, 1024, tid, lane, wave, G);
            else if (sk == 1) {
                for (int item = gw; item < 1024; item += NGW) { const int b = item >> 6, g = item & 63, n = lane; const size_t gn = (size_t)g * 64 + n;
                    const float dt = expf(INP(8)[g]), lr = INP(6)[gn], li = INP(7)[gn];
                    const float mag = expf(lr * dt), are = mag * cosf(li * dt), aim = mag * sinf(li * dt), den = lr * lr + li * li, nr = are - 1.0f;
                    const float cre = (nr * lr + aim * li) / den, cim = (aim * lr - nr * li) / den;
                    float xre = 0.f, xim = 0.f; const float* uu = SVA + b * 1024 + g * 16;
#pragma unroll
                    for (int c = 0; c < 16; ++c) { const float br = INP(9)[gn * 16 + c], bi = INP(10)[gn * 16 + c]; xre += (cre * br - cim * bi) * uu[c]; xim += (cre * bi + cim * br) * uu[c]; }
                    float v[16];
#pragma unroll
                    for (int c = 0; c < 16; ++c) { const size_t ci = (size_t)g * 1024 + c * 64 + n; v[c] = INP(11)[ci] * xre - INP(12)[ci] * xim; }
                    const float tot = reduce16(v, lane);
                    const int ch = ((lane >> 5) & 1) * 8 + ((lane >> 4) & 1) * 4 + ((lane >> 3) & 1) * 2 + ((lane >> 2) & 1);
                    if ((lane & 3) == 0) SVB[b * 1024 + g * 16 + ch] = gelu_tanh_f(tot + INP(13)[g * 16 + ch] * uu[ch]); } }
            else if (sk == 2) sv_stage(ldsl, 3, 1024, SVB, 1024, 1024, nullptr, INP(14), 2048, 0, SVB, 1024, 1024, INP(14), 2048, 1024, nullptr, 0, SVA, 1024, tid, lane, wave, G);
            else if (sk == 3) sv_stage(ldsl, 1, 1024, SVA, 1024, 1024, nullptr, INP(15), 1024, 0, nullptr, 0, 0, nullptr, 0, 0, INP(0), XS, SVH1, 1024, tid, lane, wave, G);
            else if (sk == 4 || sk == 9) { const int L = (sk == 9); sv_stage(ldsl, 2, 4096, L ? SVH0 : SVH1, 1024, 1024, INP(3) + L * 1024, INP(24) + (size_t)L * 4 * ME, 4096, 0, nullptr, 0, 0, nullptr, 0, 0, nullptr, 0, SVA, 4096, tid, lane, wave, G); }
            else if (sk == 5 || sk == 10) { const int L = (sk == 10); sv_stage(ldsl, 1, 1024, SVA, 4096, 4096, nullptr, INP(25) + (size_t)L * 4 * ME, 1024, 0, nullptr, 0, 0, nullptr, 0, 0, L ? SVH0 : SVH1, 1024, L ? SVH1 : SVH0, 1024, tid, lane, wave, G); }
            else if (sk == 6 || sk == 11) { const int L = (sk == 11); const float* hin = L ? SVH1 : SVH0;
                sv_stage(ldsl, 4, 1024, hin, 1024, 1024, INP(4) + L * 1024, INP(27) + (size_t)L * ME, 1024, 0, INP(1) + (size_t)L * M * 256, PS, 256, INP(26) + (size_t)L * (ME / 4), 1024, 0, hin, 1024, L ? SVH0 : SVH1, 1024, tid, lane, wave, G); }
            else if (sk == 7) sv_stage(ldsl, 0, 1024, SVH1, 1024, 1024, INP(2) + 1024, INP(16), 3088, 2048, nullptr, 0, 0, nullptr, 0, 0, nullptr, 0, SVA, 1024, tid, lane, wave, G);
            else if (sk == 8) sv_stage(ldsl, 1, 1024, SVA, 1024, 1024, nullptr, INP(18), 1024, 0, nullptr, 0, 0, nullptr, 0, 0, SVH1, 1024, SVH0, 1024, tid, lane, wave, G);
          } }
        if (type == T_PROLOGUE) {
            LAS float* scr = (LAS float*)(ldsl + RING_OFF + wave * 16384);
            for (int mi = 0; mi < 26; ++mi) {
                const float* src; int K = 1024, ldw = 1024, ncols = 1024, glu = 0; const float* gain = nullptr; bf16* dst;
                if (mi < 6) { const int j = mi / 3, w = mi % 3;
                    if (w == 0) { src = INP(5) + (size_t)j * ME; gain = INP(2) + (size_t)(3 * j) * 1024; dst = Wb + W_S5IN + j * W_S5STRIDE; }
                    else if (w == 1) { src = INP(14) + (size_t)j * 2 * ME; ldw = 2048; ncols = 2048; glu = 1; dst = Wb + W_S5GLU + j * W_S5STRIDE; }
                    else { src = INP(15) + (size_t)j * ME; dst = Wb + W_S5OUT + j * W_S5STRIDE; } }
                else if (mi == 6) { src = INP(16); ldw = 3088; ncols = 3072; gain = INP(2) + 1 * 1024; dst = Wb + W_FOXIN; }
                else if (mi == 7) { src = INP(18); dst = Wb + W_FOXOUT; }
                else if (mi == 8) { src = INP(19); ldw = 3088; ncols = 3072; gain = INP(2) + 2 * 1024; dst = Wb + W_GLAIN; }
                else if (mi == 9) { src = INP(23); dst = Wb + W_GLAOUT; }
                else if (mi < 14) { const int i = mi - 10; src = INP(24) + (size_t)i * 4 * ME; ldw = 4096; ncols = 4096; gain = INP(3) + (size_t)i * 1024; dst = Wb + W_MLP1 + i * W_MLPSTRIDE; }
                else if (mi < 18) { const int i = mi - 14; src = INP(25) + (size_t)i * 4 * ME; K = 4096; dst = Wb + W_MLP2 + i * W_MLPSTRIDE; }
                else if (mi < 22) { const int i = mi - 18; src = INP(27) + (size_t)i * ME; gain = INP(4) + (size_t)i * 1024; dst = Wb + W_PLEG + i * W_PLESTRIDE; }
                else { const int i = mi - 22; src = INP(26) + (size_t)i * (ME / 4); K = 256; dst = Wb + W_PLEP + i * W_PLESTRIDE; }
                const int nblk = ncols / 32, items = (K / 64) * nblk;
                for (int it = gw; it < items; it += NGW) { const int kb = it / nblk, nb = it % nblk, n0 = 32 * nb; int drow0 = n0;
                    if (glu) { const int c = n0 & 1023; drow0 = 256 * (c >> 7) + (c & 127) + ((n0 >= 1024) ? 128 : 0); }
                    transpose_item(src, K, ldw, gain, dst, n0, drow0, 64 * kb, scr, lane); }
                if (mi == 6 || mi == 8) {
                    for (int idx = gtid; idx < 256 * 1024; idx += NT) { const int n = 3072 + (idx >> 10), k = idx & 1023;
                        const float v = (n < 3088) ? src[(size_t)k * 3088 + n] * gain[k] : 0.f; dst[(size_t)n * 1024 + k] = (bf16)f2bf(v); } }
            }
            float* ssqA = (float*)(ws + WS_SSQA);
            for (int m = gw; m < M; m += NGW) {
                const GAS f32x4* xr = (const GAS f32x4*)(INP(0) + (size_t)m * D) + lane; f32x4 v[4]; float s = 0.f;
#pragma unroll
                for (int j = 0; j < 4; ++j) { v[j] = xr[64 * j]; s += (v[j].x * v[j].x + v[j].y * v[j].y) + (v[j].z * v[j].z + v[j].w * v[j].w); }
                s = wave_sum(s);
                GAS unsigned long long* o8 = (GAS unsigned long long*)(HB + (size_t)m * D) + lane;
#pragma unroll
                for (int j = 0; j < 4; ++j) o8[64 * j] = (unsigned long long)pk2(v[j].x, v[j].y) | ((unsigned long long)pk2(v[j].z, v[j].w) << 32);
                if (lane < 16) ssqA[(size_t)m * 16 + lane] = (lane == 0) ? s : 0.f;
            }
        }
        else if (type == T_MIX1 && mixer == 0) {
            if (wave < 4) {
                LAS float* ub = (LAS float*)(ldsl + wave * 4096);
                const bf16* U = BIG; bf16* Y = BIG + (size_t)64 * ME / 2 * 1;
                for (int pair = blockIdx.x * 4 + wave; pair < 1024; pair += G * 4) {
                    const int b = pair >> 6, g = pair & 63, n = lane;
                    const size_t gn = (size_t)jm * 4096 + g * 64 + n;
                    const float dt = expf(INP(8)[jm * 64 + g]), lr = INP(6)[gn], li = INP(7)[gn];
                    const float mag = expf(lr * dt), are = mag * cosf(li * dt), aim = mag * sinf(li * dt), den = lr * lr + li * li, nr = are - 1.0f;
                    const float cre = (nr * lr + aim * li) / den, cim = (aim * lr - nr * li) / den;
                    float Bre[16], Bim[16], Cre[16], Cim[16];
#pragma unroll
                    for (int c = 0; c < 16; ++c) { const float br = INP(9)[gn * 16 + c], bi = INP(10)[gn * 16 + c];
                        Bre[c] = cre * br - cim * bi; Bim[c] = cre * bi + cim * br;
                        const size_t ci = ((size_t)jm * 64 + g) * 1024 + c * 64 + n; Cre[c] = INP(11)[ci]; Cim[c] = INP(12)[ci]; }
                    const int ch = ((lane >> 5) & 1) * 8 + ((lane >> 4) & 1) * 4 + ((lane >> 3) & 1) * 2 + ((lane >> 2) & 1);
                    const float dsk = INP(13)[jm * 1024 + g * 16 + ch];
                    float sre = 0.f, sim = 0.f;
                    const bf16* up = U + (size_t)(b * T) * D + g * 16;
                    v4u r0 = *(const GAS v4u*)(up + (size_t)lane * D), r1 = *(const GAS v4u*)(up + (size_t)lane * D + 8);
                    for (int blk = 0; blk < 32; ++blk) {
                        { LAS f32x4* w = (LAS f32x4*)(ub + lane * 16);
                          w[0] = (f32x4){bf_lo(r0.x), bf_hi(r0.x), bf_lo(r0.y), bf_hi(r0.y)}; w[1] = (f32x4){bf_lo(r0.z), bf_hi(r0.z), bf_lo(r0.w), bf_hi(r0.w)};
                          w[2] = (f32x4){bf_lo(r1.x), bf_hi(r1.x), bf_lo(r1.y), bf_hi(r1.y)}; w[3] = (f32x4){bf_lo(r1.z), bf_hi(r1.z), bf_lo(r1.w), bf_hi(r1.w)}; }
                        if (blk + 1 < 32) { const bf16* nx = up + (size_t)((blk + 1) * 64 + lane) * D; r0 = *(const GAS v4u*)nx; r1 = *(const GAS v4u*)(nx + 8); }
                        for (int s = 0; s < 64; ++s) {
                            const LAS f32x4* ur = (const LAS f32x4*)(ub + s * 16); const f32x4 u0 = ur[0], u1 = ur[1], u2 = ur[2], u3 = ur[3];
                            const float uu[16] = {u0[0], u0[1], u0[2], u0[3], u1[0], u1[1], u1[2], u1[3], u2[0], u2[1], u2[2], u2[3], u3[0], u3[1], u3[2], u3[3]};
                            float xre = 0.f, xim = 0.f;
#pragma unroll
                            for (int c = 0; c < 16; ++c) { xre += Bre[c] * uu[c]; xim += Bim[c] * uu[c]; }
                            const float nre = are * sre - aim * sim + xre, nim = are * sim + aim * sre + xim; sre = nre; sim = nim;
                            float v[16];
#pragma unroll
                            for (int c = 0; c < 16; ++c) v[c] = Cre[c] * sre - Cim[c] * sim;
                            const float tot = reduce16(v, lane);
                            if ((lane & 3) == 0) { const float y = tot + dsk * ub[s * 16 + ch];
                                Y[(size_t)(b * T + blk * 64 + s) * D + g * 16 + ch] = (bf16)f2bf(gelu_tanh_f(y)); }
                        }
                    }
                }
            }
        }
        else if (type == T_MIX1 && mixer == 1) {
            if (wave == 0) {
                for (int pair = blockIdx.x; pair < 256; pair += G) { const int b = pair >> 4, hh = pair & 15; const float bf = INP(17)[jm * 16 + hh];
                    float c[32]; float run = 0.f;
#pragma unroll
                    for (int i = 0; i < 32; ++i) { const float x = FLOG[(size_t)(b * T + 32 * lane + i) * 16 + hh] + bf; run += log_sigmoid_f(x); c[i] = run; }
                    float incl = run;
#pragma unroll
                    for (int o = 1; o < 64; o <<= 1) { const float nb = __shfl_up(incl, o); if (lane >= o) incl += nb; }
                    const float excl = incl - run;
#pragma unroll
                    for (int i = 0; i < 32; ++i) NEGF[(size_t)pair * T + 32 * lane + i] = -(c[i] + excl) * LOG2E;
                }
            }
        }
        else if (type == T_MIX2 && mixer == 1) {
            const attn_body::AttnTensors AT{(const attn_body::bf16*)BIG, (const attn_body::bf16*)(BIG + 32 * ME), (const attn_body::bf16*)(BIG + 64 * ME), (attn_body::bf16*)BIG, NEGF};
            const attn_body::StaticOrder S((int)G, (int)blockIdx.x);
            attn_body::attn_phase<attn_body::StaticOrder>((char*)lds + RING_OFF, AT, S);
        }
        else if (type == T_MIX1 && mixer == 2) {
            LAS float* qs = (LAS float*)ldsl; LAS float* ks = qs + 4096; LAS float* as_ = qs + 8192; LAS float* vs_ = qs + 12288; LAS float* ob = qs + 14336; LAS float* wg = qs + 16384; LAS float* bgs = qs + 18432; LAS float* pq = qs + 18560;
            const bf16* QKV = BIG; bf16* OB = PB;
            for (int unit = blockIdx.x; unit < 256; unit += G) {
                const int b = unit >> 4, hh = (unit >> 2) & 3, vsp = unit & 3;
                __syncthreads();
                for (int i = tid; i < 2048; i += 512) wg[i] = INP(20)[(size_t)jm * 16 * 512 + (i >> 7) * 512 + hh * 128 + (i & 127)];
                if (tid < 128) bgs[tid] = INP(21)[jm * 512 + hh * 128 + tid];
                { const float* hr = (const float*)(ws + WS_SV) + b * 1024; const float* Wg = INP(19); const float* gn2 = INP(2) + 2 * 1024;
                  const int cc = tid & 255, kh = tid >> 8, col = (cc < 128) ? hh * 128 + cc : 512 + hh * 128 + (cc - 128);
                  float acc = 0.f;
#pragma unroll 8
                  for (int k = kh * 512; k < kh * 512 + 512; ++k) acc += hr[k] * gn2[k] * Wg[(size_t)k * 3088 + col];
                  ob[tid] = acc; { const float h0 = hr[tid], h1 = hr[tid + 512]; const float sq = wave_sum(h0 * h0 + h1 * h1); if (lane == 0) ob[512 + wave] = sq; }
                  __syncthreads();
                  if (tid < 256) { float sq = 0.f;
#pragma unroll
                      for (int w8 = 0; w8 < 8; ++w8) sq += ob[512 + w8];
                      pq[tid] = (ob[tid] + ob[tid + 256]) * rsqrtf(sq * (1.0f / 1024.0f) + 1e-6f); } }
                float S[16];
#pragma unroll
                for (int i = 0; i < 16; ++i) S[i] = 0.f;
                const int vl = lane & 7, kg = lane >> 3, vcol = wave * 8 + vl;
                for (int c = 0; c < 64; ++c) {
                    __syncthreads();
                    { const int s = tid >> 4, kk8 = (tid & 15) * 8; const size_t m = (size_t)b * T + c * 32 + s; const bf16* rowp = QKV + m * 3072;
                      const v4u qw = *(const GAS v4u*)(rowp + hh * 128 + kk8), kw = *(const GAS v4u*)(rowp + 512 + hh * 128 + kk8);
                      const u32x2g vw = *(const GAS u32x2g*)(rowp + 1024 + hh * 256 + vsp * 64 + (tid & 15) * 4);
                      const f32x4 g0 = *(const GAS f32x4*)(FLOG + m * 16), g1 = *(const GAS f32x4*)(FLOG + m * 16 + 4), g2 = *(const GAS f32x4*)(FLOG + m * 16 + 8), g3 = *(const GAS f32x4*)(FLOG + m * 16 + 12);
                      const float gl[16] = {g0[0], g0[1], g0[2], g0[3], g1[0], g1[1], g1[2], g1[3], g2[0], g2[1], g2[2], g2[3], g3[0], g3[1], g3[2], g3[3]};
                      LAS f32x4* qd = (LAS f32x4*)(qs + s * 128 + kk8); qd[0] = (f32x4){bf_lo(qw.x), bf_hi(qw.x), bf_lo(qw.y), bf_hi(qw.y)}; qd[1] = (f32x4){bf_lo(qw.z), bf_hi(qw.z), bf_lo(qw.w), bf_hi(qw.w)};
                      LAS f32x4* kd = (LAS f32x4*)(ks + s * 128 + kk8); kd[0] = (f32x4){bf_lo(kw.x), bf_hi(kw.x), bf_lo(kw.y), bf_hi(kw.y)}; kd[1] = (f32x4){bf_lo(kw.z), bf_hi(kw.z), bf_lo(kw.w), bf_hi(kw.w)};
                      *(LAS f32x4*)(vs_ + s * 64 + (tid & 15) * 4) = (f32x4){bf_lo(vw.x), bf_hi(vw.x), bf_lo(vw.y), bf_hi(vw.y)};
                      float av[8];
#pragma unroll
                      for (int e = 0; e < 8; ++e) av[e] = bgs[kk8 + e];
#pragma unroll
                      for (int j = 0; j < 16; ++j) { const LAS f32x4* wr4 = (const LAS f32x4*)(wg + j * 128 + kk8); const f32x4 w0 = wr4[0], w1 = wr4[1];
                          av[0] += gl[j] * w0[0]; av[1] += gl[j] * w0[1]; av[2] += gl[j] * w0[2]; av[3] += gl[j] * w0[3]; av[4] += gl[j] * w1[0]; av[5] += gl[j] * w1[1]; av[6] += gl[j] * w1[2]; av[7] += gl[j] * w1[3]; }
#pragma unroll
                      for (int e = 0; e < 8; ++e) av[e] = __expf(log_sigmoid_f(av[e]) * (1.0f / 16.0f));
                      LAS f32x4* ad = (LAS f32x4*)(as_ + s * 128 + kk8); ad[0] = (f32x4){av[0], av[1], av[2], av[3]}; ad[1] = (f32x4){av[4], av[5], av[6], av[7]};
                      if (c == 0 && tid < 16) {
#pragma unroll
                          for (int e = 0; e < 8; ++e) { qs[kk8 + e] = pq[kk8 + e]; ks[kk8 + e] = pq[128 + kk8 + e]; } } }
                    __syncthreads();
                    for (int s = 0; s < 32; ++s) {
                        const LAS f32x4* q4 = (const LAS f32x4*)(qs + s * 128 + kg * 16); const LAS f32x4* k4 = (const LAS f32x4*)(ks + s * 128 + kg * 16); const LAS f32x4* a4 = (const LAS f32x4*)(as_ + s * 128 + kg * 16);
                        const float vv = vs_[s * 64 + vcol]; float po = 0.f;
#pragma unroll
                        for (int i4 = 0; i4 < 4; ++i4) { const f32x4 qq = q4[i4], kk = k4[i4], aa = a4[i4];
#pragma unroll
                            for (int e = 0; e < 4; ++e) { const float sn = aa[e] * S[4 * i4 + e] + kk[e] * vv; S[4 * i4 + e] = sn; po += qq[e] * sn; } }
                        po += __shfl_xor(po, 8); po += __shfl_xor(po, 16); po += __shfl_xor(po, 32);
                        if (kg == 0) ob[s * 64 + vcol] = po * 0.08838834764831845f;
                    }
                    __syncthreads();
                    { const int s = tid >> 4, v4 = (tid & 15) * 4; const f32x4 o = *(const LAS f32x4*)(ob + s * 64 + v4); u32x2g w; w.x = pk2(o[0], o[1]); w.y = pk2(o[2], o[3]);
                      *(GAS u32x2g*)(OB + ((size_t)b * T + c * 32 + s) * D + hh * 256 + vsp * 64 + v4) = w; }
                }
            }
        }
        else if (type == T_MIX2 && mixer == 2) {
            const bf16* OB = PB; const bf16* R = BIG + 2048; bf16* AO = PP;
            for (int it = gw; it < M * 4; it += NGW) { const size_t m = (size_t)(it >> 2); const int hh = it & 3, col = hh * 256 + 4 * lane;
                const u32x2g ow = *(const GAS u32x2g*)(OB + m * D + col), rw = *(const GAS u32x2g*)(R + m * 3072 + col);
                const f32x4 gn = *(const GAS f32x4*)(INP(22) + jm * 1024 + col);
                const float o0 = bf_lo(ow.x), o1 = bf_hi(ow.x), o2 = bf_lo(ow.y), o3 = bf_hi(ow.y);
                const float ss = wave_sum((o0 * o0 + o1 * o1) + (o2 * o2 + o3 * o3)); const float rn = rsqrtf(ss * (1.0f / 256.0f) + 1e-6f);
                const float r0 = bf_lo(rw.x), r1 = bf_hi(rw.x), r2 = bf_lo(rw.y), r3 = bf_hi(rw.y);
                u32x2g w; w.x = pk2(o0 * rn * gn[0] * r0 * sigmoid_f(r0), o1 * rn * gn[1] * r1 * sigmoid_f(r1)); w.y = pk2(o2 * rn * gn[2] * r2 * sigmoid_f(r2), o3 * rn * gn[3] * r3 * sigmoid_f(r3));
                *(GAS u32x2g*)(AO + m * D + col) = w; }
        }
        else if (type == T_UP0) {
            const float* P = INP(1) + (size_t)layer * M * 256;
            for (size_t idx = (size_t)gtid * 8; idx < (size_t)M * 256; idx += (size_t)NT * 8) { const f32x4 a = *(const GAS f32x4*)(P + idx), b2 = *(const GAS f32x4*)(P + idx + 4);
                v4u o; o.x = pk2(a[0], a[1]); o.y = pk2(a[2], a[3]); o.z = pk2(b2[0], b2[1]); o.w = pk2(b2[2], b2[3]); *(GAS v4u*)(PB + idx) = o; }
        }
        else if (type == T_FINAL) {
            const float* ssq = (const float*)(ws + WS_SSQA);
            const GAS f32x4* gf = (const GAS f32x4*)INP(28) + lane; const f32x4 g0 = gf[0], g1 = gf[64], g2 = gf[128], g3 = gf[192];
            for (int m = gw; m < M; m += NGW) { GAS f32x4* hr = (GAS f32x4*)(h + (size_t)m * D) + lane;
                const float s = wave_sum(lane < 16 ? ssq[(size_t)m * 16 + lane] : 0.f); const float rs = rsqrtf(s * (1.0f / 1024.0f) + 1e-6f);
                const f32x4 v0 = hr[0], v1 = hr[64], v2 = hr[128], v3 = hr[192];
                hr[0] = v0 * rs * g0; hr[64] = v1 * rs * g1; hr[128] = v2 * rs * g2; hr[192] = v3 * rs * g3; }
        }

        for (int job = 0; job < 2; ++job) {
            int kind = -1;
            pg8::Gemm g{nullptr, nullptr, M, D, D};
            pg8::bf16_t* aO = nullptr; int aldc = D; const float* assq = nullptr; int asplit = 0; size_t astride = 0; float ascale = 1.f; float* aft = nullptr; int afc = 1 << 30;
            const float* rbase = h; float* rout = h; pg8::bf16_t* rhb = HB; const float* rssi = nullptr; float* rsso = nullptr;
            if (job == 0) {
                if (type == T_INPROJ) { kind = 0; g.A = HB; assq = ssq0;
                    if (mixer == 0) { g.Bt = Wb + W_S5IN + jm * W_S5STRIDE; g.N = 1024; aO = BIG; aldc = 1024; }
                    else if (mixer == 1) { g.Bt = Wb + W_FOXIN; g.N = 3328; aO = BIG; aldc = 1024; asplit = 1024; astride = 32 * ME; ascale = attn_body::C2; aft = FLOG; afc = 3072; }
                    else { g.Bt = Wb + W_GLAIN; g.N = 3328; aO = BIG; aldc = 3072; aft = FLOG; afc = 3072; } }
                else if (type == T_MIX2 && mixer == 0) { kind = 2; g.A = BIG + 32 * ME; g.Bt = Wb + W_S5GLU + jm * W_S5STRIDE; g.N = 2048; aO = BIG + 64 * ME; aldc = 1024; }
                else if (type == T_OUTPROJ) { kind = 3; g.A = (mixer == 0) ? BIG + 64 * ME : (mixer == 1) ? BIG : PP; g.Bt = Wb + ((mixer == 0) ? W_S5OUT + jm * W_S5STRIDE : (mixer == 1) ? W_FOXOUT : W_GLAOUT);
                    rbase = (layer == 0) ? INP(0) : h; rsso = ssq1; }
                else if (type == T_UP0 || type == T_UP1) { const int hf = (type == T_UP1); kind = 1; g.A = HB + (size_t)hf * 16 * ME; g.Bt = Wb + W_MLP1 + layer * W_MLPSTRIDE; g.M = M / 2; g.N = FF;
                    aO = BIG; aldc = FF; assq = ssq1 + (size_t)hf * (M / 2) * 16; }
                else if (type == T_DOWN0 || type == T_DOWN1) { const int hf = (type == T_DOWN1); kind = 3; g.A = BIG; g.Bt = Wb + W_MLP2 + layer * W_MLPSTRIDE; g.M = M / 2; g.K = FF;
                    rbase = h + (size_t)hf * 16 * ME; rout = h + (size_t)hf * 16 * ME; rhb = HB + (size_t)hf * 16 * ME; rsso = ssq2 + (size_t)hf * (M / 2) * 16; }
                else if (type == T_PLE) { kind = 4; g.A = HB; g.Bt = Wb + W_PLEG + layer * W_PLESTRIDE; rssi = ssq2; rsso = ssq3; }
            } else {
                if (type == T_DOWN0) { kind = 0; g.A = PB; g.Bt = Wb + W_PLEP + layer * W_PLESTRIDE; g.K = 256; aO = PP; aldc = 1024; }
            }
            if (kind < 0) continue;
            pg8::StaticOrder S; S.init(g.M, g.N, G, (int)blockIdx.x);
            if (kind == 0) { pg8::EpiAct<0> E{aO, aldc, assq, asplit, astride, ascale, aft, afc}; pg8::gemm_phase<pg8::EpiAct<0>, pg8::StaticOrder, true, true>(ldsl + RING_OFF, g, S, E); }
            else if (kind == 1) { pg8::EpiAct<1> E{aO, aldc, assq, 0, 0, 1.f, nullptr, 1 << 30}; pg8::gemm_phase<pg8::EpiAct<1>, pg8::StaticOrder, true, true>(ldsl + RING_OFF, g, S, E); }
            else if (kind == 2) { pg8::EpiAct<2> E{aO, aldc, nullptr, 0, 0, 1.f, nullptr, 1 << 30}; pg8::gemm_phase<pg8::EpiAct<2>, pg8::StaticOrder, true, true>(ldsl + RING_OFF, g, S, E); }
            else if (kind == 3) { pg8::EpiRes<0> E{rbase, rout, rhb, nullptr, rsso, nullptr, D}; pg8::gemm_phase<pg8::EpiRes<0>, pg8::StaticOrder, true, true>(ldsl + RING_OFF, g, S, E); }
            else { pg8::EpiRes<1> E{rbase, rout, rhb, rssi, rsso, PP, D}; pg8::gemm_phase<pg8::EpiRes<1>, pg8::StaticOrder, true, true>(ldsl + RING_OFF, g, S, E); }
        }

        if (ph + 1 < args.ph_hi) {
#if !MK_PER_PHASE
#if MK_USE_CG
            grid.sync();
#else
            if (ph == args.ph_lo) grid.sync(); else xcd_barrier(bar);
#endif
#endif
        }
    }
}

#undef ws
#undef h
#undef Wb
#undef HB
#undef PB
#undef PP
#undef BIG
#undef FLOG
#undef NEGF
#undef ssq0
#undef ssq1
#undef ssq2
#undef ssq3
extern "C" void kernel_launch(void* const* d_in, const int* in_sizes, int n_in, void* d_out, int out_size, void* d_ws, size_t ws_size, hipStream_t stream) {
    static int grid = 0;
    if (grid == 0) {
        if (n_in != 29 || in_sizes[0] != M * D || out_size != M * D || ws_size < WS_END) { fprintf(stderr, "kernel_launch: unexpected shapes: n_in %d in0 %d out %d ws %zu (need %zu)\n", n_in, n_in > 0 ? in_sizes[0] : -1, out_size, ws_size, (size_t)WS_END); grid = -1; return; }
        int dev = 0, cus = 0, per_cu = 0;
        if (hipGetDevice(&dev) != hipSuccess || hipDeviceGetAttribute(&cus, hipDeviceAttributeMultiprocessorCount, dev) != hipSuccess) { grid = -1; return; }
        if (hipFuncSetAttribute((const void*)trunk_fwd, hipFuncAttributeMaxDynamicSharedMemorySize, LDS_BYTES) != hipSuccess) { fprintf(stderr, "kernel_launch: hipFuncSetAttribute failed\n"); grid = -1; return; }
        if (hipOccupancyMaxActiveBlocksPerMultiprocessor(&per_cu, (const void*)trunk_fwd, NWAVES * 64, LDS_BYTES) != hipSuccess || per_cu < 1) { fprintf(stderr, "kernel_launch: occupancy query says %d\n", per_cu); per_cu = 1; }
        (void)hipGetLastError();
        grid = cus;
    }
    if (grid < 0) return;
    (void)hipMemsetAsync((char*)d_ws + WS_CTL, 0, CTL_ZERO_BYTES, stream);
    Args a{};
    for (int i = 0; i < 29; ++i) a.in[i] = (const float*)d_in[i];
    a.out = (float*)d_out; a.ws = (unsigned char*)d_ws;
#if MK_PER_PHASE
    for (int ph = 0; ph < N_PHASES; ++ph) { a.ph_lo = ph; a.ph_hi = ph + 1; hipLaunchKernelGGL(trunk_fwd, dim3(grid), dim3(NWAVES * 64), LDS_BYTES, stream, a); }
#else
    a.ph_lo = 0; a.ph_hi = N_PHASES;
    void* kargs[] = {&a};
    hipError_t e = hipLaunchCooperativeKernel((const void*)trunk_fwd, dim3(grid), dim3(NWAVES * 64), kargs, LDS_BYTES, stream);
    if (e != hipSuccess) fprintf(stderr, "kernel_launch: cooperative launch failed: %s (grid %d)\n", hipGetErrorString(e), grid);
#endif
}
```

```cpp
#include <hip/hip_runtime.h>
#include <hip/hip_cooperative_groups.h>
#include <cstdio>
#include <cstdint>
#include <hip/hip_bf16.h>
#include <cmath>
namespace pg8 {
#define PG8_LAS __attribute__((address_space(3)))
typedef unsigned short bf16_t;
typedef short bf16x8 __attribute__((ext_vector_type(8)));
typedef float f32x4 __attribute__((ext_vector_type(4)));
typedef unsigned u32x4 __attribute__((ext_vector_type(4)));
constexpr int BM = 256, BK = 64, HALF = 128, HTB = HALF * BK * 2  , STAGE_BYTES = 8 * HTB, NXCD = 8, WGM = 8;

__host__ __device__ __forceinline__ int lds_byte(int r, int c) { const int st = (r >> 4) * 2 + (c >> 5), rr = r & 15, cc = c & 31, ob = rr * 64 + cc * 2; return st * 1024 + (ob ^ (((ob >> 9) & 1) << 5)); }
__host__ __device__ __forceinline__ void stage_rc(int b, int& R, int& C) { const int st = b / 1024, sb = b % 1024, swz = sb ^ (((sb >> 9) & 1) << 5); R = (st >> 1) * 16 + swz / 64; C = (st & 1) * 32 + (swz % 64) / 2; }
__host__ __device__ __forceinline__ int perm32(int rho) { const int n = rho >> 4, i = rho & 15; return 8 * (i >> 2) + 4 * n + (i & 3); }

struct Unit { int pm, pn; };
struct Gemm { const bf16_t* A; const bf16_t* Bt; int M, N, K; };

struct StaticOrder {
    int nM, nN, nwg, G, c;
    __host__ __device__ void init(int M, int N, int G_, int c_) { nM = M / BM; nN = N / BM; nwg = nM * nN; G = G_; c = c_; }
    __host__ __device__ bool next(int i, Unit& u) const {
        const long L = (long)i * G + c; if (L >= nwg) return false;
        int wgid = (int)L; { const int q = nwg / NXCD, r = nwg % NXCD, xcd = wgid % NXCD, off = wgid / NXCD; wgid = (xcd < r ? xcd * (q + 1) : r * (q + 1) + (xcd - r) * q) + off; }
        const int nig = WGM * nN, gid = wgid / nig, fm = gid * WGM, gsz = (nM - fm) < WGM ? (nM - fm) : WGM;
        u.pm = fm + ((wgid % nig) % gsz); u.pn = (wgid % nig) / gsz; return true;
    }
    __device__ __forceinline__ void a_ready(const Unit&) const {}
    __device__ __forceinline__ void done(const Unit&) const {}
};

__device__ __forceinline__ unsigned cvt_pk_bf16(float lo, float hi) { unsigned r; asm volatile("v_cvt_pk_bf16_f32 %0, %1, %2" : "=v"(r) : "v"(lo), "v"(hi)); return r; }
typedef float f32x2 __attribute__((ext_vector_type(2)));
typedef unsigned u32x2 __attribute__((ext_vector_type(2)));
__device__ __forceinline__ float sigm(float x) { return 1.0f / (1.0f + __expf(-x)); }
__device__ __forceinline__ float row_rstd(const float* ssq, size_t row) {
    const f32x4* s = (const f32x4*)(ssq + row * 16); const f32x4 a = (s[0] + s[1]) + (s[2] + s[3]);
    return rsqrtf(((a[0] + a[1]) + (a[2] + a[3])) * (1.0f / 1024.0f) + 1e-6f);
}
template <int MODE> struct EpiAct {
    static constexpr bool PERM = true, AFTER_DRAIN = false;
    bf16_t* O; int ldc; const float* ssq; int split_cols; size_t split_stride; float scale0; float* ftile; int fcol0;
    __device__ __forceinline__ void operator()(const f32x4 (&acc)[2][2][4][2], const Unit& u, int wr, int wc, int fr, int fq) const {
        const int row0 = u.pm * BM + wr * 64 + fr; int colt = u.pn * BM; bf16_t* base = O;
        float rs[2][4];
#pragma unroll
        for (int ai = 0; ai < 2; ++ai)
#pragma unroll
            for (int m = 0; m < 4; ++m) rs[ai][m] = ssq ? row_rstd(ssq, (size_t)(row0 + ai * HALF + m * 16)) : 1.0f;
        if (MODE == 0 && ftile != nullptr && colt >= fcol0) {
            if (wc == 0 && fq < 2) {
#pragma unroll
                for (int ai = 0; ai < 2; ++ai)
#pragma unroll
                    for (int m = 0; m < 4; ++m) { float* dst = ftile + (size_t)(row0 + ai * HALF + m * 16) * 16 + 8 * fq;
                        *(f32x4*)dst = acc[ai][0][m][0] * rs[ai][m]; *(f32x4*)(dst + 4) = acc[ai][0][m][1] * rs[ai][m]; }
            }
            return;
        }
        if (MODE == 2) {
            const int col0 = u.pn * HALF + wc * 32 + 8 * fq;
#pragma unroll
            for (int ai = 0; ai < 2; ++ai)
#pragma unroll
                for (int m = 0; m < 4; ++m) { bf16_t* rowp = base + (size_t)(row0 + ai * HALF + m * 16) * ldc + col0;
                    const f32x4 a0 = acc[ai][0][m][0], a1 = acc[ai][0][m][1], g0 = acc[ai][1][m][0], g1 = acc[ai][1][m][1];
                    u32x4 w; w.x = cvt_pk_bf16(a0[0] * sigm(g0[0]), a0[1] * sigm(g0[1])); w.y = cvt_pk_bf16(a0[2] * sigm(g0[2]), a0[3] * sigm(g0[3]));
                    w.z = cvt_pk_bf16(a1[0] * sigm(g1[0]), a1[1] * sigm(g1[1])); w.w = cvt_pk_bf16(a1[2] * sigm(g1[2]), a1[3] * sigm(g1[3]));
                    *(u32x4*)rowp = w; }
            return;
        }
        float sc = 1.f; if (split_cols) { const int t = colt / split_cols; base += (size_t)t * split_stride; colt -= t * split_cols; if (t == 0) sc = scale0; }
        const int col0 = colt + wc * 32 + 8 * fq;
#pragma unroll
        for (int ai = 0; ai < 2; ++ai)
#pragma unroll
            for (int m = 0; m < 4; ++m) { bf16_t* rowp = base + (size_t)(row0 + ai * HALF + m * 16) * ldc + col0; const float s = rs[ai][m] * sc;
#pragma unroll
                for (int bj = 0; bj < 2; ++bj) { f32x4 v0 = acc[ai][bj][m][0] * s, v1 = acc[ai][bj][m][1] * s;
                    if (MODE == 1) {
#pragma unroll
                        for (int e = 0; e < 4; ++e) { const float a = fmaxf(v0[e], 0.f), b = fmaxf(v1[e], 0.f); v0[e] = a * a; v1[e] = b * b; } }
                    u32x4 w; w.x = cvt_pk_bf16(v0[0], v0[1]); w.y = cvt_pk_bf16(v0[2], v0[3]); w.z = cvt_pk_bf16(v1[0], v1[1]); w.w = cvt_pk_bf16(v1[2], v1[3]);
                    *(u32x4*)(rowp + bj * HALF) = w; } }
    }
};
#ifndef MK_BF16_RES
#define MK_BF16_RES 1
#endif
template <int MODE> struct EpiRes {
    static constexpr bool PERM = true, AFTER_DRAIN = false;
    const bf16_t* baseb; bf16_t* hb; const float* ssq_in; float* ssq_out; const bf16_t* pp; int ldc;
    __device__ __forceinline__ void operator()(const f32x4 (&acc)[2][2][4][2], const Unit& u, int wr, int wc, int fr, int fq) const {
        const int col0 = u.pn * BM + wc * 32 + 8 * fq;
        constexpr int MB = (MODE == 1) ? 2 : 4;
#pragma unroll
        for (int ai = 0; ai < 2; ++ai)
#pragma unroll
            for (int m0 = 0; m0 < 4; m0 += MB) {
                u32x4 pre[MB][2]; u32x4 ppw[MB][2]; float rs[MB];
#pragma unroll
                for (int mm = 0; mm < MB; ++mm) { const int r = u.pm * BM + ai * HALF + wr * 64 + (m0 + mm) * 16 + fr; const size_t off = (size_t)r * ldc + col0;
                    rs[mm] = 1.f; if (MODE == 1) rs[mm] = row_rstd(ssq_in, (size_t)r);
#pragma unroll
                    for (int bj = 0; bj < 2; ++bj) { pre[mm][bj] = *(const u32x4*)(baseb + off + bj * HALF); if (MODE == 1) ppw[mm][bj] = *(const u32x4*)(pp + off + bj * HALF); } }
#pragma unroll
                for (int mm = 0; mm < MB; ++mm) { const int m = m0 + mm; const int r = u.pm * BM + ai * HALF + wr * 64 + m * 16 + fr; const size_t off = (size_t)r * ldc + col0;
                    float q = 0.f;
#pragma unroll
                    for (int bj = 0; bj < 2; ++bj) { const size_t o2 = off + bj * HALF; f32x4 v[2];
#pragma unroll
                        for (int n = 0; n < 2; ++n) { const unsigned b0 = n ? pre[mm][bj].z : pre[mm][bj].x, b1 = n ? pre[mm][bj].w : pre[mm][bj].y;
                            const f32x4 b = (f32x4){__uint_as_float(b0 << 16), __uint_as_float(b0 & 0xffff0000u), __uint_as_float(b1 << 16), __uint_as_float(b1 & 0xffff0000u)}; const f32x4 a = acc[ai][bj][m][n];
                            if (MODE == 1) { const unsigned w0 = n ? ppw[mm][bj].z : ppw[mm][bj].x, w1 = n ? ppw[mm][bj].w : ppw[mm][bj].y;
                                const float p0 = __uint_as_float(w0 << 16), p1 = __uint_as_float(w0 & 0xffff0000u), p2 = __uint_as_float(w1 << 16), p3 = __uint_as_float(w1 & 0xffff0000u);
                                v[n][0] = b[0] + p0 * sigm(a[0] * rs[mm]); v[n][1] = b[1] + p1 * sigm(a[1] * rs[mm]); v[n][2] = b[2] + p2 * sigm(a[2] * rs[mm]); v[n][3] = b[3] + p3 * sigm(a[3] * rs[mm]); }
                            else v[n] = b + a; }
                        u32x4 w; w.x = cvt_pk_bf16(v[0][0], v[0][1]); w.y = cvt_pk_bf16(v[0][2], v[0][3]); w.z = cvt_pk_bf16(v[1][0], v[1][1]); w.w = cvt_pk_bf16(v[1][2], v[1][3]); *(u32x4*)(hb + o2) = w;
                        const float r0 = __uint_as_float(w.x << 16), r1 = __uint_as_float(w.x & 0xffff0000u), r2 = __uint_as_float(w.y << 16), r3 = __uint_as_float(w.y & 0xffff0000u);
                        const float r4 = __uint_as_float(w.z << 16), r5 = __uint_as_float(w.z & 0xffff0000u), r6 = __uint_as_float(w.w << 16), r7 = __uint_as_float(w.w & 0xffff0000u);
                        q += ((r0 * r0 + r1 * r1) + (r2 * r2 + r3 * r3)) + ((r4 * r4 + r5 * r5) + (r6 * r6 + r7 * r7)); }
                    q += __shfl_xor(q, 16); q += __shfl_xor(q, 32);
                    if (fq == 0) ssq_out[(size_t)r * 16 + u.pn * 4 + wc] = q; }
                asm volatile("" ::: "memory"); }
    }
};
template <class Epi, class Sched, bool ALIGN_EPI = false, bool SP2 = false>
__device__ __forceinline__ void gemm_phase(PG8_LAS unsigned char* lds, const Gemm g, const Sched& S, const Epi& E) {
    int tid_ = threadIdx.x; asm volatile("" : "+v"(tid_)); const int tid = tid_, wid = __builtin_amdgcn_readfirstlane(tid >> 6), lane = tid & 63, wr = wid >> 2, wc = wid & 3, fr = lane & 15, fq = lane >> 4;
    const int K = g.K, nt = K / BK;
    unsigned voffA[2], voffB[2];
#pragma unroll
    for (int i = 0; i < 2; ++i) { int R, C; stage_rc(tid * 16 + i * 8192, R, C); const int Rb = Epi::PERM ? ((R & ~31) + perm32(R & 31)) : R;
        voffA[i] = (unsigned)(R * K + C) * 2u; voffB[i] = (unsigned)(Rb * K + C) * 2u; }
    const size_t kstep = (size_t)(BK * 2);
    const size_t hstep = (size_t)HALF * K * 2;
    const size_t tstep = 2 * hstep;
    const unsigned ldsw = (unsigned)wid * 1024u;
    const int aoff = lds_byte(wr * 64 + fr, fq * 8), boff = lds_byte(wc * 32 + fr, fq * 8);
#define PG8_SA(b, h) (((b) * 2 + (h)) * HTB)
#define PG8_SB(b, h) ((4 + (b) * 2 + (h)) * HTB)
#define PG8_STAGE(bufoff, gbase, voff) do { _Pragma("unroll") for (int _i = 0; _i < 2; ++_i) \
        __builtin_amdgcn_global_load_lds((const unsigned*)((const char*)(gbase) + (voff)[_i]), (PG8_LAS unsigned*)(lds + (bufoff) + ldsw + _i * 8192), 16, 0, 0); } while (0)
#define PG8_LDA(dst, b, h) do { _Pragma("unroll") for (int m = 0; m < 4; ++m) _Pragma("unroll") for (int k = 0; k < 2; ++k) dst[m][k] = *(const PG8_LAS bf16x8*)(lds + PG8_SA(b, h) + aoff + m * 2048 + k * 1024); } while (0)
#define PG8_LDB(dst, b, h) do { _Pragma("unroll") for (int n = 0; n < 2; ++n) _Pragma("unroll") for (int k = 0; k < 2; ++k) dst[n][k] = *(const PG8_LAS bf16x8*)(lds + PG8_SB(b, h) + boff + n * 2048 + k * 1024); } while (0)
#define PG8_MMA(ai, bj, At, Bt) do { __builtin_amdgcn_s_setprio(1); _Pragma("unroll") for (int m = 0; m < 4; ++m) _Pragma("unroll") for (int n = 0; n < 2; ++n) _Pragma("unroll") for (int k = 0; k < 2; ++k) \
        acc[ai][bj][m][n] = __builtin_amdgcn_mfma_f32_16x16x32_bf16(Bt[n][k], At[m][k], acc[ai][bj][m][n], 0, 0, 0); __builtin_amdgcn_s_setprio(0); } while (0)
#define PG8_WAIT_V(n) asm volatile("s_waitcnt vmcnt(" #n ")" ::: "memory")
#define PG8_WAIT_L(n) asm volatile("s_waitcnt lgkmcnt(" #n ")" ::: "memory")
#define PG8_BAR __builtin_amdgcn_s_barrier()
#define PG8_SCHED __builtin_amdgcn_sched_barrier(0)
    Unit cur, nxt; int ui = 0;
    if (!S.next(0, cur)) return;
    f32x4 acc[2][2][4][2];
#pragma unroll
    for (int a = 0; a < 2; ++a)
#pragma unroll
        for (int b = 0; b < 2; ++b)
#pragma unroll
            for (int m = 0; m < 4; ++m)
#pragma unroll
                for (int n = 0; n < 2; ++n) acc[a][b][m][n] = (f32x4){0.f, 0.f, 0.f, 0.f};
    bf16x8 At[4][2], B0[2][2], B1[2][2];
    const char* cA = (const char*)g.A + (size_t)cur.pm * tstep; const char* cB = (const char*)g.Bt + (size_t)cur.pn * tstep;
    S.a_ready(cur);
    if constexpr (SP2) {
        PG8_STAGE(PG8_SB(0, 0), cB, voffB); PG8_STAGE(PG8_SB(0, 1), cB + hstep, voffB); PG8_STAGE(PG8_SA(0, 0), cA, voffA); PG8_STAGE(PG8_SA(0, 1), cA + hstep, voffA);
        if (wr == 1) PG8_BAR;
        PG8_WAIT_V(2); PG8_BAR;
        PG8_STAGE(PG8_SB(1, 0), cB + kstep, voffB); PG8_STAGE(PG8_SA(1, 0), cA + kstep, voffA); PG8_STAGE(PG8_SB(1, 1), cB + hstep + kstep, voffB);
        PG8_WAIT_V(6); PG8_BAR;
    } else {
        PG8_STAGE(PG8_SB(0, 0), cB, voffB); PG8_STAGE(PG8_SA(0, 0), cA, voffA); PG8_STAGE(PG8_SB(0, 1), cB + hstep, voffB); PG8_STAGE(PG8_SA(0, 1), cA + hstep, voffA);
        if (wr == 1) PG8_BAR;
        PG8_WAIT_V(4); PG8_BAR;
        PG8_STAGE(PG8_SB(1, 0), cB + kstep, voffB); PG8_STAGE(PG8_SA(1, 0), cA + kstep, voffA); PG8_STAGE(PG8_SB(1, 1), cB + hstep + kstep, voffB);
        PG8_WAIT_V(6); PG8_BAR;
    }
    for (;;) {
        const bool has_next = S.next(ui + 1, nxt);
        const char* nA = has_next ? (const char*)g.A + (size_t)nxt.pm * tstep : cA; const char* nB = has_next ? (const char*)g.Bt + (size_t)nxt.pn * tstep : cB;
        for (int t = 0; t < nt; t += 2) {
            const bool last = (t == nt - 2);
            const char* a1 = cA + (size_t)(t + 1) * kstep;
            const char* a2 = last ? nA : cA + (size_t)(t + 2) * kstep; const char* b2 = last ? nB : cB + (size_t)(t + 2) * kstep;
            const char* a3 = a2 + kstep; const char* b3 = b2 + kstep;
            if (last && has_next) S.a_ready(nxt);
            if constexpr (SP2) {
            PG8_LDB(B0, 0, 0); PG8_LDB(B1, 0, 1); PG8_SCHED; PG8_LDA(At, 0, 0); PG8_STAGE(PG8_SA(1, 1), a1 + hstep, voffA);
            PG8_WAIT_V(8); PG8_WAIT_L(0); PG8_BAR; PG8_MMA(0, 0, At, B0); PG8_MMA(0, 1, At, B1); PG8_BAR; PG8_SCHED;
            PG8_LDA(At, 0, 1); PG8_STAGE(PG8_SB(0, 0), b2, voffB); PG8_STAGE(PG8_SB(0, 1), b2 + hstep, voffB); PG8_STAGE(PG8_SA(0, 0), a2, voffA);
            PG8_WAIT_V(8); PG8_WAIT_L(0); PG8_BAR; PG8_MMA(1, 0, At, B0); PG8_MMA(1, 1, At, B1); PG8_BAR; PG8_SCHED;
            PG8_LDB(B0, 1, 0); PG8_LDB(B1, 1, 1); PG8_SCHED; PG8_LDA(At, 1, 0); PG8_STAGE(PG8_SA(0, 1), a2 + hstep, voffA);
            PG8_WAIT_V(8); PG8_WAIT_L(0); PG8_BAR; PG8_MMA(0, 0, At, B0); PG8_MMA(0, 1, At, B1); PG8_BAR; PG8_SCHED;
            PG8_LDA(At, 1, 1); PG8_STAGE(PG8_SB(1, 0), b3, voffB); PG8_STAGE(PG8_SB(1, 1), b3 + hstep, voffB); PG8_STAGE(PG8_SA(1, 0), a3, voffA);
            PG8_WAIT_V(8); PG8_WAIT_L(0); PG8_BAR; PG8_MMA(1, 0, At, B0); PG8_MMA(1, 1, At, B1); PG8_BAR; PG8_SCHED;
            } else {
            PG8_LDB(B0, 0, 0); PG8_SCHED; PG8_LDA(At, 0, 0); PG8_STAGE(PG8_SA(1, 1), a1 + hstep, voffA);
            PG8_WAIT_L(8); PG8_BAR; PG8_WAIT_L(0); PG8_MMA(0, 0, At, B0); PG8_BAR; PG8_SCHED;
            PG8_LDB(B1, 0, 1); PG8_STAGE(PG8_SB(0, 0), b2, voffB);
            PG8_BAR; PG8_WAIT_L(0); PG8_MMA(0, 1, At, B1); PG8_BAR;
            PG8_LDA(At, 0, 1); PG8_STAGE(PG8_SA(0, 0), a2, voffA);
            PG8_BAR; PG8_WAIT_L(0); PG8_MMA(1, 0, At, B0); PG8_BAR; PG8_SCHED;
            PG8_STAGE(PG8_SB(0, 1), b2 + hstep, voffB);
            PG8_WAIT_V(6); PG8_BAR; PG8_MMA(1, 1, At, B1); PG8_BAR;
            PG8_LDB(B0, 1, 0); PG8_SCHED; PG8_LDA(At, 1, 0); PG8_STAGE(PG8_SA(0, 1), a2 + hstep, voffA);
            PG8_WAIT_L(8); PG8_BAR; PG8_WAIT_L(0); PG8_MMA(0, 0, At, B0); PG8_BAR; PG8_SCHED;
            PG8_LDB(B1, 1, 1); PG8_STAGE(PG8_SB(1, 0), b3, voffB);
            PG8_BAR; PG8_WAIT_L(0); PG8_MMA(0, 1, At, B1); PG8_BAR;
            PG8_LDA(At, 1, 1); PG8_STAGE(PG8_SA(1, 0), a3, voffA);
            PG8_BAR; PG8_WAIT_L(0); PG8_MMA(1, 0, At, B0); PG8_BAR; PG8_SCHED;
            PG8_STAGE(PG8_SB(1, 1), b3 + hstep, voffB);
            PG8_WAIT_V(6); PG8_BAR; PG8_MMA(1, 1, At, B1); PG8_BAR;
            }
        }
        if constexpr (ALIGN_EPI) { if (wr == 0) PG8_BAR; }
        if constexpr (!Epi::AFTER_DRAIN) { E(acc, cur, wr, wc, fr, fq); S.done(cur); }
        if (!has_next) break;
#pragma unroll
        for (int a = 0; a < 2; ++a)
#pragma unroll
            for (int b = 0; b < 2; ++b)
#pragma unroll
                for (int m = 0; m < 4; ++m)
#pragma unroll
                    for (int n = 0; n < 2; ++n) acc[a][b][m][n] = (f32x4){0.f, 0.f, 0.f, 0.f};
        cur = nxt; cA = nA; cB = nB; ++ui;
        if constexpr (ALIGN_EPI) { if (wr == 1) PG8_BAR; }
    }
    PG8_WAIT_V(0);
    if constexpr (!ALIGN_EPI) { if (wr == 0) PG8_BAR; }
    PG8_BAR;
    if constexpr (Epi::AFTER_DRAIN) { E.fused(acc, cur, wr, wc, fr, fq, lds, wid, lane); S.done(cur); }
#undef PG8_SA
#undef PG8_SB
#undef PG8_STAGE
#undef PG8_LDA
#undef PG8_LDB
#undef PG8_MMA
#undef PG8_WAIT_V
#undef PG8_WAIT_L
#undef PG8_BAR
#undef PG8_SCHED
}
}
#include <hip/hip_bf16.h>
#include <cmath>
namespace attn_body {
using bf16=__hip_bfloat16;
using bf16x8=__attribute__((ext_vector_type(8)))short;
using s16x4=__attribute__((ext_vector_type(4)))short;
using f32x16=__attribute__((ext_vector_type(16)))float;
using u32x4=__attribute__((ext_vector_type(4)))unsigned;
constexpr int BATCH=16,NHEAD=16,SEQ=2048,D=64,DM=NHEAD*D;
constexpr int NW=8,QBLK=32,QB=QBLK*NW,KVBLK=64,NQB=SEQ/QB;
constexpr int ATTN_PITCH=DM, ATTN_UNIT_ROWS=QB;
__device__ __forceinline__ int crow(int r,int hi){return (r&3)+8*(r>>2)+4*hi;}
#define SBAR() __builtin_amdgcn_sched_barrier(0)
__device__ __forceinline__ void cmask(f32x16&p0,f32x16&p1,int jb,int qrel,int hi){
  const float NEG=-INFINITY; int kb=64*jb+4*hi;
  #pragma unroll
  for(int r=0;r<16;++r){int kv=kb+(r&3)+8*(r>>2); if(kv>qrel)p0[r]=NEG; if(kv+32>qrel)p1[r]=NEG;}
}

constexpr int NSLOT=3, SLOTB=8192;
constexpr int LDS_K=0, LDS_V=NSLOT*SLOTB, LDS_WS=2*NSLOT*SLOTB, LDS_OST=LDS_WS+NW*64*4, LDS_BIAS=LDS_OST+NW*4096, LDS_BYTES=LDS_BIAS+SEQ*4;
constexpr float C2=0.125f*1.4426950408889634f;
__device__ __forceinline__ void glds16(const void*gsrc,unsigned lds_dst){unsigned keep;
  asm volatile("s_mov_b32 %0, m0\n\ts_mov_b32 m0, %2\n\ts_nop 0\n\tglobal_load_lds_dwordx4 %1, off\n\ts_mov_b32 m0, %0":"=&s"(keep):"v"(gsrc),"s"(lds_dst):"memory");}
__device__ __forceinline__ float max3f(float a,float b,float c){float r;asm("v_max3_f32 %0, %1, %2, %3":"=v"(r):"v"(a),"v"(b),"v"(c));return r;}
__device__ __forceinline__ float max2f(float a,float b){float r;asm("v_max_f32_e32 %0, %1, %2":"=v"(r):"v"(a),"v"(b));return r;}
__device__ __forceinline__ float fadd_s(float a,float b){float r;asm("v_add_f32_e32 %0, %1, %2":"=v"(r):"v"(a),"v"(b));return r;}
__device__ __forceinline__ float fsub_s(float a,float b){float r;asm("v_sub_f32_e32 %0, %1, %2":"=v"(r):"v"(a),"v"(b));return r;}
typedef float f32x2_t __attribute__((ext_vector_type(2))); typedef __bf16 bf16x2_t __attribute__((ext_vector_type(2)));
__device__ __forceinline__ unsigned cvtpk_s(float lo,float hi){f32x2_t v={lo,hi};bf16x2_t b=__builtin_convertvector(v,bf16x2_t);return __builtin_bit_cast(unsigned,b);}
#define WAIT_BAR(N) asm volatile("s_waitcnt vmcnt(" #N ") lgkmcnt(0)\n\ts_barrier":::"memory")

__device__ __forceinline__ void qkt(f32x16&p0,f32x16&p1,const char*Kslot,const bf16x8*qr,const f32x16&negm,int r32,int hi){
  const char*kb=Kslot+hi*1024+r32*16;
  #pragma unroll
  for(int d0=0;d0<4;++d0){
    const bf16x8 b0=*reinterpret_cast<const bf16x8*>(kb+d0*2048);
    const bf16x8 b1=*reinterpret_cast<const bf16x8*>(kb+d0*2048+512);
    if(d0==0){p0=__builtin_amdgcn_mfma_f32_32x32x16_bf16(b0,qr[0],negm,0,0,0);p1=__builtin_amdgcn_mfma_f32_32x32x16_bf16(b1,qr[0],negm,0,0,0);}
    else{p0=__builtin_amdgcn_mfma_f32_32x32x16_bf16(b0,qr[d0],p0,0,0,0);p1=__builtin_amdgcn_mfma_f32_32x32x16_bf16(b1,qr[d0],p1,0,0,0);}}
}
typedef __attribute__((address_space(3))) const char* lds_cptr;
typedef short v4i16_t __attribute__((ext_vector_type(4)));
__device__ __forceinline__ void kload8(bf16x8*kf,lds_cptr kp){
  kf[0]=*(const __attribute__((address_space(3))) bf16x8*)(kp);      kf[1]=*(const __attribute__((address_space(3))) bf16x8*)(kp+512);
  kf[2]=*(const __attribute__((address_space(3))) bf16x8*)(kp+2048); kf[3]=*(const __attribute__((address_space(3))) bf16x8*)(kp+2560);
  kf[4]=*(const __attribute__((address_space(3))) bf16x8*)(kp+4096); kf[5]=*(const __attribute__((address_space(3))) bf16x8*)(kp+4608);
  kf[6]=*(const __attribute__((address_space(3))) bf16x8*)(kp+6144); kf[7]=*(const __attribute__((address_space(3))) bf16x8*)(kp+6656);
}
__device__ __forceinline__ void kload2(bf16x8*kf,lds_cptr kp,int j){ kf[2*j]=*(const __attribute__((address_space(3))) bf16x8*)(kp+j*2048); kf[2*j+1]=*(const __attribute__((address_space(3))) bf16x8*)(kp+j*2048+512); }
__device__ __forceinline__ s16x4 vtr(lds_cptr p){ return __builtin_bit_cast(s16x4,__builtin_amdgcn_ds_read_tr16_b64_v4i16((__attribute__((address_space(3))) v4i16_t*)p)); }
__device__ __forceinline__ float rowmax(const f32x16&p0,const f32x16&p1){
  float a=max3f(p0[0],p0[1],p1[0]),b=max3f(p0[2],p0[3],p1[1]);a=max3f(a,p1[2],p1[3]);
  #pragma unroll
  for(int r=4;r<16;r+=4){a=max3f(a,p0[r],p0[r+1]);b=max3f(b,p0[r+2],p0[r+3]);a=max3f(a,p1[r],p1[r+1]);b=max3f(b,p1[r+2],p1[r+3]);}
  const float m=max2f(a,b);
  auto rr=__builtin_amdgcn_permlane32_swap(__float_as_uint(m),__float_as_uint(m),false,false);
  return max2f(__uint_as_float(rr[0]),__uint_as_float(rr[1]));
}
__device__ __forceinline__ void pv(f32x16*o,int vb,bf16x8 pa0,bf16x8 pa1,bf16x8 pa2,bf16x8 pa3){
  #pragma unroll
  for(int d0=0;d0<2;++d0){s16x4 lo[4],hi[4];
    #pragma unroll
    for(int ks=0;ks<4;++ks){
      asm volatile("ds_read_b64_tr_b16 %0,%1 offset:%c2":"=&v"(lo[ks]):"v"(vb),"i"(d0*4096+ks*1024):"memory");
      asm volatile("ds_read_b64_tr_b16 %0,%1 offset:%c2":"=&v"(hi[ks]):"v"(vb),"i"(d0*4096+ks*1024+512):"memory");}
    asm volatile("s_waitcnt lgkmcnt(0)":::"memory");SBAR();
    #define PK(k) (bf16x8){lo[k][0],lo[k][1],lo[k][2],lo[k][3],hi[k][0],hi[k][1],hi[k][2],hi[k][3]}
    o[d0]=__builtin_amdgcn_mfma_f32_32x32x16_bf16(pa0,PK(0),o[d0],0,0,0);
    o[d0]=__builtin_amdgcn_mfma_f32_32x32x16_bf16(pa1,PK(1),o[d0],0,0,0);
    o[d0]=__builtin_amdgcn_mfma_f32_32x32x16_bf16(pa2,PK(2),o[d0],0,0,0);
    o[d0]=__builtin_amdgcn_mfma_f32_32x32x16_bf16(pa3,PK(3),o[d0],0,0,0);
    #undef PK
  }
}

#ifndef ATTN_STORE16
#define ATTN_STORE16(p,v) (*(u32x4*)(p)=(v))
#endif
typedef float f32x4_t __attribute__((ext_vector_type(4)));
template<int THRL> __device__ __forceinline__ void attn_unit(int b,int h,int qb,const bf16*Q,const bf16*__restrict__ K,const bf16*__restrict__ V,bf16*O,const float*NEGF,char*shm){
  int tid_=threadIdx.x; asm volatile("":"+v"(tid_)); const int tid=tid_,lane=tid&63,r32=lane&31,hi=lane>>5; const int wid=__builtin_amdgcn_readfirstlane(tid>>6);
  const long rowbase=(long)b*SEQ; const int q0=qb*QB;
  const bf16*Qw=Q+(rowbase+q0+wid*QBLK)*DM+h*D;
  const bf16*Kh=K+rowbase*DM+h*D,*Vh=V+rowbase*DM+h*D;
  const unsigned lds0=(unsigned)(uintptr_t)shm;
  float*wsf=(float*)(shm+LDS_WS)+wid*64;
  const bf16*ksrc=Kh+(long)lane*DM+wid*8;
  const bf16*vsrc=Vh+(long)(16*(wid&3)+(lane>>2))*DM+(wid>>2)*32+(lane&3)*8;
  const unsigned kdst=lds0+LDS_K+wid*1024, vdst=lds0+LDS_V+wid*1024;
  #define DMA_K(t,slot) glds16(ksrc+(long)(t)*KVBLK*DM,(unsigned)__builtin_amdgcn_readfirstlane(kdst+(slot)))
  #define DMA_V(t,slot) glds16(vsrc+(long)(t)*KVBLK*DM,(unsigned)__builtin_amdgcn_readfirstlane(vdst+(slot)))
  const int vb0=(int)(lds0+LDS_V)+((lane>>4)&1)*32+(lane&3)*8+(4*hi+((lane&15)>>2))*64;
  const char*Kbase=shm+LDS_K; bf16x8 kf[8];
  const lds_cptr shm3=(lds_cptr)shm; const lds_cptr kp0=shm3+LDS_K+hi*1024+r32*16; const lds_cptr vp0=shm3+LDS_V+((lane>>4)&1)*32+(lane&3)*8+(4*hi+((lane&15)>>2))*64;
  const int NT=(q0+QB)/KVBLK;
  { const f32x4_t bv_=*(const f32x4_t*)(NEGF+(long)(b*NHEAD+h)*SEQ+tid*4); *(__attribute__((address_space(3))) f32x4_t*)((__attribute__((address_space(3))) char*)shm+LDS_BIAS+tid*16)=bv_; }
  #define KBIAS(P0,P1,t) do{ const lds_cptr bq_=shm3+LDS_BIAS+((t)*64+4*hi)*4; \
    _Pragma("unroll") for(int j_=0;j_<4;++j_){ { const f32x4_t x0_=*(const __attribute__((address_space(3))) f32x4_t*)(bq_+32*j_); \
      P0[4*j_]+=x0_[0]-mhat;P0[4*j_+1]+=x0_[1]-mhat;P0[4*j_+2]+=x0_[2]-mhat;P0[4*j_+3]+=x0_[3]-mhat; } \
      { const f32x4_t x1_=*(const __attribute__((address_space(3))) f32x4_t*)(bq_+32*j_+128); \
      P1[4*j_]+=x1_[0]-mhat;P1[4*j_+1]+=x1_[1]-mhat;P1[4*j_+2]+=x1_[2]-mhat;P1[4*j_+3]+=x1_[3]-mhat; } } }while(0)
  DMA_K(0,0);DMA_V(0,0);DMA_K(1,SLOTB);
  bf16x8 qr[4];
  #pragma unroll
  for(int d0=0;d0<4;++d0)qr[d0]=*reinterpret_cast<const bf16x8*>(&Qw[(long)r32*DM+d0*16+hi*8]);
  float mhat=0.f,l_reg=0.f;f32x16 o[2];o[0]=f32x16{};o[1]=f32x16{};const f32x16 negm=f32x16{};
  const int qrel=wid*QBLK+r32;
  #define CMASK(P0,P1,t) do{int jb_=(t)-(NT-4); if(jb_>=0)cmask(P0,P1,jb_,qrel,hi);}while(0)
  bool resc=false;
  #define START(P0,P1) do{ const float rm=rowmax(P0,P1); resc=false; \
    { const float dl=rm; mhat=fadd_s(mhat,dl); \
      _Pragma("unroll") for(int r=0;r<16;++r){P0[r]=fsub_s(P0[r],dl);P1[r]=fsub_s(P1[r],dl);} \
       } \
    _Pragma("unroll") for(int r=0;r<16;++r)P0[r]=__builtin_amdgcn_exp2f(P0[r]); }while(0)
  #define RESC() do{ if(resc){ asm volatile("s_waitcnt lgkmcnt(0)":::"memory"); \
      _Pragma("unroll") for(int d_=0;d_<2;++d_) _Pragma("unroll") for(int r=0;r<16;++r)o[d_][r]*=wsf[crow(r,hi)]; } }while(0)
  f32x16 pA0,pA1,pB0,pB1;
  int sl_prev=0,sl_cur=0,sl_next=SLOTB;
  #define ROT() do{sl_prev=sl_cur;sl_cur=sl_next;sl_next=(sl_next==(NSLOT-1)*SLOTB)?0:sl_next+SLOTB;}while(0)
  DMA_K(2,2*SLOTB);
  WAIT_BAR(3);
  qkt(pA0,pA1,Kbase,qr,negm,r32,hi);asm volatile("s_nop 15\n\ts_nop 7":"+v"(pA0),"+v"(pA1));KBIAS(pA0,pA1,0);CMASK(pA0,pA1,0);
  START(pA0,pA1);
  _Pragma("unroll") for(int r=0;r<16;++r)pA1[r]=__builtin_amdgcn_exp2f(pA1[r]);
  WAIT_BAR(0);
  DMA_K(3,0);DMA_V(1,SLOTB);
  ROT();
  kload8(kf,kp0+sl_cur);
  WAIT_BAR(2);
  s16x4 vlo[8],vhi[8]; u32x4 pw0,pw1,pw2,pw3;
  #define PKW(P,B) cvtpk_s(P[B],P[B+1])
  #define PAF(k) __builtin_bit_cast(bf16x8,pw##k)
  #define VFR(i) (bf16x8){vlo[i][0],vlo[i][1],vlo[i][2],vlo[i][3],vhi[i][0],vhi[i][1],vhi[i][2],vhi[i][3]}
  #define PIN(x) asm volatile("":"+v"(x))
  #define MX3(a,b,c) __builtin_fmaxf(__builtin_fmaxf((a),(b)),(c))
  #define GAPA(MF,A0,A1,A2,A3,W0,W1,PW) do{ MF; sacc+=A0; sacc+=A1; sacc+=A2; sacc+=A3; PIN(sacc); W0; W1; PIN(PW); SBAR(); }while(0)
  #define EX(v) __builtin_amdgcn_exp2f(v)
  #define GAPB(MF,X,B) do{ MF; X[B]=EX(X[B]); X[B+1]=EX(X[B+1]); X[B+2]=EX(X[B+2]); X[B+3]=EX(X[B+3]); PIN(X); SBAR(); }while(0)
  #define VRD(i) do{ vlo[i]=vtr(vp_+(((i)>>2)*4096+((i)&3)*1024)); vhi[i]=vtr(vp_+(((i)>>2)*4096+((i)&3)*1024+512)); }while(0)
  #define KRD(G,j) do{ if(G){ kload2(kf,kp0+sl_next,j); SBAR(); } }while(0)
  #define STEP(C0,C1,P0,P1,t,GK,GV,GL) do{ SBAR(); \
    const lds_cptr vp_=vp0+sl_prev; \
    VRD(0); SBAR(); float sacc=(P0[0]+P0[1]); \
    GAPA(C0=__builtin_amdgcn_mfma_f32_32x32x16_bf16(kf[0],qr[0],negm,0,0,0), P0[2],P0[3],P0[4],P0[5],     pw0[0]=PKW(P0,0), pw0[1]=PKW(P0,2), pw0); \
    VRD(4); SBAR(); GAPA(C1=__builtin_amdgcn_mfma_f32_32x32x16_bf16(kf[1],qr[0],negm,0,0,0), P0[6],P0[7],P0[8],P0[9],     pw0[2]=PKW(P0,4), pw0[3]=PKW(P0,6), pw0); \
    VRD(1); SBAR(); GAPA(C0=__builtin_amdgcn_mfma_f32_32x32x16_bf16(kf[2],qr[1],C0,0,0,0),   P0[10],P0[11],P0[12],P0[13], pw1[0]=PKW(P0,8), pw1[1]=PKW(P0,10), pw1); \
    VRD(5); SBAR(); GAPA(C1=__builtin_amdgcn_mfma_f32_32x32x16_bf16(kf[3],qr[1],C1,0,0,0),   P0[14],P0[15],P1[0],P1[1],   pw1[2]=PKW(P0,12),pw1[3]=PKW(P0,14), pw1); \
    VRD(2); SBAR(); GAPA(C0=__builtin_amdgcn_mfma_f32_32x32x16_bf16(kf[4],qr[2],C0,0,0,0),   P1[2],P1[3],P1[4],P1[5],     pw2[0]=PKW(P1,0), pw2[1]=PKW(P1,2), pw2); \
    VRD(6); SBAR(); GAPA(C1=__builtin_amdgcn_mfma_f32_32x32x16_bf16(kf[5],qr[2],C1,0,0,0),   P1[6],P1[7],P1[8],P1[9],     pw2[2]=PKW(P1,4), pw2[3]=PKW(P1,6), pw2); \
    VRD(3); SBAR(); GAPA(C0=__builtin_amdgcn_mfma_f32_32x32x16_bf16(kf[6],qr[3],C0,0,0,0),   P1[10],P1[11],P1[12],P1[13], pw3[0]=PKW(P1,8), pw3[1]=PKW(P1,10), pw3); \
    VRD(7); SBAR(); GAPA(C1=__builtin_amdgcn_mfma_f32_32x32x16_bf16(kf[7],qr[3],C1,0,0,0),   P1[14],P1[15],0.f,0.f,       pw3[2]=PKW(P1,12),pw3[3]=PKW(P1,14), pw3); \
    l_reg+=sacc; \
    if(GK){DMA_K((t)+3,sl_cur);} if(GV){DMA_V((t)+1,sl_next);} \
    KBIAS(C0,C1,t); CMASK(C0,C1,t); \
    { float a=MX3(C0[0],C0[1],C1[0]),b=MX3(C0[2],C0[3],C1[1]); a=MX3(a,C1[2],C1[3]); \
      _Pragma("unroll") for(int r=4;r<16;r+=4){a=MX3(a,C0[r],C0[r+1]);b=MX3(b,C0[r+2],C0[r+3]);a=MX3(a,C1[r],C1[r+1]);b=MX3(b,C1[r+2],C1[r+3]);} \
      float rm=__builtin_fmaxf(a,b); { auto rr=__builtin_amdgcn_permlane32_swap(__float_as_uint(rm),__float_as_uint(rm),false,false); rm=__builtin_fmaxf(__uint_as_float(rr[0]),__uint_as_float(rr[1])); } \
      resc=false; \
      if(__builtin_expect(__any(rm>(float)THRL),0)){ const float dl=__builtin_fmaxf(rm,0.f); mhat+=dl; \
        _Pragma("unroll") for(int r=0;r<16;++r){C0[r]-=dl;C1[r]-=dl;} \
         \
        const float f=__builtin_amdgcn_exp2f(-dl); l_reg*=f; if(hi==0)wsf[r32]=f; resc=true; } } \
    SBAR(); \
    GAPB(o[0]=__builtin_amdgcn_mfma_f32_32x32x16_bf16(PAF(0),VFR(0),o[0],0,0,0), C0,0); \
    GAPB(o[1]=__builtin_amdgcn_mfma_f32_32x32x16_bf16(PAF(0),VFR(4),o[1],0,0,0), C0,4); \
    KRD(GL,0); GAPB(o[0]=__builtin_amdgcn_mfma_f32_32x32x16_bf16(PAF(1),VFR(1),o[0],0,0,0), C0,8); \
    KRD(GL,1); GAPB(o[1]=__builtin_amdgcn_mfma_f32_32x32x16_bf16(PAF(1),VFR(5),o[1],0,0,0), C0,12); \
    KRD(GL,2); GAPB(o[0]=__builtin_amdgcn_mfma_f32_32x32x16_bf16(PAF(2),VFR(2),o[0],0,0,0), C1,0); \
    KRD(GL,3); GAPB(o[1]=__builtin_amdgcn_mfma_f32_32x32x16_bf16(PAF(2),VFR(6),o[1],0,0,0), C1,4); \
    GAPB(o[0]=__builtin_amdgcn_mfma_f32_32x32x16_bf16(PAF(3),VFR(3),o[0],0,0,0), C1,8); \
    GAPB(o[1]=__builtin_amdgcn_mfma_f32_32x32x16_bf16(PAF(3),VFR(7),o[1],0,0,0), C1,12); \
    }while(0)
  int t=1;
  #undef CMASK
  #define CMASK(P0,P1,t) do{}while(0)
  for(;t+5<NT;t+=2){
    STEP(pB0,pB1,pA0,pA1,t,true,true,true);     WAIT_BAR(2); RESC(); ROT();
    STEP(pA0,pA1,pB0,pB1,t+1,true,true,true);   WAIT_BAR(2); RESC(); ROT();
  }
  #undef CMASK
  #define CMASK(P0,P1,t) do{int jb_=(t)-(NT-4); if(jb_>=0)cmask(P0,P1,jb_,qrel,hi);}while(0)
  #define ENDW(tt) do{ if((tt)+3<NT){WAIT_BAR(2);} else if((tt)+2<NT){WAIT_BAR(1);} else {WAIT_BAR(0);} }while(0)
  for(;t+1<NT;t+=2){
    STEP(pB0,pB1,pA0,pA1,t,(t+3<NT),(t+1<NT),(t+1<NT));       ENDW(t);   RESC(); ROT();
    STEP(pA0,pA1,pB0,pB1,t+1,(t+4<NT),(t+2<NT),(t+2<NT));     ENDW(t+1); RESC(); ROT();
  }
  STEP(pB0,pB1,pA0,pA1,NT-1,false,false,false); RESC();
  { float sacc=pB0[0]+pB0[1]; _Pragma("unroll") for(int r=2;r<16;++r)sacc+=pB0[r]; _Pragma("unroll") for(int r=0;r<16;++r)sacc+=pB1[r]; l_reg+=sacc;
    pw0=(u32x4){PKW(pB0,0),PKW(pB0,2),PKW(pB0,4),PKW(pB0,6)};pw1=(u32x4){PKW(pB0,8),PKW(pB0,10),PKW(pB0,12),PKW(pB0,14)};pw2=(u32x4){PKW(pB1,0),PKW(pB1,2),PKW(pB1,4),PKW(pB1,6)};pw3=(u32x4){PKW(pB1,8),PKW(pB1,10),PKW(pB1,12),PKW(pB1,14)};
    SBAR(); pv(o,vb0+sl_cur,PAF(0),PAF(1),PAF(2),PAF(3)); }
  #undef PKW
  #undef PAF
  #undef VFR
  #undef PIN
  #undef MX3
  #undef GAPA
  #undef GAPB
  #undef EX
  #undef VRD
  #undef KRD
  #undef STEP
  #undef ENDW
  {auto rr=__builtin_amdgcn_permlane32_swap(__float_as_uint(l_reg),__float_as_uint(l_reg),false,false);l_reg=__uint_as_float(rr[0])+__uint_as_float(rr[1]);}
  if(hi==0)wsf[32+r32]=l_reg;asm volatile("s_waitcnt lgkmcnt(0)":::"memory");
  float rli[16];
  #pragma unroll
  for(int r=0;r<16;++r)rli[r]=__builtin_amdgcn_rcpf(wsf[32+crow(r,hi)]);
  bf16*Ow=O+(rowbase+q0+wid*QBLK)*DM+h*D;
  { bf16*stg=(bf16*)(shm+LDS_OST)+wid*2048;
    #pragma unroll
    for(int r=0;r<16;++r){const int orow=crow(r,hi);
      #pragma unroll
      for(int d0=0;d0<2;++d0)stg[orow*64+d0*32+r32]=__float2bfloat16(o[d0][r]*rli[r]);}
    asm volatile("s_waitcnt lgkmcnt(0)":::"memory");
    #pragma unroll
    for(int i=0;i<4;++i){const int row=i*8+(lane>>3),ch=lane&7; const u32x4 v=*(const u32x4*)(stg+row*64+ch*8); ATTN_STORE16(Ow+(long)row*DM+ch*8,v);} }
  asm volatile("s_waitcnt lgkmcnt(0)\n\ts_barrier":::"memory");
  #undef KBIAS
  #undef DMA_K
  #undef DMA_V
  #undef CMASK
  #undef START
  #undef RESC
  #undef ROT
}
constexpr int ATTN_LDS_BYTES=LDS_BYTES;
struct AttnTensors { const bf16* Q; const bf16* K; const bf16* V; bf16* O; const float* NEGF; };
struct AttnUnit { int bh; int qb; };
struct StaticOrder {
  int c,G;
  __device__ __forceinline__ explicit StaticOrder(int grid,int block):c(block),G(grid){}
  __device__ __forceinline__ bool next(int i,AttnUnit&u)const{ const int bh=c+(i>>3)*G; if(bh>=BATCH*NHEAD)return false; u.bh=bh; u.qb=7-(i&7); return true; }
  __device__ __forceinline__ void a_ready(const AttnUnit&)const{}
  __device__ __forceinline__ void done(const AttnUnit&)const{}
};
template<class Sched,int THRL=8> __device__ __forceinline__ void attn_phase(char*lds,const AttnTensors&T,const Sched&S){
  AttnUnit u;
  for(int i=0;S.next(i,u);++i){ S.a_ready(u); attn_unit<THRL>(u.bh/NHEAD,u.bh%NHEAD,u.qb,T.Q,T.K,T.V,T.O,T.NEGF,lds); S.done(u); }
}
#undef SBAR
#undef WAIT_BAR
}
#define GAS __attribute__((address_space(1)))
#define LAS __attribute__((address_space(3)))
typedef unsigned short bf16;
typedef unsigned v4u __attribute__((ext_vector_type(4)));
typedef float f32x4 __attribute__((ext_vector_type(4)));
typedef short bf16x8 __attribute__((ext_vector_type(8)));
typedef GAS unsigned gu32;
typedef GAS unsigned long long gu64;
#define RLX_AGENT __ATOMIC_RELAXED, __HIP_MEMORY_SCOPE_AGENT
#define LDS_WAIT() asm volatile("s_waitcnt lgkmcnt(0)" ::: "memory")
#define VM_WAIT() asm volatile("s_waitcnt vmcnt(0)" ::: "memory")
__device__ __forceinline__ unsigned long long rt() { return __builtin_amdgcn_s_memrealtime(); }
__device__ __forceinline__ unsigned f2bf(float f) { unsigned u = __builtin_bit_cast(unsigned, f); return (u + 0x7fffu + ((u >> 16) & 1u)) >> 16; }
__device__ __forceinline__ unsigned pk2(float lo, float hi) { return f2bf(lo) | (f2bf(hi) << 16); }

#define XB_TMO      128
#define XB_XCNT(j)  (256  + 64 * (j))
#define XB_XSUB(j)  (1280 + 64 * (j))
#define XB_XGEN(j)  (2304 + 64 * (j))
#define XB_TOP      3328
#define XB_TOPGEN   3392
#define XCD_BAR_WORDS 3456
#define XB_SPIN_CAP (1u << 18)

__device__ __forceinline__ unsigned xb_ld(unsigned* p)              { return __hip_atomic_load(p, __ATOMIC_RELAXED, __HIP_MEMORY_SCOPE_AGENT); }
__device__ __forceinline__ unsigned xb_add(unsigned* p, unsigned v) { return __hip_atomic_fetch_add(p, v, __ATOMIC_RELAXED, __HIP_MEMORY_SCOPE_AGENT); }
__device__ __forceinline__ unsigned xb_xcc_id() { return (unsigned)__builtin_amdgcn_s_getreg((3 << 11) | 20) & 0xFu; }
#define XB_SPIN(cond, bar) do { unsigned _sp = 0; while (cond) { __builtin_amdgcn_s_sleep(1); \
    if ((++_sp & 255u) == 0u) { if (xb_ld(&(bar)[XB_TMO])) break; if (_sp > XB_SPIN_CAP) { atomicAdd(&(bar)[XB_TMO], 1u); break; } } } } while (0)

struct XcdBarrier {
    unsigned* bar; unsigned x;
    volatile LAS unsigned* st;
};

__device__ __forceinline__ XcdBarrier xcd_barrier_post(unsigned* bar, volatile LAS unsigned* st) {
    XcdBarrier b; b.bar = bar; b.x = xb_xcc_id(); b.st = st;
    if (threadIdx.x == 0) (void)xb_add(&bar[XB_XCNT(b.x)], 1u);
    return b;
}
__device__ __forceinline__ void xcd_barrier_complete(unsigned* bar, unsigned x, unsigned& nloc, unsigned& nx) {
    const unsigned G = gridDim.x * gridDim.y * gridDim.z;
    unsigned sum, cnt, mine, sp = 0u;
    for (;;) {
        sum = 0u; cnt = 0u; mine = 0u;
#pragma unroll
        for (unsigned j = 0; j < 16; ++j) { const unsigned c = xb_ld(&bar[XB_XCNT(j)]); sum += c; cnt += (c > 0u) ? 1u : 0u; mine = (j == x) ? c : mine; }
        if (sum == G) break;
        __builtin_amdgcn_s_sleep(1);
        if ((++sp & 255u) == 0u) { if (xb_ld(&bar[XB_TMO])) break; if (sp > XB_SPIN_CAP) { atomicAdd(&bar[XB_TMO], 1u); break; } }
    }
    nloc = mine > 0u ? mine : 1u; nx = cnt > 0u ? cnt : 1u;
}

__device__ __forceinline__ void xcd_barrier(const XcdBarrier& b) {
    asm volatile("s_waitcnt vmcnt(0)" ::: "memory");
    __syncthreads();
    if (threadIdx.x == 0) {
        unsigned* bar = b.bar;
        __builtin_amdgcn_s_waitcnt(0);
        unsigned nloc = b.st[0], nx = b.st[1];
        if (nloc == 0u) { xcd_barrier_complete(bar, b.x, nloc, nx); b.st[0] = nloc; b.st[1] = nx; }
        const unsigned old = xb_add(&bar[XB_XSUB(b.x)], 1u);
        const unsigned gen = old / nloc;
        if (old + 1u == (gen + 1u) * nloc) {
            __builtin_amdgcn_fence(__ATOMIC_RELEASE, "agent");
            asm volatile("s_waitcnt vmcnt(0)" ::: "memory");
            const unsigned og = xb_add(&bar[XB_TOP], 1u);
            const unsigned tg = og / nx;
            if (og + 1u == (tg + 1u) * nx) xb_add(&bar[XB_TOPGEN], 1u);
            else XB_SPIN(xb_ld(&bar[XB_TOPGEN]) == tg, bar);
            __builtin_amdgcn_fence(__ATOMIC_ACQUIRE, "agent");
            xb_add(&bar[XB_XGEN(b.x)], 1u);
            asm volatile("s_waitcnt vmcnt(0)" ::: "memory");
        } else {
            XB_SPIN(xb_ld(&bar[XB_XGEN(b.x)]) == gen, bar);
            __builtin_amdgcn_fence(__ATOMIC_ACQUIRE, "agent");
            asm volatile("s_waitcnt vmcnt(0)" ::: "memory");
        }
    }
    __syncthreads();
}
namespace cg = cooperative_groups;
constexpr int NWAVES = 8;
#ifndef MK_PER_PHASE
#define MK_PER_PHASE 0
#endif
#ifndef MK_USE_CG
#define MK_USE_CG 0
#endif
#ifndef MK_DUP_NG
#define MK_DUP_NG 1
#endif
#ifndef MK_DUP_G
#define MK_DUP_G 1
#endif
constexpr int BATCH = 16, T = 2048, D = 1024, FF = 4096, M = BATCH * T;
constexpr size_t MiB = 1u << 20;
constexpr size_t WS_CTL = 0, CTL_ZERO_BYTES = 1 * MiB, WS_SSQA = 1 * MiB, WS_SSQB = 3 * MiB, WS_FLOG = 5 * MiB, WS_NEGF = 7 * MiB, WS_SV = 9 * MiB, WS_W = 10 * MiB,
                 WS_HB = 118 * MiB, WS_PB = 182 * MiB, WS_PP = 246 * MiB, WS_BIG = 310 * MiB, WS_END = 510 * MiB;
constexpr size_t ME = 1u << 20;
constexpr size_t W_S5IN = 0, W_S5GLU = 1 * ME, W_S5OUT = 3 * ME, W_S5STRIDE = 4 * ME, W_FOXIN = 8 * ME, W_FOXOUT = W_FOXIN + 3328 * 1024, W_GLAIN = W_FOXOUT + ME, W_GLAOUT = W_GLAIN + 3328 * 1024,
                 W_MLP1 = W_GLAOUT + ME, W_MLP2 = W_MLP1 + 4 * ME, W_MLPSTRIDE = 8 * ME, W_PLEG = W_MLP1 + 32 * ME, W_PLEP = W_PLEG + ME, W_PLESTRIDE = ME + ME / 4, W_TOTAL = W_PLEG + 4 * W_PLESTRIDE;
static_assert(W_TOTAL * 2 <= 108 * MiB, "weights region");
constexpr int CW_BAR = 4096;
constexpr int RING_OFF = 0, RING_BYTES = 131072, LDSCTL_OFF = RING_BYTES, MISC_OFF = LDSCTL_OFF + 320, LDS_BYTES = 147456;
constexpr float LOG2E = 1.4426950408889634f;
typedef unsigned u32x2g __attribute__((ext_vector_type(2)));

__device__ __forceinline__ float wave_sum(float v) {
#pragma unroll
    for (int o = 1; o < 64; o <<= 1) v += __shfl_xor(v, o);
    return v;
}
__device__ __forceinline__ float sigmoid_f(float x) { return 1.0f / (1.0f + __expf(-x)); }
__device__ __forceinline__ float log_sigmoid_f(float x) { return fminf(x, 0.f) - log1pf(__expf(-fabsf(x))); }
__device__ __forceinline__ float gelu_tanh_f(float x) { const float uu = 0.7978845608028654f * (x + 0.044715f * x * x * x); const float th = 1.0f - 2.0f / (__expf(2.0f * uu) + 1.0f); return 0.5f * x * (1.0f + th); }
typedef float f32x2c_ __attribute__((ext_vector_type(2))); typedef __bf16 bf16x2c_ __attribute__((ext_vector_type(2)));
__device__ __forceinline__ unsigned cvtpk_c(float lo, float hi) { const f32x2c_ v = {lo, hi}; return __builtin_bit_cast(unsigned, __builtin_convertvector(v, bf16x2c_)); }
__device__ __forceinline__ float bf_lo(unsigned w) { return __uint_as_float(w << 16); }
__device__ __forceinline__ float bf_hi(unsigned w) { return __uint_as_float(w & 0xffff0000u); }

__device__ __forceinline__ void transpose_item(const float* W, int K, int ldw, const float* gain, bf16* WT, int n0, int drow0, int k0, LAS float* scr, int lane) {
    f32x4 wv[8];
#pragma unroll
    for (int i = 0; i < 8; ++i) wv[i] = *(const GAS f32x4*)(W + (size_t)(k0 + 8 * i + (lane >> 3)) * ldw + n0 + (lane & 7) * 4);
#pragma unroll
    for (int i = 0; i < 8; ++i) { const int kk = 8 * i + (lane >> 3); const float gk = gain ? gain[k0 + kk] : 1.0f; LAS float* d = scr + kk * 33 + (lane & 7) * 4;
        d[0] = wv[i][0] * gk; d[1] = wv[i][1] * gk; d[2] = wv[i][2] * gk; d[3] = wv[i][3] * gk; }
    LDS_WAIT(); asm volatile("" ::: "memory");
    const int c = lane & 7;
#pragma unroll
    for (int j = 0; j < 4; ++j) { const int n = (lane >> 3) + 8 * j; const LAS float* s = scr + (8 * c) * 33 + n;
        v4u o; o.x = pk2(s[0 * 33], s[1 * 33]); o.y = pk2(s[2 * 33], s[3 * 33]); o.z = pk2(s[4 * 33], s[5 * 33]); o.w = pk2(s[6 * 33], s[7 * 33]);
        *(GAS v4u*)(WT + (size_t)(drow0 + n) * K + k0 + 8 * c) = o; }
    LDS_WAIT(); asm volatile("" ::: "memory");
}

__device__ __forceinline__ const float* ld_ptr(LAS unsigned long long* t, int i) { const unsigned long long v = t[i];
    const unsigned lo = __builtin_amdgcn_readfirstlane((unsigned)v), hi = __builtin_amdgcn_readfirstlane((unsigned)(v >> 32)); return (const float*)(const GAS float*)(((unsigned long long)hi << 32) | lo); }

__device__ __forceinline__ float reduce16(float (&v)[16], int lane) {
    { const bool hb5 = (lane & 32) != 0;
#pragma unroll
      for (int i = 0; i < 8; ++i) { const float snd = hb5 ? v[i] : v[i + 8], kp = hb5 ? v[i + 8] : v[i]; v[i] = kp + __shfl_xor(snd, 32); } }
    { const bool hb4 = (lane & 16) != 0;
#pragma unroll
      for (int i = 0; i < 4; ++i) { const float snd = hb4 ? v[i] : v[i + 4], kp = hb4 ? v[i + 4] : v[i]; v[i] = kp + __shfl_xor(snd, 16); } }
    { const bool hb3 = (lane & 8) != 0;
#pragma unroll
      for (int i = 0; i < 2; ++i) { const float snd = hb3 ? v[i] : v[i + 2], kp = hb3 ? v[i + 2] : v[i]; v[i] = kp + __shfl_xor(snd, 8); } }
    { const bool hb2 = (lane & 4) != 0; const float snd = hb2 ? v[0] : v[1], kp = hb2 ? v[1] : v[0]; v[0] = kp + __shfl_xor(snd, 4); }
    float tot = v[0]; tot += __shfl_xor(tot, 2); tot += __shfl_xor(tot, 1); return tot;
}
__device__ __forceinline__ void sv_pass(float (&acc)[16], LAS float* inT, const float* in, size_t in_stride, int K, const float* gain, const float* W, int ldw, int col, int tk, int KG, int lane, int wave) {
    for (int k0 = 0; k0 < K; k0 += 1024) {
        const int kc = (K - k0) < 1024 ? (K - k0) : 1024;
        __syncthreads();
        for (int rr = 0; rr < 2; ++rr) { const int r = 2 * wave + rr; const float* src = in + (size_t)r * in_stride + k0;
            f32x4 v[4]; float ss = 0.f;
#pragma unroll
            for (int i = 0; i < 4; ++i) { const int k4 = lane + 64 * i; v[i] = (f32x4){0.f, 0.f, 0.f, 0.f}; if (4 * k4 < kc) v[i] = *(const GAS f32x4*)(src + 4 * k4); ss += (v[i][0] * v[i][0] + v[i][1] * v[i][1]) + (v[i][2] * v[i][2] + v[i][3] * v[i][3]); }
            float sc = 1.f; if (gain) { ss = wave_sum(ss); sc = rsqrtf(ss * (1.0f / 1024.0f) + 1e-6f); }
#pragma unroll
            for (int i = 0; i < 4; ++i) { const int k4 = lane + 64 * i; if (4 * k4 < kc) { f32x4 g = (f32x4){1.f, 1.f, 1.f, 1.f}; if (gain) g = *(const GAS f32x4*)(gain + k0 + 4 * k4);
#pragma unroll
                for (int e = 0; e < 4; ++e) inT[(4 * k4 + e) * 16 + r] = v[i][e] * sc * g[e]; } } }
        __syncthreads();
#pragma unroll 4
        for (int k = tk; k < kc; k += KG) { const float w = W[(size_t)(k0 + k) * ldw + col]; const LAS f32x4* ip = (const LAS f32x4*)(inT + k * 16); const f32x4 a0 = ip[0], a1 = ip[1], a2 = ip[2], a3 = ip[3];
            acc[0] += w * a0[0]; acc[1] += w * a0[1]; acc[2] += w * a0[2]; acc[3] += w * a0[3]; acc[4] += w * a1[0]; acc[5] += w * a1[1]; acc[6] += w * a1[2]; acc[7] += w * a1[3];
            acc[8] += w * a2[0]; acc[9] += w * a2[1]; acc[10] += w * a2[2]; acc[11] += w * a2[3]; acc[12] += w * a3[0]; acc[13] += w * a3[1]; acc[14] += w * a3[2]; acc[15] += w * a3[3]; }
    }
}
__device__ __forceinline__ void sv_stage(LAS unsigned char* ldsl, int mode, int N, const float* in0, size_t st0, int K0, const float* gain0, const float* W0, int ldw0, int c00,
                                         const float* in1, size_t st1, int K1, const float* W1, int ldw1, int c01, const float* res, size_t rst, float* out, int ost, int tid, int lane, int wave, int G) {
    const int cw = N / 256, KG = 512 / cw, tc = tid % cw, tk = tid / cw;
    LAS float* inT = (LAS float*)ldsl; LAS float* red0 = inT + 16384; LAS float* red1 = inT + 24576;
    for (int cb = blockIdx.x; cb < 256; cb += G) { const int n0 = ((G == 256) ? ((cb & 7) << 5) + (cb >> 3) : cb) * cw;
        float a0[16], a1[16];
#pragma unroll
        for (int r = 0; r < 16; ++r) { a0[r] = 0.f; a1[r] = 0.f; }
        sv_pass(a0, inT, in0, st0, K0, gain0, W0, ldw0, c00 + n0 + tc, tk, KG, lane, wave);
        if (K1 > 0) sv_pass(a1, inT, in1, st1, K1, nullptr, W1, ldw1, c01 + n0 + tc, tk, KG, lane, wave);
        __syncthreads();
#pragma unroll
        for (int r = 0; r < 16; ++r) { red0[tid * 16 + r] = a0[r]; red1[tid * 16 + r] = a1[r]; }
        __syncthreads();
        if (tid < 16 * cw) { const int r = tid / cw, c = tid % cw; float s0 = 0.f, s1 = 0.f;
            for (int g = 0; g < KG; ++g) { s0 += red0[(g * cw + c) * 16 + r]; s1 += red1[(g * cw + c) * 16 + r]; }
            const int n = n0 + c; float o;
            if (mode == 0) o = s0; else if (mode == 1) o = res[(size_t)r * rst + n] + s0; else if (mode == 2) { const float t = fmaxf(s0, 0.f); o = t * t; }
            else if (mode == 3) o = s0 * sigmoid_f(s1); else o = res[(size_t)r * rst + n] + s1 * sigmoid_f(s0);
            out[(size_t)r * ost + n] = o; }
    }
    __syncthreads();
}
struct Args { const float* in[29]; float* out; unsigned char* ws; int ph_lo, ph_hi; };
constexpr int N_PHASES = 38;
enum { T_PROLOGUE = 0, T_INPROJ, T_MIX1, T_MIX2, T_OUTPROJ, T_UP0, T_DOWN0, T_UP1, T_DOWN1, T_PLE, T_FINAL };

__global__ void __launch_bounds__(NWAVES * 64, 2) trunk_fwd(Args args) {
    extern __shared__ __attribute__((aligned(16))) unsigned char lds[];
    LAS unsigned char* const ldsl = (LAS unsigned char*)lds;
    volatile LAS unsigned* MISC = (volatile LAS unsigned*)(ldsl + MISC_OFF);
    const int tid0 = threadIdx.x;
#define tid tid0
    for (int u = tid; u < (LDS_BYTES - LDSCTL_OFF) / 4; u += NWAVES * 64) ((LAS unsigned*)(ldsl + LDSCTL_OFF))[u] = 0u;
    __syncthreads();
    LAS unsigned long long* const ptab = (LAS unsigned long long*)(ldsl + LDSCTL_OFF + 64);
    if (tid == 0) {
#define PT_(i) ptab[i] = (unsigned long long)args.in[i];
        PT_(0) PT_(1) PT_(2) PT_(3) PT_(4) PT_(5) PT_(6) PT_(7) PT_(8) PT_(9) PT_(10) PT_(11) PT_(12) PT_(13) PT_(14) PT_(15) PT_(16) PT_(17) PT_(18) PT_(19) PT_(20) PT_(21) PT_(22) PT_(23) PT_(24) PT_(25) PT_(26) PT_(27) PT_(28)
        ptab[29] = (unsigned long long)args.ws; ptab[30] = (unsigned long long)args.out;
#undef PT_
    }
    __syncthreads();
#define INP(i) ld_ptr(ptab, (i))
#define ws ((unsigned char*)ld_ptr(ptab, 29))
#define h ((float*)ld_ptr(ptab, 30))
#define Wb ((bf16*)(ws + WS_W))
#define HB ((bf16*)(ws + WS_HB))
#define PB ((bf16*)(ws + WS_PB))
#define PP ((bf16*)(ws + WS_PP))
#define BIG ((bf16*)(ws + WS_BIG))
#define FLOG ((float*)(ws + WS_FLOG))
#define NEGF ((float*)(ws + WS_NEGF))
#if !MK_PER_PHASE
    cg::grid_group grid = cg::this_grid();
#if !MK_USE_CG
    XcdBarrier bar = xcd_barrier_post((unsigned*)(ws + WS_CTL) + CW_BAR, MISC + 8);
#endif
#endif
    (void)MISC;

#undef tid
    for (int ph = args.ph_lo; ph < args.ph_hi; ++ph) {
        int tid = tid0; asm volatile("" : "+v"(tid));
        const int lane = tid & 63, wave = __builtin_amdgcn_readfirstlane(tid >> 6);
        const int G = gridDim.x, gw = blockIdx.x * NWAVES + wave, NGW = G * NWAVES, gtid = blockIdx.x * (NWAVES * 64) + tid, NT = G * NWAVES * 64;
        int type, layer = 0;
        if (ph == 0) type = T_PROLOGUE; else if (ph >= 37) type = T_FINAL; else { layer = (ph - 1) / 9; type = T_INPROJ + (ph - 1) % 9; }
        const int mixer = layer % 3, jm = layer / 3;
#define SSQ_(k) ((float*)(ws + (((3 * layer + (k)) & 1) ? WS_SSQB : WS_SSQA)))
#define ssq0 SSQ_(0)
#define ssq1 SSQ_(1)
#define ssq2 SSQ_(2)
#define ssq3 SSQ_(3)


        for (int rep_ = 0; rep_ < (((type == T_MIX2 && mixer == 1) || type == T_FINAL) ? 1 : MK_DUP_NG); ++rep_) {
        if (rep_) __syncthreads();
        int tid_o = tid; asm volatile("" : "+v"(tid_o));
        { const int tid = tid_o, lane = tid & 63, wave = __builtin_amdgcn_readfirstlane(tid >> 6), gw = blockIdx.x * NWAVES + wave, gtid = blockIdx.x * (NWAVES * 64) + tid; (void)gtid; (void)gw; (void)lane;
        { const int sk = ph - 1;
          if (sk >= 0 && sk < 13) {
            float* const SVH0 = (float*)(ws + WS_SV); float* const SVH1 = SVH0 + 16384; float* const SVA = SVH0 + 32768; float* const SVB = SVH0 + 98304;
            const size_t XS = (size_t)T * D, PS = (size_t)T * 256;
            if (sk == 0) sv_stage(ldsl, 0, 1024, INP(0), XS, 1024, INP(2), INP(5), 1024, 0, nullptr, 0, 0, nullptr, 0, 0, nullptr, 0, SVA, 1024, tid, lane, wave, G);
            else if (sk == 1) {
                for (int item = gw; item < 1024; item += NGW) { const int b = item >> 6, g = item & 63, n = lane; const size_t gn = (size_t)g * 64 + n;
                    const float dt = expf(INP(8)[g]), lr = INP(6)[gn], li = INP(7)[gn];
                    const float mag = expf(lr * dt), are = mag * cosf(li * dt), aim = mag * sinf(li * dt), den = lr * lr + li * li, nr = are - 1.0f;
                    const float cre = (nr * lr + aim * li) / den, cim = (aim * lr - nr * li) / den;
                    float xre = 0.f, xim = 0.f; const float* uu = SVA + b * 1024 + g * 16;
#pragma unroll
                    for (int c = 0; c < 16; ++c) { const float br = INP(9)[gn * 16 + c], bi = INP(10)[gn * 16 + c]; xre += (cre * br - cim * bi) * uu[c]; xim += (cre * bi + cim * br) * uu[c]; }
                    float v[16];
#pragma unroll
                    for (int c = 0; c < 16; ++c) { const size_t ci = (size_t)g * 1024 + c * 64 + n; v[c] = INP(11)[ci] * xre - INP(12)[ci] * xim; }
                    const float tot = reduce16(v, lane);
                    const int ch = ((lane >> 5) & 1) * 8 + ((lane >> 4) & 1) * 4 + ((lane >> 3) & 1) * 2 + ((lane >> 2) & 1);
                    if ((lane & 3) == 0) SVB[b * 1024 + g * 16 + ch] = gelu_tanh_f(tot + INP(13)[g * 16 + ch] * uu[ch]); } }
            else if (sk == 2) sv_stage(ldsl, 3, 1024, SVB, 1024, 1024, nullptr, INP(14), 2048, 0, SVB, 1024, 1024, INP(14), 2048, 1024, nullptr, 0, SVA, 1024, tid, lane, wave, G);
            else if (sk == 3) sv_stage(ldsl, 1, 1024, SVA, 1024, 1024, nullptr, INP(15), 1024, 0, nullptr, 0, 0, nullptr, 0, 0, INP(0), XS, SVH1, 1024, tid, lane, wave, G);
            else if (sk == 4 || sk == 9) { const int L = (sk == 9); sv_stage(ldsl, 2, 4096, L ? SVH0 : SVH1, 1024, 1024, INP(3) + L * 1024, INP(24) + (size_t)L * 4 * ME, 4096, 0, nullptr, 0, 0, nullptr, 0, 0, nullptr, 0, SVA, 4096, tid, lane, wave, G); }
            else if (sk == 5 || sk == 10) { const int L = (sk == 10); sv_stage(ldsl, 1, 1024, SVA, 4096, 4096, nullptr, INP(25) + (size_t)L * 4 * ME, 1024, 0, nullptr, 0, 0, nullptr, 0, 0, L ? SVH0 : SVH1, 1024, L ? SVH1 : SVH0, 1024, tid, lane, wave, G); }
            else if (sk == 6 || sk == 11) { const int L = (sk == 11); const float* hin = L ? SVH1 : SVH0;
                sv_stage(ldsl, 4, 1024, hin, 1024, 1024, INP(4) + L * 1024, INP(27) + (size_t)L * ME, 1024, 0, INP(1) + (size_t)L * M * 256, PS, 256, INP(26) + (size_t)L * (ME / 4), 1024, 0, hin, 1024, L ? SVH0 : SVH1, 1024, tid, lane, wave, G); }
            else if (sk == 7) sv_stage(ldsl, 0, 1024, SVH1, 1024, 1024, INP(2) + 1024, INP(16), 3088, 2048, nullptr, 0, 0, nullptr, 0, 0, nullptr, 0, SVA, 1024, tid, lane, wave, G);
            else if (sk == 8) sv_stage(ldsl, 1, 1024, SVA, 1024, 1024, nullptr, INP(18), 1024, 0, nullptr, 0, 0, nullptr, 0, 0, SVH1, 1024, SVH0, 1024, tid, lane, wave, G);
            else if (sk == 12) sv_stage(ldsl, 0, 1024, SVH0, 1024, 1024, INP(2) + 2 * 1024, INP(19), 3088, 0, nullptr, 0, 0, nullptr, 0, 0, nullptr, 0, SVA, 1024, tid, lane, wave, G);
          } }
        if (type == T_PROLOGUE) {
            LAS float* scr = (LAS float*)(ldsl + RING_OFF + wave * 16384);
            for (int gi = gw; gi < 27136 + 512; gi += NGW) {
                int mi, it;
                if (gi < 4096) { const int j = gi >> 11, r = gi & 2047; const int w = (r < 512) ? 0 : (r < 1536) ? 1 : 2; mi = 3 * j + w; it = r - ((w == 0) ? 0 : (w == 1) ? 512 : 1536); }
                else if (gi < 8192) { const int r = gi - 4096; if (r < 1536) { mi = 6; it = r; } else if (r < 2048) { mi = 7; it = r - 1536; } else if (r < 3584) { mi = 8; it = r - 2048; } else { mi = 9; it = r - 3584; } }
                else if (gi < 16384) { mi = 10 + ((gi - 8192) >> 11); it = (gi - 8192) & 2047; }
                else if (gi < 24576) { mi = 14 + ((gi - 16384) >> 11); it = (gi - 16384) & 2047; }
                else if (gi < 26624) { mi = 18 + ((gi - 24576) >> 9); it = (gi - 24576) & 511; }
                else if (gi < 27136) { mi = 22 + ((gi - 26624) >> 7); it = (gi - 26624) & 127; }
                else { mi = (gi - 27136 < 256) ? 6 : 8; it = -1 - ((gi - 27136) & 255); }
                const float* src; int K = 1024, ldw = 1024, ncols = 1024, glu = 0; const float* gain = nullptr; bf16* dst;
                if (mi < 6) { const int j = mi / 3, w = mi % 3;
                    if (w == 0) { src = INP(5) + (size_t)j * ME; gain = INP(2) + (size_t)(3 * j) * 1024; dst = Wb + W_S5IN + j * W_S5STRIDE; }
                    else if (w == 1) { src = INP(14) + (size_t)j * 2 * ME; ldw = 2048; ncols = 2048; glu = 1; dst = Wb + W_S5GLU + j * W_S5STRIDE; }
                    else { src = INP(15) + (size_t)j * ME; dst = Wb + W_S5OUT + j * W_S5STRIDE; } }
                else if (mi == 6) { src = INP(16); ldw = 3088; ncols = 3072; gain = INP(2) + 1 * 1024; dst = Wb + W_FOXIN; }
                else if (mi == 7) { src = INP(18); dst = Wb + W_FOXOUT; }
                else if (mi == 8) { src = INP(19); ldw = 3088; ncols = 3072; gain = INP(2) + 2 * 1024; dst = Wb + W_GLAIN; }
                else if (mi == 9) { src = INP(23); dst = Wb + W_GLAOUT; }
                else if (mi < 14) { const int i = mi - 10; src = INP(24) + (size_t)i * 4 * ME; ldw = 4096; ncols = 4096; gain = INP(3) + (size_t)i * 1024; dst = Wb + W_MLP1 + i * W_MLPSTRIDE; }
                else if (mi < 18) { const int i = mi - 14; src = INP(25) + (size_t)i * 4 * ME; K = 4096; dst = Wb + W_MLP2 + i * W_MLPSTRIDE; }
                else if (mi < 22) { const int i = mi - 18; src = INP(27) + (size_t)i * ME; gain = INP(4) + (size_t)i * 1024; dst = Wb + W_PLEG + i * W_PLESTRIDE; }
                else { const int i = mi - 22; src = INP(26) + (size_t)i * (ME / 4); K = 256; dst = Wb + W_PLEP + i * W_PLESTRIDE; }
                const int nblk = ncols / 32;
                if (it >= 0) { const int kb = it / nblk, nb = it % nblk, n0 = 32 * nb; int drow0 = n0;
                    if (glu) { const int c = n0 & 1023; drow0 = 256 * (c >> 7) + (c & 127) + ((n0 >= 1024) ? 128 : 0); }
                    transpose_item(src, K, ldw, gain, dst, n0, drow0, 64 * kb, scr, lane); }
                else { const int n = 3072 + (-1 - it);
#pragma unroll 4
                    for (int k = lane; k < 1024; k += 64) { const float v = (n < 3088) ? src[(size_t)k * 3088 + n] * gain[k] : 0.f; dst[(size_t)n * 1024 + k] = (bf16)f2bf(v); } }
            }
            float* ssqA = (float*)(ws + WS_SSQA);
            for (int m = gw; m < M; m += 2 * NGW) {
                const int m2 = (m + NGW < M) ? m + NGW : m;
                const GAS f32x4* xr0 = (const GAS f32x4*)(INP(0) + (size_t)m * D) + lane; const GAS f32x4* xr1 = (const GAS f32x4*)(INP(0) + (size_t)m2 * D) + lane;
                f32x4 v[2][4];
#pragma unroll
                for (int j = 0; j < 4; ++j) { v[0][j] = xr0[64 * j]; v[1][j] = xr1[64 * j]; }
#pragma unroll
                for (int r = 0; r < 2; ++r) { const int mr = r ? m2 : m; float s = 0.f;
#pragma unroll
                    for (int j = 0; j < 4; ++j) s += (v[r][j].x * v[r][j].x + v[r][j].y * v[r][j].y) + (v[r][j].z * v[r][j].z + v[r][j].w * v[r][j].w);
                    s = wave_sum(s);
                    GAS unsigned long long* o8 = (GAS unsigned long long*)(PB + (size_t)mr * D) + lane;
#pragma unroll
                    for (int j = 0; j < 4; ++j) o8[64 * j] = (unsigned long long)pk2(v[r][j].x, v[r][j].y) | ((unsigned long long)pk2(v[r][j].z, v[r][j].w) << 32);
                    if (lane < 16) ssqA[(size_t)mr * 16 + lane] = (lane == 0) ? s : 0.f; }
            }
        }
        else if (type == T_MIX1 && mixer == 0) {
            {
                const int q = wave & 3; const bool helper = wave >= 4;
                LAS float* xs = (LAS float*)(ldsl + q * 25664);
                LAS unsigned short* ssb = (LAS unsigned short*)(ldsl + q * 25664 + 16896);
                volatile LAS unsigned* fl = (volatile LAS unsigned*)(ldsl + q * 25664 + 25600);
                const bf16* U = BIG; bf16* Y = BIG + (size_t)32 * ME;
                const int fr = lane & 15, fq = lane >> 4;
                typedef float f32x2s __attribute__((ext_vector_type(2)));
#define S5_WAIT(idx, target) { while ((int)fl[idx] < (int)(target)) __builtin_amdgcn_s_sleep(1); asm volatile("" ::: "memory"); }
#define S5_POST(idx, val) { asm volatile("s_waitcnt lgkmcnt(0)" ::: "memory"); if (lane == 0) fl[idx] = (unsigned)(val); }
                for (int pair = blockIdx.x * 4 + q; pair < 1024; pair += G * 4) {
                    const int b = pair >> 6, g = pair & 63;
                    __syncthreads();
                    if (!helper && lane == 0) { fl[0] = 0u; fl[1] = 0u; fl[2] = 0u; }
                    __syncthreads();
                    const float dt = expf(INP(8)[jm * 64 + g]);
                    if (!helper) {
                        float are, aim;
                        { const size_t gn = (size_t)jm * 4096 + g * 64 + lane; const float lr = INP(6)[gn], li = INP(7)[gn], mag = expf(lr * dt); are = mag * cosf(li * dt); aim = mag * sinf(li * dt); }
                        float sre = 0.f, sim = 0.f;
#pragma unroll 1
                        for (int blk = 0; blk < 128; ++blk) {
                            S5_WAIT(0, blk + 1) S5_WAIT(2, blk - 1)
                            const LAS float* xrd = xs + (blk & 1) * 2112; LAS unsigned* sw = (LAS unsigned*)(ssb + (blk & 1) * 2176);
                            f32x2s xv[16];
#pragma unroll
                            for (int s = 0; s < 16; ++s) xv[s] = *(const LAS f32x2s*)(xrd + s * 132 + 2 * lane);
#pragma unroll
                            for (int s = 0; s < 16; ++s) { const float nre = are * sre - aim * sim + xv[s].x, nim = are * sim + aim * sre + xv[s].y; sre = nre; sim = nim;
                                sw[s * 68 + lane] = cvtpk_c(sre, sim); }
                            S5_POST(1, blk + 1)
                        }
                    } else {
                        bf16x8 bfr[8];
#pragma unroll
                    for (int j = 0; j < 8; ++j) {
                        const size_t gn = (size_t)jm * 4096 + g * 64 + 8 * j + (fr >> 1); const float lr = INP(6)[gn], li = INP(7)[gn];
                        const float mag = expf(lr * dt), ar = mag * cosf(li * dt), ai = mag * sinf(li * dt), den = lr * lr + li * li, nr = ar - 1.0f;
                        const float cre = (nr * lr + ai * li) / den, cim = (ai * lr - nr * li) / den;
                        const float ca = (fr & 1) ? cim : cre, cb = (fr & 1) ? cre : -cim;
                        unsigned w4[4] = {0u, 0u, 0u, 0u};
                        if (fq < 2) { const f32x4 b0 = *(const GAS f32x4*)(INP(9) + gn * 16 + 8 * fq), b1 = *(const GAS f32x4*)(INP(9) + gn * 16 + 8 * fq + 4), i0 = *(const GAS f32x4*)(INP(10) + gn * 16 + 8 * fq), i1 = *(const GAS f32x4*)(INP(10) + gn * 16 + 8 * fq + 4);
                            w4[0] = pk2(ca * b0[0] + cb * i0[0], ca * b0[1] + cb * i0[1]); w4[1] = pk2(ca * b0[2] + cb * i0[2], ca * b0[3] + cb * i0[3]);
                            w4[2] = pk2(ca * b1[0] + cb * i1[0], ca * b1[1] + cb * i1[1]); w4[3] = pk2(ca * b1[2] + cb * i1[2], ca * b1[3] + cb * i1[3]); }
                        bfr[j] = __builtin_bit_cast(bf16x8, (v4u){w4[0], w4[1], w4[2], w4[3]}); }
                    bf16x8 cfr[4];
#pragma unroll
                    for (int kk = 0; kk < 4; ++kk) { const size_t cb = ((size_t)jm * 64 + g) * 1024 + fr * 64 + 16 * kk + 4 * fq;
                        const f32x4 c0 = *(const GAS f32x4*)(INP(11) + cb), c1 = *(const GAS f32x4*)(INP(12) + cb);
                        cfr[kk] = __builtin_bit_cast(bf16x8, (v4u){pk2(c0[0], -c1[0]), pk2(c0[1], -c1[1]), pk2(c0[2], -c1[2]), pk2(c0[3], -c1[3])}); }
                    bf16x8 dfr;
                    { const float dv = INP(13)[jm * 1024 + g * 16 + fr]; unsigned dw[4] = {0u, 0u, 0u, 0u};
                      if (fq < 2 && (fr >> 3) == fq) { const int e = fr & 7; dw[e >> 1] = (e & 1) ? (f2bf(dv) << 16) : f2bf(dv); }
                      dfr = __builtin_bit_cast(bf16x8, (v4u){dw[0], dw[1], dw[2], dw[3]}); }

                        const bf16* up = U + (size_t)(b * T) * D + g * 16 + 8 * fq;
                        v4u ur0 = (v4u){0u, 0u, 0u, 0u}, ur1 = ur0, ur2 = ur0, ur3 = ur0;
                        if (fq < 2) { ur0 = *(const GAS v4u*)(up + (size_t)fr * D); ur1 = *(const GAS v4u*)(up + (size_t)(16 + fr) * D); ur2 = *(const GAS v4u*)(up + (size_t)(32 + fr) * D); ur3 = *(const GAS v4u*)(up + (size_t)(48 + fr) * D); }
                        bf16x8 u0 = __builtin_bit_cast(bf16x8, (v4u){0u, 0u, 0u, 0u}), u1 = u0;
#define S5_HSTEP(J, UR) { const int blk = i4 + (J); u1 = u0; u0 = __builtin_bit_cast(bf16x8, UR); \
                            if (blk + 4 < 128 && fq < 2) UR = *(const GAS v4u*)(up + (size_t)((blk + 4) * 16 + fr) * D); \
                            if (blk < 128) { S5_WAIT(1, blk - 1) LAS float* xw = xs + (blk & 1) * 2112; \
_Pragma("unroll") \
                                for (int nt = 0; nt < 8; ++nt) { const f32x4 xd = __builtin_amdgcn_mfma_f32_16x16x32_bf16(bfr[nt], u0, (f32x4){0.f, 0.f, 0.f, 0.f}, 0, 0, 0); \
                                    *(LAS f32x4*)(xw + fr * 132 + 16 * nt + 4 * fq) = xd; } \
                                S5_POST(0, blk + 1) } \
                            if (blk >= 1 && blk <= 128) { S5_WAIT(1, blk) const LAS unsigned short* srd = ssb + ((blk - 1) & 1) * 2176; bf16x8 af[4]; \
_Pragma("unroll") \
                                for (int kk = 0; kk < 4; ++kk) af[kk] = *(const LAS bf16x8*)(srd + fr * 136 + 32 * kk + 8 * fq); \
                                S5_POST(2, blk) \
                                f32x4 ya = (f32x4){0.f, 0.f, 0.f, 0.f}; \
_Pragma("unroll") \
                                for (int kk = 0; kk < 4; ++kk) ya = __builtin_amdgcn_mfma_f32_16x16x32_bf16(cfr[kk], af[kk], ya, 0, 0, 0); \
                                ya = __builtin_amdgcn_mfma_f32_16x16x32_bf16(dfr, u1, ya, 0, 0, 0); \
                                float go[4]; \
_Pragma("unroll") \
                                for (int e = 0; e < 4; ++e) { const float yv = ya[e], uu2 = -2.0f * LOG2E * 0.7978845608028654f * (yv + 0.044715f * yv * yv * yv); go[e] = yv * __builtin_amdgcn_rcpf(1.0f + __builtin_amdgcn_exp2f(uu2)); } \
                                { u32x2g w; w.x = cvtpk_c(go[0], go[1]); w.y = cvtpk_c(go[2], go[3]); *(GAS u32x2g*)(Y + (size_t)(b * T + (blk - 1) * 16 + fr) * D + g * 16 + 4 * fq) = w; } } }
#pragma unroll 1
                        for (int i4 = 0; i4 < 132; i4 += 4) { S5_HSTEP(0, ur0) S5_HSTEP(1, ur1) S5_HSTEP(2, ur2) S5_HSTEP(3, ur3) }
#undef S5_HSTEP
                    }
                }
#undef S5_WAIT
#undef S5_POST
            }
        }
        else if (type == T_MIX1 && mixer == 1) {
            if (wave == 0) {
                for (int pair = blockIdx.x; pair < 256; pair += G) { const int b = pair >> 4, hh = pair & 15; const float bf = INP(17)[jm * 16 + hh];
                    float c[32]; float run = 0.f;
#pragma unroll
                    for (int i = 0; i < 32; ++i) { const float x = FLOG[(size_t)(b * T + 32 * lane + i) * 16 + hh] + bf; run += log_sigmoid_f(x); c[i] = run; }
                    float incl = run;
#pragma unroll
                    for (int o = 1; o < 64; o <<= 1) { const float nb = __shfl_up(incl, o); if (lane >= o) incl += nb; }
                    const float excl = incl - run;
#pragma unroll
                    for (int i = 0; i < 32; ++i) NEGF[(size_t)pair * T + 32 * lane + i] = -(c[i] + excl) * LOG2E;
                }
            }
        }
        else if (type == T_MIX2 && mixer == 1) {
            const attn_body::AttnTensors AT{(const attn_body::bf16*)BIG, (const attn_body::bf16*)(BIG + 32 * ME), (const attn_body::bf16*)(BIG + 64 * ME), (attn_body::bf16*)BIG, NEGF};
            const attn_body::StaticOrder S((int)G, (int)blockIdx.x);
            attn_body::attn_phase<attn_body::StaticOrder>((char*)lds + RING_OFF, AT, S);
        }
        else if (type == T_MIX1 && mixer == 2) {
            constexpr int PQD = 136, PSS = 72;
            LAS unsigned short* QD = (LAS unsigned short*)ldsl; LAS unsigned short* KI = QD + 64 * PQD; LAS unsigned short* KUT = KI + 64 * PQD; LAS unsigned short* VT = KUT + 128 * PSS;
            LAS unsigned short* ST = VT + 64 * PSS; LAS unsigned short* ATT = ST + 64 * PQD; LAS float* EB = (LAS float*)(ATT + 64 * PSS); LAS float* PS = EB + 128; LAS float* pq = PS + 512; LAS float* GLs = pq + 256;
            const bf16* QKV = BIG; bf16* OB = PP;
            const int fr = lane & 15, fq = lane >> 4, kk = tid & 127, tq = tid >> 7;
            for (int unit = blockIdx.x; unit < 256; unit += G) {
                const int b = unit >> 4, hh = (unit >> 2) & 3, vsp = unit & 3;
                __syncthreads();
                float wgr[16];
#pragma unroll
                for (int j = 0; j < 16; ++j) wgr[j] = INP(20)[(size_t)jm * 16 * 512 + j * 512 + hh * 128 + kk];
                const float bgr = INP(21)[jm * 512 + hh * 128 + kk];
                if (tid < 256) pq[tid] = ((const float*)(ws + WS_SV) + 32768)[b * 1024 + (tid < 128 ? hh * 128 + tid : 512 + hh * 128 + (tid - 128))];
                for (int i = tid; i < 64 * PQD / 2; i += 512) ((LAS unsigned*)ST)[i] = 0u;
                __syncthreads();
                float c_exact = 0.f;
                if (wave == 0) c_exact = wave_sum(pq[lane] * pq[128 + lane] + pq[64 + lane] * pq[192 + lane]) * 0.08838834764831845f;
                f32x4 Sacc[4];
#pragma unroll
                for (int nt = 0; nt < 4; ++nt) Sacc[nt] = (f32x4){0.f, 0.f, 0.f, 0.f};
                unsigned short qh[16], kh[16]; v4u vreg; f32x4 greg = (f32x4){0.f, 0.f, 0.f, 0.f};
                { const size_t m0 = (size_t)b * T;
#pragma unroll
                  for (int i = 0; i < 16; ++i) { const bf16* rp = QKV + (m0 + 16 * tq + i) * 3072 + hh * 128 + kk; qh[i] = rp[0]; kh[i] = rp[512]; }
                  vreg = *(const GAS v4u*)(QKV + (m0 + (tid >> 3)) * 3072 + 1024 + hh * 256 + vsp * 64 + (tid & 7) * 8);
                  if (tid < 256) greg = *(const GAS f32x4*)(FLOG + (m0 + (tid >> 2)) * 16 + (tid & 3) * 4); }
                for (int c = 0; c < 32; ++c) {
                    const size_t mb = (size_t)b * T + c * 64;
                    if (tid < 256) *(LAS f32x4*)(GLs + tid * 4) = greg;
                    __syncthreads();
                    float bc[16]; float run = 0.f;
#pragma unroll
                    for (int i = 0; i < 16; ++i) { const LAS f32x4* gp = (const LAS f32x4*)(GLs + (16 * tq + i) * 16); const f32x4 g0 = gp[0], g1 = gp[1], g2 = gp[2], g3 = gp[3];
                        float x = bgr;
                        x += g0[0] * wgr[0] + g0[1] * wgr[1] + g0[2] * wgr[2] + g0[3] * wgr[3]; x += g1[0] * wgr[4] + g1[1] * wgr[5] + g1[2] * wgr[6] + g1[3] * wgr[7];
                        x += g2[0] * wgr[8] + g2[1] * wgr[9] + g2[2] * wgr[10] + g2[3] * wgr[11]; x += g3[0] * wgr[12] + g3[1] * wgr[13] + g3[2] * wgr[14] + g3[3] * wgr[15];
                        run -= __builtin_amdgcn_logf(1.0f + __builtin_amdgcn_exp2f(-x * LOG2E)) * (0.6931471805599453f / 16.0f); bc[i] = run; }
                    PS[tq * 128 + kk] = run;
                    __syncthreads();
                    const float p0 = PS[kk], p1 = PS[128 + kk], p2 = PS[256 + kk], p3 = PS[384 + kk];
                    const float off = (tq > 0 ? p0 : 0.f) + (tq > 1 ? p1 : 0.f) + (tq > 2 ? p2 : 0.f), blast = (p0 + p1) + (p2 + p3);
                    if (tq == 0) EB[kk] = __builtin_amdgcn_exp2f(blast * LOG2E);
                    const float ebl = __builtin_amdgcn_exp2f(blast * LOG2E);
                    float kuv[16];
#pragma unroll
                    for (int i = 0; i < 16; ++i) { const int t = 16 * tq + i; const float bcu = bc[i] + off, e1 = __builtin_amdgcn_exp2f(bcu * LOG2E), ie1 = __builtin_amdgcn_rcpf(e1), qv = __uint_as_float((unsigned)qh[i] << 16), kv = __uint_as_float((unsigned)kh[i] << 16);
                        const float ki = kv * ie1;
                        const unsigned pk = cvtpk_c(qv * 0.08838834764831845f * e1, ki); QD[t * PQD + kk] = (unsigned short)pk; KI[t * PQD + kk] = (unsigned short)(pk >> 16);
                        kuv[i] = ki * ebl; }
                    { v4u w0, w1; w0.x = cvtpk_c(kuv[0], kuv[1]); w0.y = cvtpk_c(kuv[2], kuv[3]); w0.z = cvtpk_c(kuv[4], kuv[5]); w0.w = cvtpk_c(kuv[6], kuv[7]); w1.x = cvtpk_c(kuv[8], kuv[9]); w1.y = cvtpk_c(kuv[10], kuv[11]); w1.z = cvtpk_c(kuv[12], kuv[13]); w1.w = cvtpk_c(kuv[14], kuv[15]);
                      *(LAS v4u*)(KUT + kk * PSS + 16 * tq) = w0; *(LAS v4u*)(KUT + kk * PSS + 16 * tq + 8) = w1; }
                    { const int s = tid >> 3, v8 = (tid & 7) * 8; const unsigned w4[4] = {vreg.x, vreg.y, vreg.z, vreg.w};
#pragma unroll
                      for (int e = 0; e < 8; ++e) VT[(v8 + e) * PSS + s] = (unsigned short)((e & 1) ? (w4[e >> 1] >> 16) : (w4[e >> 1] & 0xffffu)); }
                    if (c + 1 < 32) { const size_t m1 = mb + 64;
#pragma unroll
                        for (int i = 0; i < 16; ++i) { const bf16* rp = QKV + (m1 + 16 * tq + i) * 3072 + hh * 128 + kk; qh[i] = rp[0]; kh[i] = rp[512]; }
                        vreg = *(const GAS v4u*)(QKV + (m1 + (tid >> 3)) * 3072 + 1024 + hh * 256 + vsp * 64 + (tid & 7) * 8);
                        if (tid < 256) greg = *(const GAS f32x4*)(FLOG + (m1 + (tid >> 2)) * 16 + (tid & 3) * 4); }
                    __syncthreads();
                    { const int mt = wave >> 1;
#pragma unroll
                      for (int n2 = 0; n2 < 2; ++n2) { const int nt = 2 * (wave & 1) + n2; f32x4 acc = (f32x4){0.f, 0.f, 0.f, 0.f};
                          if (nt <= mt) {
#pragma unroll
                              for (int k4 = 0; k4 < 4; ++k4) { const bf16x8 a = *(const LAS bf16x8*)(QD + (16 * mt + fr) * PQD + 32 * k4 + 8 * fq), bb = *(const LAS bf16x8*)(KI + (16 * nt + fr) * PQD + 32 * k4 + 8 * fq);
                                  acc = __builtin_amdgcn_mfma_f32_16x16x32_bf16(a, bb, acc, 0, 0, 0); }
                              if (nt == mt) {
#pragma unroll
                                  for (int e = 0; e < 4; ++e) if (fr > 4 * fq + e) acc[e] = 0.f; }
                              if (c == 0 && mt == 0 && nt == 0 && lane == 0) acc[0] = c_exact; }
                          { const unsigned p01 = cvtpk_c(acc[0], acc[1]), p23 = cvtpk_c(acc[2], acc[3]); unsigned short* dummy_ = nullptr; (void)dummy_;
                            ATT[(16 * mt + 4 * fq + 0) * PSS + 16 * nt + fr] = (unsigned short)p01; ATT[(16 * mt + 4 * fq + 1) * PSS + 16 * nt + fr] = (unsigned short)(p01 >> 16);
                            ATT[(16 * mt + 4 * fq + 2) * PSS + 16 * nt + fr] = (unsigned short)p23; ATT[(16 * mt + 4 * fq + 3) * PSS + 16 * nt + fr] = (unsigned short)(p23 >> 16); } } }
                    __syncthreads();
                    { const int mt = wave >> 1;
#pragma unroll
                      for (int n2 = 0; n2 < 2; ++n2) { const int nt = 2 * (wave & 1) + n2; f32x4 acc = (f32x4){0.f, 0.f, 0.f, 0.f};
#pragma unroll
                          for (int ks = 0; ks < 2; ++ks) { const bf16x8 a = *(const LAS bf16x8*)(ATT + (16 * mt + fr) * PSS + 32 * ks + 8 * fq), bb = *(const LAS bf16x8*)(VT + (16 * nt + fr) * PSS + 32 * ks + 8 * fq);
                              acc = __builtin_amdgcn_mfma_f32_16x16x32_bf16(a, bb, acc, 0, 0, 0); }
#pragma unroll
                          for (int k4 = 0; k4 < 4; ++k4) { const bf16x8 a = *(const LAS bf16x8*)(QD + (16 * mt + fr) * PQD + 32 * k4 + 8 * fq), bb = *(const LAS bf16x8*)(ST + (16 * nt + fr) * PQD + 32 * k4 + 8 * fq);
                              acc = __builtin_amdgcn_mfma_f32_16x16x32_bf16(a, bb, acc, 0, 0, 0); }
                          { const unsigned p01 = cvtpk_c(acc[0], acc[1]), p23 = cvtpk_c(acc[2], acc[3]); bf16* op = OB + (mb + 16 * mt + 4 * fq) * D + hh * 256 + vsp * 64 + 16 * nt + fr;
                            op[0] = (bf16)p01; op[D] = (bf16)(p01 >> 16); op[2 * D] = (bf16)p23; op[3 * D] = (bf16)(p23 >> 16); } } }
                    { const int mt = wave;
                      const f32x4 ebv = *(const LAS f32x4*)(EB + 16 * mt + 4 * fq);
#pragma unroll
                      for (int nt = 0; nt < 4; ++nt) { f32x4 acc = Sacc[nt] * ebv;
#pragma unroll
                          for (int ks = 0; ks < 2; ++ks) { const bf16x8 a = *(const LAS bf16x8*)(KUT + (16 * mt + fr) * PSS + 32 * ks + 8 * fq), bb = *(const LAS bf16x8*)(VT + (16 * nt + fr) * PSS + 32 * ks + 8 * fq);
                              acc = __builtin_amdgcn_mfma_f32_16x16x32_bf16(a, bb, acc, 0, 0, 0); }
                          Sacc[nt] = acc; } }
                    __syncthreads();
                    { const int mt = wave;
#pragma unroll
                      for (int nt = 0; nt < 4; ++nt) { u32x2g w; w.x = cvtpk_c(Sacc[nt][0], Sacc[nt][1]); w.y = cvtpk_c(Sacc[nt][2], Sacc[nt][3]); *(LAS u32x2g*)(ST + (16 * nt + fr) * PQD + 16 * mt + 4 * fq) = w; } }
                }
            }
        }
        else if (type == T_MIX2 && mixer == 2) {
            const bf16* OB = PP; const bf16* R = BIG + 2048; bf16* AO = PP;
            for (int it = gw; it < M * 4; it += NGW) { const size_t m = (size_t)(it >> 2); const int hh = it & 3, col = hh * 256 + 4 * lane;
                const u32x2g ow = *(const GAS u32x2g*)(OB + m * D + col), rw = *(const GAS u32x2g*)(R + m * 3072 + col);
                const f32x4 gn = *(const GAS f32x4*)(INP(22) + jm * 1024 + col);
                const float o0 = bf_lo(ow.x), o1 = bf_hi(ow.x), o2 = bf_lo(ow.y), o3 = bf_hi(ow.y);
                const float ss = wave_sum((o0 * o0 + o1 * o1) + (o2 * o2 + o3 * o3)); const float rn = rsqrtf(ss * (1.0f / 256.0f) + 1e-6f);
                const float r0 = bf_lo(rw.x), r1 = bf_hi(rw.x), r2 = bf_lo(rw.y), r3 = bf_hi(rw.y);
                u32x2g w; w.x = pk2(o0 * rn * gn[0] * r0 * sigmoid_f(r0), o1 * rn * gn[1] * r1 * sigmoid_f(r1)); w.y = pk2(o2 * rn * gn[2] * r2 * sigmoid_f(r2), o3 * rn * gn[3] * r3 * sigmoid_f(r3));
                *(GAS u32x2g*)(AO + m * D + col) = w; }
        }
        else if (type == T_UP0) {
            const float* P = INP(1) + (size_t)layer * M * 256;
            for (size_t idx = (size_t)gtid * 8; idx < (size_t)M * 256; idx += (size_t)NT * 16) { const size_t id2 = (idx + (size_t)NT * 8 < (size_t)M * 256) ? idx + (size_t)NT * 8 : idx;
                const f32x4 a = *(const GAS f32x4*)(P + idx), b2 = *(const GAS f32x4*)(P + idx + 4), c = *(const GAS f32x4*)(P + id2), d2 = *(const GAS f32x4*)(P + id2 + 4);
                v4u o; o.x = pk2(a[0], a[1]); o.y = pk2(a[2], a[3]); o.z = pk2(b2[0], b2[1]); o.w = pk2(b2[2], b2[3]); *(GAS v4u*)(PB + idx) = o;
                v4u o2; o2.x = pk2(c[0], c[1]); o2.y = pk2(c[2], c[3]); o2.z = pk2(d2[0], d2[1]); o2.w = pk2(d2[2], d2[3]); *(GAS v4u*)(PB + id2) = o2; }
        }
        else if (type == T_FINAL) {
            const float* ssq = (const float*)(ws + WS_SSQA);
            const GAS f32x4* gf = (const GAS f32x4*)INP(28) + lane; const f32x4 g0 = gf[0], g1 = gf[64], g2 = gf[128], g3 = gf[192];
            for (int m = gw; m < M; m += 2 * NGW) {
                const int m2 = (m + NGW < M) ? m + NGW : m;
                u32x2g w[2][4]; float sq[2];
#pragma unroll
                for (int r = 0; r < 2; ++r) { const int mr = r ? m2 : m; const GAS u32x2g* br = (const GAS u32x2g*)(PB + (size_t)mr * D) + lane;
                    w[r][0] = br[0]; w[r][1] = br[64]; w[r][2] = br[128]; w[r][3] = br[192]; sq[r] = lane < 16 ? ssq[(size_t)mr * 16 + lane] : 0.f; }
#pragma unroll
                for (int r = 0; r < 2; ++r) { const int mr = r ? m2 : m; GAS f32x4* hr = (GAS f32x4*)(h + (size_t)mr * D) + lane;
                    const float rs = rsqrtf(wave_sum(sq[r]) * (1.0f / 1024.0f) + 1e-6f);
                    hr[0] = (f32x4){bf_lo(w[r][0].x), bf_hi(w[r][0].x), bf_lo(w[r][0].y), bf_hi(w[r][0].y)} * rs * g0; hr[64] = (f32x4){bf_lo(w[r][1].x), bf_hi(w[r][1].x), bf_lo(w[r][1].y), bf_hi(w[r][1].y)} * rs * g1;
                    hr[128] = (f32x4){bf_lo(w[r][2].x), bf_hi(w[r][2].x), bf_lo(w[r][2].y), bf_hi(w[r][2].y)} * rs * g2; hr[192] = (f32x4){bf_lo(w[r][3].x), bf_hi(w[r][3].x), bf_lo(w[r][3].y), bf_hi(w[r][3].y)} * rs * g3; } }
        }

        } }
        for (int job = 0; job < 2; ++job) {
            int kind = -1;
            pg8::Gemm g{nullptr, nullptr, M, D, D};
            pg8::bf16_t* aO = nullptr; int aldc = D; const float* assq = nullptr; int asplit = 0; size_t astride = 0; float ascale = 1.f; float* aft = nullptr; int afc = 1 << 30;
            const pg8::bf16_t* rbase = HB; pg8::bf16_t* rhb = HB; const float* rssi = nullptr; float* rsso = nullptr;
            if (job == 0) {
                if (type == T_INPROJ) { kind = 0; g.A = PB; assq = ssq0;
                    if (mixer == 0) { g.Bt = Wb + W_S5IN + jm * W_S5STRIDE; g.N = 1024; aO = BIG; aldc = 1024; }
                    else if (mixer == 1) { g.Bt = Wb + W_FOXIN; g.N = 3328; aO = BIG; aldc = 1024; asplit = 1024; astride = 32 * ME; ascale = attn_body::C2; aft = FLOG; afc = 3072; }
                    else { g.Bt = Wb + W_GLAIN; g.N = 3328; aO = BIG; aldc = 3072; aft = FLOG; afc = 3072; } }
                else if (type == T_MIX2 && mixer == 0) { kind = 2; g.A = BIG + 32 * ME; g.Bt = Wb + W_S5GLU + jm * W_S5STRIDE; g.N = 2048; aO = BIG + 64 * ME; aldc = 1024; }
                else if (type == T_OUTPROJ) { kind = 3; g.A = (mixer == 0) ? BIG + 64 * ME : (mixer == 1) ? BIG : PP; g.Bt = Wb + ((mixer == 0) ? W_S5OUT + jm * W_S5STRIDE : (mixer == 1) ? W_FOXOUT : W_GLAOUT);
                    rbase = PB; rsso = ssq1; }
                else if (type == T_UP0 || type == T_UP1) { const int hf = (type == T_UP1); kind = 1; g.A = HB + (size_t)hf * 16 * ME; g.Bt = Wb + W_MLP1 + layer * W_MLPSTRIDE; g.M = M / 2; g.N = FF;
                    aO = BIG; aldc = FF; assq = ssq1 + (size_t)hf * (M / 2) * 16; }
                else if (type == T_DOWN0 || type == T_DOWN1) { const int hf = (type == T_DOWN1); kind = 3; g.A = BIG; g.Bt = Wb + W_MLP2 + layer * W_MLPSTRIDE; g.M = M / 2; g.K = FF;
                    rbase = HB + (size_t)hf * 16 * ME; rhb = HB + (size_t)hf * 16 * ME; rsso = ssq2 + (size_t)hf * (M / 2) * 16; }
                else if (type == T_PLE) { kind = 4; g.A = HB; g.Bt = Wb + W_PLEG + layer * W_PLESTRIDE; rssi = ssq2; rsso = ssq3; rhb = PB; }
            } else {
                if (type == T_DOWN0) { kind = 0; g.A = PB; g.Bt = Wb + W_PLEP + layer * W_PLESTRIDE; g.K = 256; aO = PP; aldc = 1024; }
            }
            if (kind < 0) continue;
            pg8::StaticOrder S; S.init(g.M, g.N, G, (int)blockIdx.x);
            for (int grep_ = 0; grep_ < ((kind <= 2) ? MK_DUP_G : 1); ++grep_)
            if (kind == 0) { pg8::EpiAct<0> E{aO, aldc, assq, asplit, astride, ascale, aft, afc}; pg8::gemm_phase<pg8::EpiAct<0>, pg8::StaticOrder, true, true>(ldsl + RING_OFF, g, S, E); }
            else if (kind == 1) { pg8::EpiAct<1> E{aO, aldc, assq, 0, 0, 1.f, nullptr, 1 << 30}; pg8::gemm_phase<pg8::EpiAct<1>, pg8::StaticOrder, true, true>(ldsl + RING_OFF, g, S, E); }
            else if (kind == 2) { pg8::EpiAct<2> E{aO, aldc, nullptr, 0, 0, 1.f, nullptr, 1 << 30}; pg8::gemm_phase<pg8::EpiAct<2>, pg8::StaticOrder, true, true>(ldsl + RING_OFF, g, S, E); }
            else if (kind == 3) { pg8::EpiRes<0> E{rbase, rhb, nullptr, rsso, nullptr, D}; pg8::gemm_phase<pg8::EpiRes<0>, pg8::StaticOrder, true, true>(ldsl + RING_OFF, g, S, E); }
            else { pg8::EpiRes<1> E{rbase, rhb, rssi, rsso, PP, D}; pg8::gemm_phase<pg8::EpiRes<1>, pg8::StaticOrder, true, true>(ldsl + RING_OFF, g, S, E); }
        }

        if (ph + 1 < args.ph_hi) {
#if !MK_PER_PHASE
#if MK_USE_CG
            grid.sync();
#else
            if (ph == args.ph_lo) grid.sync(); else xcd_barrier(bar);
#endif
#endif
        }
    }
}

#undef ws
#undef h
#undef Wb
#undef HB
#undef PB
#undef PP
#undef BIG
#undef FLOG
#undef NEGF
#undef ssq0
#undef ssq1
#undef ssq2
#undef ssq3
extern "C" void kernel_launch(void* const* d_in, const int* in_sizes, int n_in, void* d_out, int out_size, void* d_ws, size_t ws_size, hipStream_t stream) {
    static int grid = 0;
    if (grid == 0) {
        if (n_in != 29 || in_sizes[0] != M * D || out_size != M * D || ws_size < WS_END) { fprintf(stderr, "kernel_launch: unexpected shapes: n_in %d in0 %d out %d ws %zu (need %zu)\n", n_in, n_in > 0 ? in_sizes[0] : -1, out_size, ws_size, (size_t)WS_END); grid = -1; return; }
        int dev = 0, cus = 0, per_cu = 0;
        if (hipGetDevice(&dev) != hipSuccess || hipDeviceGetAttribute(&cus, hipDeviceAttributeMultiprocessorCount, dev) != hipSuccess) { grid = -1; return; }
        if (hipFuncSetAttribute((const void*)trunk_fwd, hipFuncAttributeMaxDynamicSharedMemorySize, LDS_BYTES) != hipSuccess) { fprintf(stderr, "kernel_launch: hipFuncSetAttribute failed\n"); grid = -1; return; }
        if (hipOccupancyMaxActiveBlocksPerMultiprocessor(&per_cu, (const void*)trunk_fwd, NWAVES * 64, LDS_BYTES) != hipSuccess || per_cu < 1) { fprintf(stderr, "kernel_launch: occupancy query says %d\n", per_cu); per_cu = 1; }
        (void)hipGetLastError();
        grid = cus;
    }
    if (grid < 0) return;
    (void)hipMemsetAsync((char*)d_ws + WS_CTL, 0, CTL_ZERO_BYTES, stream);
    Args a{};
    for (int i = 0; i < 29; ++i) a.in[i] = (const float*)d_in[i];
    a.out = (float*)d_out; a.ws = (unsigned char*)d_ws;
#if MK_PER_PHASE
    for (int ph = 0; ph < N_PHASES; ++ph) { a.ph_lo = ph; a.ph_hi = ph + 1; hipLaunchKernelGGL(trunk_fwd, dim3(grid), dim3(NWAVES * 64), LDS_BYTES, stream, a); }
#else
    a.ph_lo = 0; a.ph_hi = N_PHASES;
    void* kargs[] = {&a};
    hipError_t e = hipLaunchCooperativeKernel((const void*)trunk_fwd, dim3(grid), dim3(NWAVES * 64), kargs, LDS_BYTES, stream);
    if (e != hipSuccess) fprintf(stderr, "kernel_launch: cooperative launch failed: %s (grid %d)\n", hipGetErrorString(e), grid);
#endif
}
```

```cpp
#include <hip/hip_runtime.h>
#include <hip/hip_cooperative_groups.h>
#include <cstdio>
#include <cstdint>
#include <hip/hip_bf16.h>
#include <cmath>
namespace pg8 {
#define PG8_LAS __attribute__((address_space(3)))
typedef unsigned short bf16_t;
typedef short bf16x8 __attribute__((ext_vector_type(8)));
typedef float f32x4 __attribute__((ext_vector_type(4)));
typedef unsigned u32x4 __attribute__((ext_vector_type(4)));
constexpr int BM = 256, BK = 64, HALF = 128, HTB = HALF * BK * 2  , STAGE_BYTES = 8 * HTB, NXCD = 8, WGM = 8;

__host__ __device__ __forceinline__ int lds_byte(int r, int c) { const int st = (r >> 4) * 2 + (c >> 5), rr = r & 15, cc = c & 31, ob = rr * 64 + cc * 2; return st * 1024 + (ob ^ (((ob >> 9) & 1) << 5)); }
__host__ __device__ __forceinline__ void stage_rc(int b, int& R, int& C) { const int st = b / 1024, sb = b % 1024, swz = sb ^ (((sb >> 9) & 1) << 5); R = (st >> 1) * 16 + swz / 64; C = (st & 1) * 32 + (swz % 64) / 2; }
__host__ __device__ __forceinline__ int perm32(int rho) { const int n = rho >> 4, i = rho & 15; return 8 * (i >> 2) + 4 * n + (i & 3); }

struct Unit { int pm, pn; };
struct Gemm { const bf16_t* A; const bf16_t* Bt; int M, N, K; };

struct StaticOrder {
    int nM, nN, nwg, G, c;
    __host__ __device__ void init(int M, int N, int G_, int c_) { nM = M / BM; nN = N / BM; nwg = nM * nN; G = G_; c = c_; }
    __host__ __device__ bool next(int i, Unit& u) const {
        const long L = (long)i * G + c; if (L >= nwg) return false;
        int wgid = (int)L; { const int q = nwg / NXCD, r = nwg % NXCD, xcd = wgid % NXCD, off = wgid / NXCD; wgid = (xcd < r ? xcd * (q + 1) : r * (q + 1) + (xcd - r) * q) + off; }
        const int nig = WGM * nN, gid = wgid / nig, fm = gid * WGM, gsz = (nM - fm) < WGM ? (nM - fm) : WGM;
        u.pm = fm + ((wgid % nig) % gsz); u.pn = (wgid % nig) / gsz; return true;
    }
    __device__ __forceinline__ void a_ready(const Unit&) const {}
    __device__ __forceinline__ void done(const Unit&) const {}
};

__device__ __forceinline__ unsigned cvt_pk_bf16(float lo, float hi) { unsigned r; asm volatile("v_cvt_pk_bf16_f32 %0, %1, %2" : "=v"(r) : "v"(lo), "v"(hi)); return r; }
typedef float f32x2 __attribute__((ext_vector_type(2)));
typedef unsigned u32x2 __attribute__((ext_vector_type(2)));
__device__ __forceinline__ float sigm(float x) { return 1.0f / (1.0f + __expf(-x)); }
__device__ __forceinline__ float row_rstd(const float* ssq, size_t row) {
    const f32x4* s = (const f32x4*)(ssq + row * 16); const f32x4 a = (s[0] + s[1]) + (s[2] + s[3]);
    return rsqrtf(((a[0] + a[1]) + (a[2] + a[3])) * (1.0f / 1024.0f) + 1e-6f);
}
template <int MODE> struct EpiAct {
    static constexpr bool PERM = true, AFTER_DRAIN = false;
    bf16_t* O; int ldc; const float* ssq; int split_cols; size_t split_stride; float scale0; float* ftile; int fcol0;
    __device__ __forceinline__ void operator()(const f32x4 (&acc)[2][2][4][2], const Unit& u, int wr, int wc, int fr, int fq) const {
        const int row0 = u.pm * BM + wr * 64 + fr; int colt = u.pn * BM; bf16_t* base = O;
        float rs[2][4];
#pragma unroll
        for (int ai = 0; ai < 2; ++ai)
#pragma unroll
            for (int m = 0; m < 4; ++m) rs[ai][m] = ssq ? row_rstd(ssq, (size_t)(row0 + ai * HALF + m * 16)) : 1.0f;
        if (MODE == 0 && ftile != nullptr && colt >= fcol0) {
            if (wc == 0 && fq < 2) {
#pragma unroll
                for (int ai = 0; ai < 2; ++ai)
#pragma unroll
                    for (int m = 0; m < 4; ++m) { float* dst = ftile + (size_t)(row0 + ai * HALF + m * 16) * 16 + 8 * fq;
                        *(f32x4*)dst = acc[ai][0][m][0] * rs[ai][m]; *(f32x4*)(dst + 4) = acc[ai][0][m][1] * rs[ai][m]; }
            }
            return;
        }
        if (MODE == 2) {
            const int col0 = u.pn * HALF + wc * 32 + 8 * fq;
#pragma unroll
            for (int ai = 0; ai < 2; ++ai)
#pragma unroll
                for (int m = 0; m < 4; ++m) { bf16_t* rowp = base + (size_t)(row0 + ai * HALF + m * 16) * ldc + col0;
                    const f32x4 a0 = acc[ai][0][m][0], a1 = acc[ai][0][m][1], g0 = acc[ai][1][m][0], g1 = acc[ai][1][m][1];
                    u32x4 w; w.x = cvt_pk_bf16(a0[0] * sigm(g0[0]), a0[1] * sigm(g0[1])); w.y = cvt_pk_bf16(a0[2] * sigm(g0[2]), a0[3] * sigm(g0[3]));
                    w.z = cvt_pk_bf16(a1[0] * sigm(g1[0]), a1[1] * sigm(g1[1])); w.w = cvt_pk_bf16(a1[2] * sigm(g1[2]), a1[3] * sigm(g1[3]));
                    *(u32x4*)rowp = w; }
            return;
        }
        float sc = 1.f; if (split_cols) { const int t = colt / split_cols; base += (size_t)t * split_stride; colt -= t * split_cols; if (t == 0) sc = scale0; }
        const int col0 = colt + wc * 32 + 8 * fq;
#pragma unroll
        for (int ai = 0; ai < 2; ++ai)
#pragma unroll
            for (int m = 0; m < 4; ++m) { bf16_t* rowp = base + (size_t)(row0 + ai * HALF + m * 16) * ldc + col0; const float s = rs[ai][m] * sc;
#pragma unroll
                for (int bj = 0; bj < 2; ++bj) { f32x4 v0 = acc[ai][bj][m][0] * s, v1 = acc[ai][bj][m][1] * s;
                    if (MODE == 1) {
#pragma unroll
                        for (int e = 0; e < 4; ++e) { const float a = fmaxf(v0[e], 0.f), b = fmaxf(v1[e], 0.f); v0[e] = a * a; v1[e] = b * b; } }
                    u32x4 w; w.x = cvt_pk_bf16(v0[0], v0[1]); w.y = cvt_pk_bf16(v0[2], v0[3]); w.z = cvt_pk_bf16(v1[0], v1[1]); w.w = cvt_pk_bf16(v1[2], v1[3]);
                    *(u32x4*)(rowp + bj * HALF) = w; } }
    }
};
#ifndef MK_BF16_RES
#define MK_BF16_RES 1
#endif
template <int MODE> struct EpiRes {
    static constexpr bool PERM = true, AFTER_DRAIN = false;
    const bf16_t* baseb; bf16_t* hb; const float* ssq_in; float* ssq_out; const bf16_t* pp; int ldc;
    __device__ __forceinline__ void operator()(const f32x4 (&acc)[2][2][4][2], const Unit& u, int wr, int wc, int fr, int fq) const {
        const int col0 = u.pn * BM + wc * 32 + 8 * fq;
        constexpr int MB = (MODE == 1) ? 2 : 4;
#pragma unroll
        for (int ai = 0; ai < 2; ++ai)
#pragma unroll
            for (int m0 = 0; m0 < 4; m0 += MB) {
                u32x4 pre[MB][2]; u32x4 ppw[MB][2]; float rs[MB];
#pragma unroll
                for (int mm = 0; mm < MB; ++mm) { const int r = u.pm * BM + ai * HALF + wr * 64 + (m0 + mm) * 16 + fr; const size_t off = (size_t)r * ldc + col0;
                    rs[mm] = 1.f; if (MODE == 1) rs[mm] = row_rstd(ssq_in, (size_t)r);
#pragma unroll
                    for (int bj = 0; bj < 2; ++bj) { pre[mm][bj] = *(const u32x4*)(baseb + off + bj * HALF); if (MODE == 1) ppw[mm][bj] = *(const u32x4*)(pp + off + bj * HALF); } }
#pragma unroll
                for (int mm = 0; mm < MB; ++mm) { const int m = m0 + mm; const int r = u.pm * BM + ai * HALF + wr * 64 + m * 16 + fr; const size_t off = (size_t)r * ldc + col0;
                    float q = 0.f;
#pragma unroll
                    for (int bj = 0; bj < 2; ++bj) { const size_t o2 = off + bj * HALF; f32x4 v[2];
#pragma unroll
                        for (int n = 0; n < 2; ++n) { const unsigned b0 = n ? pre[mm][bj].z : pre[mm][bj].x, b1 = n ? pre[mm][bj].w : pre[mm][bj].y;
                            const f32x4 b = (f32x4){__uint_as_float(b0 << 16), __uint_as_float(b0 & 0xffff0000u), __uint_as_float(b1 << 16), __uint_as_float(b1 & 0xffff0000u)}; const f32x4 a = acc[ai][bj][m][n];
                            if (MODE == 1) { const unsigned w0 = n ? ppw[mm][bj].z : ppw[mm][bj].x, w1 = n ? ppw[mm][bj].w : ppw[mm][bj].y;
                                const float p0 = __uint_as_float(w0 << 16), p1 = __uint_as_float(w0 & 0xffff0000u), p2 = __uint_as_float(w1 << 16), p3 = __uint_as_float(w1 & 0xffff0000u);
                                v[n][0] = b[0] + p0 * sigm(a[0] * rs[mm]); v[n][1] = b[1] + p1 * sigm(a[1] * rs[mm]); v[n][2] = b[2] + p2 * sigm(a[2] * rs[mm]); v[n][3] = b[3] + p3 * sigm(a[3] * rs[mm]); }
                            else v[n] = b + a; }
                        u32x4 w; w.x = cvt_pk_bf16(v[0][0], v[0][1]); w.y = cvt_pk_bf16(v[0][2], v[0][3]); w.z = cvt_pk_bf16(v[1][0], v[1][1]); w.w = cvt_pk_bf16(v[1][2], v[1][3]); *(u32x4*)(hb + o2) = w;
                        const float r0 = __uint_as_float(w.x << 16), r1 = __uint_as_float(w.x & 0xffff0000u), r2 = __uint_as_float(w.y << 16), r3 = __uint_as_float(w.y & 0xffff0000u);
                        const float r4 = __uint_as_float(w.z << 16), r5 = __uint_as_float(w.z & 0xffff0000u), r6 = __uint_as_float(w.w << 16), r7 = __uint_as_float(w.w & 0xffff0000u);
                        q += ((r0 * r0 + r1 * r1) + (r2 * r2 + r3 * r3)) + ((r4 * r4 + r5 * r5) + (r6 * r6 + r7 * r7)); }
                    q += __shfl_xor(q, 16); q += __shfl_xor(q, 32);
                    if (fq == 0) ssq_out[(size_t)r * 16 + u.pn * 4 + wc] = q; }
                asm volatile("" ::: "memory"); }
    }
};
template <class Epi, class Sched, bool ALIGN_EPI = false, bool SP2 = false>
__device__ __forceinline__ void gemm_phase(PG8_LAS unsigned char* lds, const Gemm g, const Sched& S, const Epi& E) {
    int tid_ = threadIdx.x; asm volatile("" : "+v"(tid_)); const int tid = tid_, wid = __builtin_amdgcn_readfirstlane(tid >> 6), lane = tid & 63, wr = wid >> 2, wc = wid & 3, fr = lane & 15, fq = lane >> 4;
    const int K = g.K, nt = K / BK;
    unsigned voffA[2], voffB[2];
#pragma unroll
    for (int i = 0; i < 2; ++i) { int R, C; stage_rc(tid * 16 + i * 8192, R, C); const int Rb = Epi::PERM ? ((R & ~31) + perm32(R & 31)) : R;
        voffA[i] = (unsigned)(R * K + C) * 2u; voffB[i] = (unsigned)(Rb * K + C) * 2u; }
    const size_t kstep = (size_t)(BK * 2);
    const size_t hstep = (size_t)HALF * K * 2;
    const size_t tstep = 2 * hstep;
    const unsigned ldsw = (unsigned)wid * 1024u;
    const int aoff = lds_byte(wr * 64 + fr, fq * 8), boff = lds_byte(wc * 32 + fr, fq * 8);
#define PG8_SA(b, h) (((b) * 2 + (h)) * HTB)
#define PG8_SB(b, h) ((4 + (b) * 2 + (h)) * HTB)
#define PG8_STAGE(bufoff, gbase, voff) do { _Pragma("unroll") for (int _i = 0; _i < 2; ++_i) \
        __builtin_amdgcn_global_load_lds((const unsigned*)((const char*)(gbase) + (voff)[_i]), (PG8_LAS unsigned*)(lds + (bufoff) + ldsw + _i * 8192), 16, 0, 0); } while (0)
#define PG8_LDA(dst, b, h) do { _Pragma("unroll") for (int m = 0; m < 4; ++m) _Pragma("unroll") for (int k = 0; k < 2; ++k) dst[m][k] = *(const PG8_LAS bf16x8*)(lds + PG8_SA(b, h) + aoff + m * 2048 + k * 1024); } while (0)
#define PG8_LDB(dst, b, h) do { _Pragma("unroll") for (int n = 0; n < 2; ++n) _Pragma("unroll") for (int k = 0; k < 2; ++k) dst[n][k] = *(const PG8_LAS bf16x8*)(lds + PG8_SB(b, h) + boff + n * 2048 + k * 1024); } while (0)
#define PG8_MMA(ai, bj, At, Bt) do { __builtin_amdgcn_s_setprio(1); _Pragma("unroll") for (int m = 0; m < 4; ++m) _Pragma("unroll") for (int n = 0; n < 2; ++n) _Pragma("unroll") for (int k = 0; k < 2; ++k) \
        acc[ai][bj][m][n] = __builtin_amdgcn_mfma_f32_16x16x32_bf16(Bt[n][k], At[m][k], acc[ai][bj][m][n], 0, 0, 0); __builtin_amdgcn_s_setprio(0); } while (0)
#define PG8_WAIT_V(n) asm volatile("s_waitcnt vmcnt(" #n ")" ::: "memory")
#define PG8_WAIT_L(n) asm volatile("s_waitcnt lgkmcnt(" #n ")" ::: "memory")
#define PG8_BAR __builtin_amdgcn_s_barrier()
#define PG8_SCHED __builtin_amdgcn_sched_barrier(0)
    Unit cur, nxt; int ui = 0;
    if (!S.next(0, cur)) return;
    f32x4 acc[2][2][4][2];
#pragma unroll
    for (int a = 0; a < 2; ++a)
#pragma unroll
        for (int b = 0; b < 2; ++b)
#pragma unroll
            for (int m = 0; m < 4; ++m)
#pragma unroll
                for (int n = 0; n < 2; ++n) acc[a][b][m][n] = (f32x4){0.f, 0.f, 0.f, 0.f};
    bf16x8 At[4][2], B0[2][2], B1[2][2];
    const char* cA = (const char*)g.A + (size_t)cur.pm * tstep; const char* cB = (const char*)g.Bt + (size_t)cur.pn * tstep;
    S.a_ready(cur);
    if constexpr (SP2) {
        PG8_STAGE(PG8_SB(0, 0), cB, voffB); PG8_STAGE(PG8_SB(0, 1), cB + hstep, voffB); PG8_STAGE(PG8_SA(0, 0), cA, voffA); PG8_STAGE(PG8_SA(0, 1), cA + hstep, voffA);
        if (wr == 1) PG8_BAR;
        PG8_WAIT_V(2); PG8_BAR;
        PG8_STAGE(PG8_SB(1, 0), cB + kstep, voffB); PG8_STAGE(PG8_SA(1, 0), cA + kstep, voffA); PG8_STAGE(PG8_SB(1, 1), cB + hstep + kstep, voffB);
        PG8_WAIT_V(6); PG8_BAR;
    } else {
        PG8_STAGE(PG8_SB(0, 0), cB, voffB); PG8_STAGE(PG8_SA(0, 0), cA, voffA); PG8_STAGE(PG8_SB(0, 1), cB + hstep, voffB); PG8_STAGE(PG8_SA(0, 1), cA + hstep, voffA);
        if (wr == 1) PG8_BAR;
        PG8_WAIT_V(4); PG8_BAR;
        PG8_STAGE(PG8_SB(1, 0), cB + kstep, voffB); PG8_STAGE(PG8_SA(1, 0), cA + kstep, voffA); PG8_STAGE(PG8_SB(1, 1), cB + hstep + kstep, voffB);
        PG8_WAIT_V(6); PG8_BAR;
    }
    for (;;) {
        const bool has_next = S.next(ui + 1, nxt);
        const char* nA = has_next ? (const char*)g.A + (size_t)nxt.pm * tstep : cA; const char* nB = has_next ? (const char*)g.Bt + (size_t)nxt.pn * tstep : cB;
        for (int t = 0; t < nt; t += 2) {
            const bool last = (t == nt - 2);
            const char* a1 = cA + (size_t)(t + 1) * kstep;
            const char* a2 = last ? nA : cA + (size_t)(t + 2) * kstep; const char* b2 = last ? nB : cB + (size_t)(t + 2) * kstep;
            const char* a3 = a2 + kstep; const char* b3 = b2 + kstep;
            if (last && has_next) S.a_ready(nxt);
            if constexpr (SP2) {
            PG8_LDB(B0, 0, 0); PG8_LDB(B1, 0, 1); PG8_SCHED; PG8_LDA(At, 0, 0); PG8_STAGE(PG8_SA(1, 1), a1 + hstep, voffA);
            PG8_WAIT_V(8); PG8_WAIT_L(0); PG8_BAR; PG8_MMA(0, 0, At, B0); PG8_MMA(0, 1, At, B1); PG8_BAR; PG8_SCHED;
            PG8_LDA(At, 0, 1); PG8_STAGE(PG8_SB(0, 0), b2, voffB); PG8_STAGE(PG8_SB(0, 1), b2 + hstep, voffB); PG8_STAGE(PG8_SA(0, 0), a2, voffA);
            PG8_WAIT_V(8); PG8_WAIT_L(0); PG8_BAR; PG8_MMA(1, 0, At, B0); PG8_MMA(1, 1, At, B1); PG8_BAR; PG8_SCHED;
            PG8_LDB(B0, 1, 0); PG8_LDB(B1, 1, 1); PG8_SCHED; PG8_LDA(At, 1, 0); PG8_STAGE(PG8_SA(0, 1), a2 + hstep, voffA);
            PG8_WAIT_V(8); PG8_WAIT_L(0); PG8_BAR; PG8_MMA(0, 0, At, B0); PG8_MMA(0, 1, At, B1); PG8_BAR; PG8_SCHED;
            PG8_LDA(At, 1, 1); PG8_STAGE(PG8_SB(1, 0), b3, voffB); PG8_STAGE(PG8_SB(1, 1), b3 + hstep, voffB); PG8_STAGE(PG8_SA(1, 0), a3, voffA);
            PG8_WAIT_V(8); PG8_WAIT_L(0); PG8_BAR; PG8_MMA(1, 0, At, B0); PG8_MMA(1, 1, At, B1); PG8_BAR; PG8_SCHED;
            } else {
            PG8_LDB(B0, 0, 0); PG8_SCHED; PG8_LDA(At, 0, 0); PG8_STAGE(PG8_SA(1, 1), a1 + hstep, voffA);
            PG8_WAIT_L(8); PG8_BAR; PG8_WAIT_L(0); PG8_MMA(0, 0, At, B0); PG8_BAR; PG8_SCHED;
            PG8_LDB(B1, 0, 1); PG8_STAGE(PG8_SB(0, 0), b2, voffB);
            PG8_BAR; PG8_WAIT_L(0); PG8_MMA(0, 1, At, B1); PG8_BAR;
            PG8_LDA(At, 0, 1); PG8_STAGE(PG8_SA(0, 0), a2, voffA);
            PG8_BAR; PG8_WAIT_L(0); PG8_MMA(1, 0, At, B0); PG8_BAR; PG8_SCHED;
            PG8_STAGE(PG8_SB(0, 1), b2 + hstep, voffB);
            PG8_WAIT_V(6); PG8_BAR; PG8_MMA(1, 1, At, B1); PG8_BAR;
            PG8_LDB(B0, 1, 0); PG8_SCHED; PG8_LDA(At, 1, 0); PG8_STAGE(PG8_SA(0, 1), a2 + hstep, voffA);
            PG8_WAIT_L(8); PG8_BAR; PG8_WAIT_L(0); PG8_MMA(0, 0, At, B0); PG8_BAR; PG8_SCHED;
            PG8_LDB(B1, 1, 1); PG8_STAGE(PG8_SB(1, 0), b3, voffB);
            PG8_BAR; PG8_WAIT_L(0); PG8_MMA(0, 1, At, B1); PG8_BAR;
            PG8_LDA(At, 1, 1); PG8_STAGE(PG8_SA(1, 0), a3, voffA);
            PG8_BAR; PG8_WAIT_L(0); PG8_MMA(1, 0, At, B0); PG8_BAR; PG8_SCHED;
            PG8_STAGE(PG8_SB(1, 1), b3 + hstep, voffB);
            PG8_WAIT_V(6); PG8_BAR; PG8_MMA(1, 1, At, B1); PG8_BAR;
            }
        }
        if constexpr (ALIGN_EPI) { if (wr == 0) PG8_BAR; }
        if constexpr (!Epi::AFTER_DRAIN) { E(acc, cur, wr, wc, fr, fq); S.done(cur); }
        if (!has_next) break;
#pragma unroll
        for (int a = 0; a < 2; ++a)
#pragma unroll
            for (int b = 0; b < 2; ++b)
#pragma unroll
                for (int m = 0; m < 4; ++m)
#pragma unroll
                    for (int n = 0; n < 2; ++n) acc[a][b][m][n] = (f32x4){0.f, 0.f, 0.f, 0.f};
        cur = nxt; cA = nA; cB = nB; ++ui;
        if constexpr (ALIGN_EPI) { if (wr == 1) PG8_BAR; }
    }
    PG8_WAIT_V(0);
    if constexpr (!ALIGN_EPI) { if (wr == 0) PG8_BAR; }
    PG8_BAR;
    if constexpr (Epi::AFTER_DRAIN) { E.fused(acc, cur, wr, wc, fr, fq, lds, wid, lane); S.done(cur); }
#undef PG8_SA
#undef PG8_SB
#undef PG8_STAGE
#undef PG8_LDA
#undef PG8_LDB
#undef PG8_MMA
#undef PG8_WAIT_V
#undef PG8_WAIT_L
#undef PG8_BAR
#undef PG8_SCHED
}
}
#include <hip/hip_bf16.h>
#include <cmath>
namespace attn_body {
using bf16=__hip_bfloat16;
using bf16x8=__attribute__((ext_vector_type(8)))short;
using s16x4=__attribute__((ext_vector_type(4)))short;
using f32x16=__attribute__((ext_vector_type(16)))float;
using u32x4=__attribute__((ext_vector_type(4)))unsigned;
constexpr int BATCH=16,NHEAD=16,SEQ=2048,D=64,DM=NHEAD*D;
constexpr int NW=8,QBLK=32,QB=QBLK*NW,KVBLK=64,NQB=SEQ/QB;
constexpr int ATTN_PITCH=DM, ATTN_UNIT_ROWS=QB;
__device__ __forceinline__ int crow(int r,int hi){return (r&3)+8*(r>>2)+4*hi;}
#define SBAR() __builtin_amdgcn_sched_barrier(0)
__device__ __forceinline__ void cmask(f32x16&p0,f32x16&p1,int jb,int qrel,int hi){
  const float NEG=-INFINITY; int kb=64*jb+4*hi;
  #pragma unroll
  for(int r=0;r<16;++r){int kv=kb+(r&3)+8*(r>>2); if(kv>qrel)p0[r]=NEG; if(kv+32>qrel)p1[r]=NEG;}
}

constexpr int NSLOT=3, SLOTB=8192;
constexpr int LDS_K=0, LDS_V=NSLOT*SLOTB, LDS_WS=2*NSLOT*SLOTB, LDS_OST=LDS_WS+NW*64*4, LDS_BIAS=LDS_OST+NW*4096, LDS_BYTES=LDS_BIAS+SEQ*4;
constexpr float C2=0.125f*1.4426950408889634f;
__device__ __forceinline__ void glds16(const void*gsrc,unsigned lds_dst){unsigned keep;
  asm volatile("s_mov_b32 %0, m0\n\ts_mov_b32 m0, %2\n\ts_nop 0\n\tglobal_load_lds_dwordx4 %1, off\n\ts_mov_b32 m0, %0":"=&s"(keep):"v"(gsrc),"s"(lds_dst):"memory");}
__device__ __forceinline__ float max3f(float a,float b,float c){float r;asm("v_max3_f32 %0, %1, %2, %3":"=v"(r):"v"(a),"v"(b),"v"(c));return r;}
__device__ __forceinline__ float max2f(float a,float b){float r;asm("v_max_f32_e32 %0, %1, %2":"=v"(r):"v"(a),"v"(b));return r;}
__device__ __forceinline__ float fadd_s(float a,float b){float r;asm("v_add_f32_e32 %0, %1, %2":"=v"(r):"v"(a),"v"(b));return r;}
__device__ __forceinline__ float fsub_s(float a,float b){float r;asm("v_sub_f32_e32 %0, %1, %2":"=v"(r):"v"(a),"v"(b));return r;}
typedef float f32x2_t __attribute__((ext_vector_type(2))); typedef __bf16 bf16x2_t __attribute__((ext_vector_type(2)));
__device__ __forceinline__ unsigned cvtpk_s(float lo,float hi){f32x2_t v={lo,hi};bf16x2_t b=__builtin_convertvector(v,bf16x2_t);return __builtin_bit_cast(unsigned,b);}
#define WAIT_BAR(N) asm volatile("s_waitcnt vmcnt(" #N ") lgkmcnt(0)\n\ts_barrier":::"memory")

__device__ __forceinline__ void qkt(f32x16&p0,f32x16&p1,const char*Kslot,const bf16x8*qr,const f32x16&negm,int r32,int hi){
  const char*kb=Kslot+hi*1024+r32*16;
  #pragma unroll
  for(int d0=0;d0<4;++d0){
    const bf16x8 b0=*reinterpret_cast<const bf16x8*>(kb+d0*2048);
    const bf16x8 b1=*reinterpret_cast<const bf16x8*>(kb+d0*2048+512);
    if(d0==0){p0=__builtin_amdgcn_mfma_f32_32x32x16_bf16(b0,qr[0],negm,0,0,0);p1=__builtin_amdgcn_mfma_f32_32x32x16_bf16(b1,qr[0],negm,0,0,0);}
    else{p0=__builtin_amdgcn_mfma_f32_32x32x16_bf16(b0,qr[d0],p0,0,0,0);p1=__builtin_amdgcn_mfma_f32_32x32x16_bf16(b1,qr[d0],p1,0,0,0);}}
}
typedef __attribute__((address_space(3))) const char* lds_cptr;
typedef short v4i16_t __attribute__((ext_vector_type(4)));
__device__ __forceinline__ void kload8(bf16x8*kf,lds_cptr kp){
  kf[0]=*(const __attribute__((address_space(3))) bf16x8*)(kp);      kf[1]=*(const __attribute__((address_space(3))) bf16x8*)(kp+512);
  kf[2]=*(const __attribute__((address_space(3))) bf16x8*)(kp+2048); kf[3]=*(const __attribute__((address_space(3))) bf16x8*)(kp+2560);
  kf[4]=*(const __attribute__((address_space(3))) bf16x8*)(kp+4096); kf[5]=*(const __attribute__((address_space(3))) bf16x8*)(kp+4608);
  kf[6]=*(const __attribute__((address_space(3))) bf16x8*)(kp+6144); kf[7]=*(const __attribute__((address_space(3))) bf16x8*)(kp+6656);
}
__device__ __forceinline__ void kload2(bf16x8*kf,lds_cptr kp,int j){ kf[2*j]=*(const __attribute__((address_space(3))) bf16x8*)(kp+j*2048); kf[2*j+1]=*(const __attribute__((address_space(3))) bf16x8*)(kp+j*2048+512); }
__device__ __forceinline__ s16x4 vtr(lds_cptr p){ return __builtin_bit_cast(s16x4,__builtin_amdgcn_ds_read_tr16_b64_v4i16((__attribute__((address_space(3))) v4i16_t*)p)); }
__device__ __forceinline__ float rowmax(const f32x16&p0,const f32x16&p1){
  float a=max3f(p0[0],p0[1],p1[0]),b=max3f(p0[2],p0[3],p1[1]);a=max3f(a,p1[2],p1[3]);
  #pragma unroll
  for(int r=4;r<16;r+=4){a=max3f(a,p0[r],p0[r+1]);b=max3f(b,p0[r+2],p0[r+3]);a=max3f(a,p1[r],p1[r+1]);b=max3f(b,p1[r+2],p1[r+3]);}
  const float m=max2f(a,b);
  auto rr=__builtin_amdgcn_permlane32_swap(__float_as_uint(m),__float_as_uint(m),false,false);
  return max2f(__uint_as_float(rr[0]),__uint_as_float(rr[1]));
}
__device__ __forceinline__ void pv(f32x16*o,int vb,bf16x8 pa0,bf16x8 pa1,bf16x8 pa2,bf16x8 pa3){
  #pragma unroll
  for(int d0=0;d0<2;++d0){s16x4 lo[4],hi[4];
    #pragma unroll
    for(int ks=0;ks<4;++ks){
      asm volatile("ds_read_b64_tr_b16 %0,%1 offset:%c2":"=&v"(lo[ks]):"v"(vb),"i"(d0*4096+ks*1024):"memory");
      asm volatile("ds_read_b64_tr_b16 %0,%1 offset:%c2":"=&v"(hi[ks]):"v"(vb),"i"(d0*4096+ks*1024+512):"memory");}
    asm volatile("s_waitcnt lgkmcnt(0)":::"memory");SBAR();
    #define PK(k) (bf16x8){lo[k][0],lo[k][1],lo[k][2],lo[k][3],hi[k][0],hi[k][1],hi[k][2],hi[k][3]}
    o[d0]=__builtin_amdgcn_mfma_f32_32x32x16_bf16(pa0,PK(0),o[d0],0,0,0);
    o[d0]=__builtin_amdgcn_mfma_f32_32x32x16_bf16(pa1,PK(1),o[d0],0,0,0);
    o[d0]=__builtin_amdgcn_mfma_f32_32x32x16_bf16(pa2,PK(2),o[d0],0,0,0);
    o[d0]=__builtin_amdgcn_mfma_f32_32x32x16_bf16(pa3,PK(3),o[d0],0,0,0);
    #undef PK
  }
}

#ifndef ATTN_STORE16
#define ATTN_STORE16(p,v) (*(u32x4*)(p)=(v))
#endif
typedef float f32x4_t __attribute__((ext_vector_type(4)));
template<int THRL> __device__ __forceinline__ void attn_unit(int b,int h,int qb,const bf16*Q,const bf16*__restrict__ K,const bf16*__restrict__ V,bf16*O,const float*NEGF,char*shm){
  int tid_=threadIdx.x; asm volatile("":"+v"(tid_)); const int tid=tid_,lane=tid&63,r32=lane&31,hi=lane>>5; const int wid=__builtin_amdgcn_readfirstlane(tid>>6);
  const long rowbase=(long)b*SEQ; const int q0=qb*QB;
  const bf16*Qw=Q+(rowbase+q0+wid*QBLK)*DM+h*D;
  const bf16*Kh=K+rowbase*DM+h*D,*Vh=V+rowbase*DM+h*D;
  const unsigned lds0=(unsigned)(uintptr_t)shm;
  float*wsf=(float*)(shm+LDS_WS)+wid*64;
  const bf16*ksrc=Kh+(long)lane*DM+wid*8;
  const bf16*vsrc=Vh+(long)(16*(wid&3)+(lane>>2))*DM+(wid>>2)*32+(lane&3)*8;
  const unsigned kdst=lds0+LDS_K+wid*1024, vdst=lds0+LDS_V+wid*1024;
  #define DMA_K(t,slot) glds16(ksrc+(long)(t)*KVBLK*DM,(unsigned)__builtin_amdgcn_readfirstlane(kdst+(slot)))
  #define DMA_V(t,slot) glds16(vsrc+(long)(t)*KVBLK*DM,(unsigned)__builtin_amdgcn_readfirstlane(vdst+(slot)))
  const int vb0=(int)(lds0+LDS_V)+((lane>>4)&1)*32+(lane&3)*8+(4*hi+((lane&15)>>2))*64;
  const char*Kbase=shm+LDS_K; bf16x8 kf[8];
  const lds_cptr shm3=(lds_cptr)shm; const lds_cptr kp0=shm3+LDS_K+hi*1024+r32*16; const lds_cptr vp0=shm3+LDS_V+((lane>>4)&1)*32+(lane&3)*8+(4*hi+((lane&15)>>2))*64;
  const int NT=(q0+QB)/KVBLK;
  { const f32x4_t bv_=*(const f32x4_t*)(NEGF+(long)(b*NHEAD+h)*SEQ+tid*4); *(__attribute__((address_space(3))) f32x4_t*)((__attribute__((address_space(3))) char*)shm+LDS_BIAS+tid*16)=bv_; }
  #define KBIAS(P0,P1,t) do{ const lds_cptr bq_=shm3+LDS_BIAS+((t)*64+4*hi)*4; \
    _Pragma("unroll") for(int j_=0;j_<4;++j_){ { const f32x4_t x0_=*(const __attribute__((address_space(3))) f32x4_t*)(bq_+32*j_); \
      P0[4*j_]+=x0_[0]-mhat;P0[4*j_+1]+=x0_[1]-mhat;P0[4*j_+2]+=x0_[2]-mhat;P0[4*j_+3]+=x0_[3]-mhat; } \
      { const f32x4_t x1_=*(const __attribute__((address_space(3))) f32x4_t*)(bq_+32*j_+128); \
      P1[4*j_]+=x1_[0]-mhat;P1[4*j_+1]+=x1_[1]-mhat;P1[4*j_+2]+=x1_[2]-mhat;P1[4*j_+3]+=x1_[3]-mhat; } } }while(0)
  DMA_K(0,0);DMA_V(0,0);DMA_K(1,SLOTB);
  bf16x8 qr[4];
  #pragma unroll
  for(int d0=0;d0<4;++d0)qr[d0]=*reinterpret_cast<const bf16x8*>(&Qw[(long)r32*DM+d0*16+hi*8]);
  float mhat=0.f,l_reg=0.f;f32x16 o[2];o[0]=f32x16{};o[1]=f32x16{};const f32x16 negm=f32x16{};
  const int qrel=wid*QBLK+r32;
  #define CMASK(P0,P1,t) do{int jb_=(t)-(NT-4); if(jb_>=0)cmask(P0,P1,jb_,qrel,hi);}while(0)
  bool resc=false;
  #define START(P0,P1) do{ const float rm=rowmax(P0,P1); resc=false; \
    { const float dl=rm; mhat=fadd_s(mhat,dl); \
      _Pragma("unroll") for(int r=0;r<16;++r){P0[r]=fsub_s(P0[r],dl);P1[r]=fsub_s(P1[r],dl);} \
       } \
    _Pragma("unroll") for(int r=0;r<16;++r)P0[r]=__builtin_amdgcn_exp2f(P0[r]); }while(0)
  #define RESC() do{ if(resc){ asm volatile("s_waitcnt lgkmcnt(0)":::"memory"); \
      _Pragma("unroll") for(int d_=0;d_<2;++d_) _Pragma("unroll") for(int r=0;r<16;++r)o[d_][r]*=wsf[crow(r,hi)]; } }while(0)
  f32x16 pA0,pA1,pB0,pB1;
  int sl_prev=0,sl_cur=0,sl_next=SLOTB;
  #define ROT() do{sl_prev=sl_cur;sl_cur=sl_next;sl_next=(sl_next==(NSLOT-1)*SLOTB)?0:sl_next+SLOTB;}while(0)
  DMA_K(2,2*SLOTB);
  WAIT_BAR(3);
  qkt(pA0,pA1,Kbase,qr,negm,r32,hi);asm volatile("s_nop 15\n\ts_nop 7":"+v"(pA0),"+v"(pA1));KBIAS(pA0,pA1,0);CMASK(pA0,pA1,0);
  START(pA0,pA1);
  _Pragma("unroll") for(int r=0;r<16;++r)pA1[r]=__builtin_amdgcn_exp2f(pA1[r]);
  WAIT_BAR(0);
  DMA_K(3,0);DMA_V(1,SLOTB);
  ROT();
  kload8(kf,kp0+sl_cur);
  WAIT_BAR(2);
  s16x4 vlo[8],vhi[8]; u32x4 pw0,pw1,pw2,pw3;
  #define PKW(P,B) cvtpk_s(P[B],P[B+1])
  #define PAF(k) __builtin_bit_cast(bf16x8,pw##k)
  #define VFR(i) (bf16x8){vlo[i][0],vlo[i][1],vlo[i][2],vlo[i][3],vhi[i][0],vhi[i][1],vhi[i][2],vhi[i][3]}
  #define PIN(x) asm volatile("":"+v"(x))
  #define MX3(a,b,c) __builtin_fmaxf(__builtin_fmaxf((a),(b)),(c))
  #define GAPA(MF,A0,A1,A2,A3,W0,W1,PW) do{ MF; sacc+=A0; sacc+=A1; sacc+=A2; sacc+=A3; PIN(sacc); W0; W1; PIN(PW); SBAR(); }while(0)
  #define EX(v) __builtin_amdgcn_exp2f(v)
  #define GAPB(MF,X,B) do{ MF; X[B]=EX(X[B]); X[B+1]=EX(X[B+1]); X[B+2]=EX(X[B+2]); X[B+3]=EX(X[B+3]); PIN(X); SBAR(); }while(0)
  #define VRD(i) do{ vlo[i]=vtr(vp_+(((i)>>2)*4096+((i)&3)*1024)); vhi[i]=vtr(vp_+(((i)>>2)*4096+((i)&3)*1024+512)); }while(0)
  #define KRD(G,j) do{ if(G){ kload2(kf,kp0+sl_next,j); SBAR(); } }while(0)
  #define STEP(C0,C1,P0,P1,t,GK,GV,GL) do{ SBAR(); \
    const lds_cptr vp_=vp0+sl_prev; \
    VRD(0); SBAR(); float sacc=(P0[0]+P0[1]); \
    GAPA(C0=__builtin_amdgcn_mfma_f32_32x32x16_bf16(kf[0],qr[0],negm,0,0,0), P0[2],P0[3],P0[4],P0[5],     pw0[0]=PKW(P0,0), pw0[1]=PKW(P0,2), pw0); \
    VRD(4); SBAR(); GAPA(C1=__builtin_amdgcn_mfma_f32_32x32x16_bf16(kf[1],qr[0],negm,0,0,0), P0[6],P0[7],P0[8],P0[9],     pw0[2]=PKW(P0,4), pw0[3]=PKW(P0,6), pw0); \
    VRD(1); SBAR(); GAPA(C0=__builtin_amdgcn_mfma_f32_32x32x16_bf16(kf[2],qr[1],C0,0,0,0),   P0[10],P0[11],P0[12],P0[13], pw1[0]=PKW(P0,8), pw1[1]=PKW(P0,10), pw1); \
    VRD(5); SBAR(); GAPA(C1=__builtin_amdgcn_mfma_f32_32x32x16_bf16(kf[3],qr[1],C1,0,0,0),   P0[14],P0[15],P1[0],P1[1],   pw1[2]=PKW(P0,12),pw1[3]=PKW(P0,14), pw1); \
    VRD(2); SBAR(); GAPA(C0=__builtin_amdgcn_mfma_f32_32x32x16_bf16(kf[4],qr[2],C0,0,0,0),   P1[2],P1[3],P1[4],P1[5],     pw2[0]=PKW(P1,0), pw2[1]=PKW(P1,2), pw2); \
    VRD(6); SBAR(); GAPA(C1=__builtin_amdgcn_mfma_f32_32x32x16_bf16(kf[5],qr[2],C1,0,0,0),   P1[6],P1[7],P1[8],P1[9],     pw2[2]=PKW(P1,4), pw2[3]=PKW(P1,6), pw2); \
    VRD(3); SBAR(); GAPA(C0=__builtin_amdgcn_mfma_f32_32x32x16_bf16(kf[6],qr[3],C0,0,0,0),   P1[10],P1[11],P1[12],P1[13], pw3[0]=PKW(P1,8), pw3[1]=PKW(P1,10), pw3); \
    VRD(7); SBAR(); GAPA(C1=__builtin_amdgcn_mfma_f32_32x32x16_bf16(kf[7],qr[3],C1,0,0,0),   P1[14],P1[15],0.f,0.f,       pw3[2]=PKW(P1,12),pw3[3]=PKW(P1,14), pw3); \
    l_reg+=sacc; \
    if(GK){DMA_K((t)+3,sl_cur);} if(GV){DMA_V((t)+1,sl_next);} \
    KBIAS(C0,C1,t); CMASK(C0,C1,t); \
    { float a=MX3(C0[0],C0[1],C1[0]),b=MX3(C0[2],C0[3],C1[1]); a=MX3(a,C1[2],C1[3]); \
      _Pragma("unroll") for(int r=4;r<16;r+=4){a=MX3(a,C0[r],C0[r+1]);b=MX3(b,C0[r+2],C0[r+3]);a=MX3(a,C1[r],C1[r+1]);b=MX3(b,C1[r+2],C1[r+3]);} \
      float rm=__builtin_fmaxf(a,b); { auto rr=__builtin_amdgcn_permlane32_swap(__float_as_uint(rm),__float_as_uint(rm),false,false); rm=__builtin_fmaxf(__uint_as_float(rr[0]),__uint_as_float(rr[1])); } \
      resc=false; \
      if(__builtin_expect(__any(rm>(float)THRL),0)){ const float dl=__builtin_fmaxf(rm,0.f); mhat+=dl; \
        _Pragma("unroll") for(int r=0;r<16;++r){C0[r]-=dl;C1[r]-=dl;} \
         \
        const float f=__builtin_amdgcn_exp2f(-dl); l_reg*=f; if(hi==0)wsf[r32]=f; resc=true; } } \
    SBAR(); \
    GAPB(o[0]=__builtin_amdgcn_mfma_f32_32x32x16_bf16(PAF(0),VFR(0),o[0],0,0,0), C0,0); \
    GAPB(o[1]=__builtin_amdgcn_mfma_f32_32x32x16_bf16(PAF(0),VFR(4),o[1],0,0,0), C0,4); \
    KRD(GL,0); GAPB(o[0]=__builtin_amdgcn_mfma_f32_32x32x16_bf16(PAF(1),VFR(1),o[0],0,0,0), C0,8); \
    KRD(GL,1); GAPB(o[1]=__builtin_amdgcn_mfma_f32_32x32x16_bf16(PAF(1),VFR(5),o[1],0,0,0), C0,12); \
    KRD(GL,2); GAPB(o[0]=__builtin_amdgcn_mfma_f32_32x32x16_bf16(PAF(2),VFR(2),o[0],0,0,0), C1,0); \
    KRD(GL,3); GAPB(o[1]=__builtin_amdgcn_mfma_f32_32x32x16_bf16(PAF(2),VFR(6),o[1],0,0,0), C1,4); \
    GAPB(o[0]=__builtin_amdgcn_mfma_f32_32x32x16_bf16(PAF(3),VFR(3),o[0],0,0,0), C1,8); \
    GAPB(o[1]=__builtin_amdgcn_mfma_f32_32x32x16_bf16(PAF(3),VFR(7),o[1],0,0,0), C1,12); \
    }while(0)
  int t=1;
  #undef CMASK
  #define CMASK(P0,P1,t) do{}while(0)
  for(;t+5<NT;t+=2){
    STEP(pB0,pB1,pA0,pA1,t,true,true,true);     WAIT_BAR(2); RESC(); ROT();
    STEP(pA0,pA1,pB0,pB1,t+1,true,true,true);   WAIT_BAR(2); RESC(); ROT();
  }
  #undef CMASK
  #define CMASK(P0,P1,t) do{int jb_=(t)-(NT-4); if(jb_>=0)cmask(P0,P1,jb_,qrel,hi);}while(0)
  #define ENDW(tt) do{ if((tt)+3<NT){WAIT_BAR(2);} else if((tt)+2<NT){WAIT_BAR(1);} else {WAIT_BAR(0);} }while(0)
  for(;t+1<NT;t+=2){
    STEP(pB0,pB1,pA0,pA1,t,(t+3<NT),(t+1<NT),(t+1<NT));       ENDW(t);   RESC(); ROT();
    STEP(pA0,pA1,pB0,pB1,t+1,(t+4<NT),(t+2<NT),(t+2<NT));     ENDW(t+1); RESC(); ROT();
  }
  STEP(pB0,pB1,pA0,pA1,NT-1,false,false,false); RESC();
  { float sacc=pB0[0]+pB0[1]; _Pragma("unroll") for(int r=2;r<16;++r)sacc+=pB0[r]; _Pragma("unroll") for(int r=0;r<16;++r)sacc+=pB1[r]; l_reg+=sacc;
    pw0=(u32x4){PKW(pB0,0),PKW(pB0,2),PKW(pB0,4),PKW(pB0,6)};pw1=(u32x4){PKW(pB0,8),PKW(pB0,10),PKW(pB0,12),PKW(pB0,14)};pw2=(u32x4){PKW(pB1,0),PKW(pB1,2),PKW(pB1,4),PKW(pB1,6)};pw3=(u32x4){PKW(pB1,8),PKW(pB1,10),PKW(pB1,12),PKW(pB1,14)};
    SBAR(); pv(o,vb0+sl_cur,PAF(0),PAF(1),PAF(2),PAF(3)); }
  #undef PKW
  #undef PAF
  #undef VFR
  #undef PIN
  #undef MX3
  #undef GAPA
  #undef GAPB
  #undef EX
  #undef VRD
  #undef KRD
  #undef STEP
  #undef ENDW
  {auto rr=__builtin_amdgcn_permlane32_swap(__float_as_uint(l_reg),__float_as_uint(l_reg),false,false);l_reg=__uint_as_float(rr[0])+__uint_as_float(rr[1]);}
  if(hi==0)wsf[32+r32]=l_reg;asm volatile("s_waitcnt lgkmcnt(0)":::"memory");
  float rli[16];
  #pragma unroll
  for(int r=0;r<16;++r)rli[r]=__builtin_amdgcn_rcpf(wsf[32+crow(r,hi)]);
  bf16*Ow=O+(rowbase+q0+wid*QBLK)*DM+h*D;
  { bf16*stg=(bf16*)(shm+LDS_OST)+wid*2048;
    #pragma unroll
    for(int r=0;r<16;++r){const int orow=crow(r,hi);
      #pragma unroll
      for(int d0=0;d0<2;++d0)stg[orow*64+d0*32+r32]=__float2bfloat16(o[d0][r]*rli[r]);}
    asm volatile("s_waitcnt lgkmcnt(0)":::"memory");
    #pragma unroll
    for(int i=0;i<4;++i){const int row=i*8+(lane>>3),ch=lane&7; const u32x4 v=*(const u32x4*)(stg+row*64+ch*8); ATTN_STORE16(Ow+(long)row*DM+ch*8,v);} }
  asm volatile("s_waitcnt lgkmcnt(0)\n\ts_barrier":::"memory");
  #undef KBIAS
  #undef DMA_K
  #undef DMA_V
  #undef CMASK
  #undef START
  #undef RESC
  #undef ROT
}
constexpr int ATTN_LDS_BYTES=LDS_BYTES;
struct AttnTensors { const bf16* Q; const bf16* K; const bf16* V; bf16* O; const float* NEGF; };
struct AttnUnit { int bh; int qb; };
struct StaticOrder {
  int c,G;
  __device__ __forceinline__ explicit StaticOrder(int grid,int block):c(block),G(grid){}
  __device__ __forceinline__ bool next(int i,AttnUnit&u)const{ const int bh=c+(i>>3)*G; if(bh>=BATCH*NHEAD)return false; u.bh=bh; u.qb=7-(i&7); return true; }
  __device__ __forceinline__ void a_ready(const AttnUnit&)const{}
  __device__ __forceinline__ void done(const AttnUnit&)const{}
};
template<class Sched,int THRL=8> __device__ __forceinline__ void attn_phase(char*lds,const AttnTensors&T,const Sched&S){
  AttnUnit u;
  for(int i=0;S.next(i,u);++i){ S.a_ready(u); attn_unit<THRL>(u.bh/NHEAD,u.bh%NHEAD,u.qb,T.Q,T.K,T.V,T.O,T.NEGF,lds); S.done(u); }
}
#undef SBAR
#undef WAIT_BAR
}
#define GAS __attribute__((address_space(1)))
#define LAS __attribute__((address_space(3)))
typedef unsigned short bf16;
typedef unsigned v4u __attribute__((ext_vector_type(4)));
typedef float f32x4 __attribute__((ext_vector_type(4)));
typedef short bf16x8 __attribute__((ext_vector_type(8)));
typedef GAS unsigned gu32;
typedef GAS unsigned long long gu64;
#define RLX_AGENT __ATOMIC_RELAXED, __HIP_MEMORY_SCOPE_AGENT
#define LDS_WAIT() asm volatile("s_waitcnt lgkmcnt(0)" ::: "memory")
#define VM_WAIT() asm volatile("s_waitcnt vmcnt(0)" ::: "memory")
__device__ __forceinline__ unsigned long long rt() { return __builtin_amdgcn_s_memrealtime(); }
__device__ __forceinline__ unsigned f2bf(float f) { unsigned u = __builtin_bit_cast(unsigned, f); return (u + 0x7fffu + ((u >> 16) & 1u)) >> 16; }
__device__ __forceinline__ unsigned pk2(float lo, float hi) { return f2bf(lo) | (f2bf(hi) << 16); }

#define XB_TMO      128
#define XB_XCNT(j)  (256  + 64 * (j))
#define XB_XSUB(j)  (1280 + 64 * (j))
#define XB_XGEN(j)  (2304 + 64 * (j))
#define XB_TOP      3328
#define XB_TOPGEN   3392
#define XCD_BAR_WORDS 3456
#define XB_SPIN_CAP (1u << 18)

__device__ __forceinline__ unsigned xb_ld(unsigned* p)              { return __hip_atomic_load(p, __ATOMIC_RELAXED, __HIP_MEMORY_SCOPE_AGENT); }
__device__ __forceinline__ unsigned xb_add(unsigned* p, unsigned v) { return __hip_atomic_fetch_add(p, v, __ATOMIC_RELAXED, __HIP_MEMORY_SCOPE_AGENT); }
__device__ __forceinline__ unsigned xb_xcc_id() { return (unsigned)__builtin_amdgcn_s_getreg((3 << 11) | 20) & 0xFu; }
#define XB_SPIN(cond, bar) do { unsigned _sp = 0; while (cond) { __builtin_amdgcn_s_sleep(1); \
    if ((++_sp & 255u) == 0u) { if (xb_ld(&(bar)[XB_TMO])) break; if (_sp > XB_SPIN_CAP) { atomicAdd(&(bar)[XB_TMO], 1u); break; } } } } while (0)

struct XcdBarrier {
    unsigned* bar; unsigned x;
    volatile LAS unsigned* st;
};

__device__ __forceinline__ XcdBarrier xcd_barrier_post(unsigned* bar, volatile LAS unsigned* st) {
    XcdBarrier b; b.bar = bar; b.x = xb_xcc_id(); b.st = st;
    if (threadIdx.x == 0) (void)xb_add(&bar[XB_XCNT(b.x)], 1u);
    return b;
}
__device__ __forceinline__ void xcd_barrier_complete(unsigned* bar, unsigned x, unsigned& nloc, unsigned& nx) {
    const unsigned G = gridDim.x * gridDim.y * gridDim.z;
    unsigned sum, cnt, mine, sp = 0u;
    for (;;) {
        sum = 0u; cnt = 0u; mine = 0u;
#pragma unroll
        for (unsigned j = 0; j < 16; ++j) { const unsigned c = xb_ld(&bar[XB_XCNT(j)]); sum += c; cnt += (c > 0u) ? 1u : 0u; mine = (j == x) ? c : mine; }
        if (sum == G) break;
        __builtin_amdgcn_s_sleep(1);
        if ((++sp & 255u) == 0u) { if (xb_ld(&bar[XB_TMO])) break; if (sp > XB_SPIN_CAP) { atomicAdd(&bar[XB_TMO], 1u); break; } }
    }
    nloc = mine > 0u ? mine : 1u; nx = cnt > 0u ? cnt : 1u;
}

__device__ __forceinline__ void xcd_barrier(const XcdBarrier& b) {
    asm volatile("s_waitcnt vmcnt(0)" ::: "memory");
    __syncthreads();
    if (threadIdx.x == 0) {
        unsigned* bar = b.bar;
        __builtin_amdgcn_s_waitcnt(0);
        unsigned nloc = b.st[0], nx = b.st[1];
        if (nloc == 0u) { xcd_barrier_complete(bar, b.x, nloc, nx); b.st[0] = nloc; b.st[1] = nx; }
        const unsigned old = xb_add(&bar[XB_XSUB(b.x)], 1u);
        const unsigned gen = old / nloc;
        if (old + 1u == (gen + 1u) * nloc) {
            __builtin_amdgcn_fence(__ATOMIC_RELEASE, "agent");
            asm volatile("s_waitcnt vmcnt(0)" ::: "memory");
            const unsigned og = xb_add(&bar[XB_TOP], 1u);
            const unsigned tg = og / nx;
            if (og + 1u == (tg + 1u) * nx) xb_add(&bar[XB_TOPGEN], 1u);
            else XB_SPIN(xb_ld(&bar[XB_TOPGEN]) == tg, bar);
            __builtin_amdgcn_fence(__ATOMIC_ACQUIRE, "agent");
            xb_add(&bar[XB_XGEN(b.x)], 1u);
            asm volatile("s_waitcnt vmcnt(0)" ::: "memory");
        } else {
            XB_SPIN(xb_ld(&bar[XB_XGEN(b.x)]) == gen, bar);
            __builtin_amdgcn_fence(__ATOMIC_ACQUIRE, "agent");
            asm volatile("s_waitcnt vmcnt(0)" ::: "memory");
        }
    }
    __syncthreads();
}
namespace cg = cooperative_groups;
constexpr int NWAVES = 8;
#ifndef MK_PER_PHASE
#define MK_PER_PHASE 0
#endif
#ifndef MK_USE_CG
#define MK_USE_CG 0
#endif
#ifndef MK_DUP_NG
#define MK_DUP_NG 1
#endif
#ifndef MK_DUP_G
#define MK_DUP_G 1
#endif
constexpr int BATCH = 16, T = 2048, D = 1024, FF = 4096, M = BATCH * T;
constexpr size_t MiB = 1u << 20;
constexpr size_t WS_CTL = 0, CTL_ZERO_BYTES = 1 * MiB, WS_SSQA = 1 * MiB, WS_SSQB = 3 * MiB, WS_FLOG = 5 * MiB, WS_NEGF = 7 * MiB, WS_SV = 9 * MiB, WS_W = 10 * MiB,
                 WS_HB = 118 * MiB, WS_PB = 182 * MiB, WS_PP = 246 * MiB, WS_BIG = 310 * MiB, WS_END = 510 * MiB;
constexpr size_t ME = 1u << 20;
constexpr size_t W_S5IN = 0, W_S5GLU = 1 * ME, W_S5OUT = 3 * ME, W_S5STRIDE = 4 * ME, W_FOXIN = 8 * ME, W_FOXOUT = W_FOXIN + 3328 * 1024, W_GLAIN = W_FOXOUT + ME, W_GLAOUT = W_GLAIN + 3328 * 1024,
                 W_MLP1 = W_GLAOUT + ME, W_MLP2 = W_MLP1 + 4 * ME, W_MLPSTRIDE = 8 * ME, W_PLEG = W_MLP1 + 32 * ME, W_PLEP = W_PLEG + ME, W_PLESTRIDE = ME + ME / 4, W_TOTAL = W_PLEG + 4 * W_PLESTRIDE;
static_assert(W_TOTAL * 2 <= 108 * MiB, "weights region");
constexpr int CW_BAR = 4096;
constexpr int RING_OFF = 0, RING_BYTES = 131072, LDSCTL_OFF = RING_BYTES, MISC_OFF = LDSCTL_OFF + 320, LDS_BYTES = 147456;
constexpr float LOG2E = 1.4426950408889634f;
typedef unsigned u32x2g __attribute__((ext_vector_type(2)));

__device__ __forceinline__ float wave_sum(float v) {
#pragma unroll
    for (int o = 1; o < 64; o <<= 1) v += __shfl_xor(v, o);
    return v;
}
__device__ __forceinline__ float sigmoid_f(float x) { return 1.0f / (1.0f + __expf(-x)); }
__device__ __forceinline__ float log_sigmoid_f(float x) { return fminf(x, 0.f) - log1pf(__expf(-fabsf(x))); }
__device__ __forceinline__ float gelu_tanh_f(float x) { const float uu = 0.7978845608028654f * (x + 0.044715f * x * x * x); const float th = 1.0f - 2.0f / (__expf(2.0f * uu) + 1.0f); return 0.5f * x * (1.0f + th); }
typedef float f32x2c_ __attribute__((ext_vector_type(2))); typedef __bf16 bf16x2c_ __attribute__((ext_vector_type(2)));
__device__ __forceinline__ unsigned cvtpk_c(float lo, float hi) { const f32x2c_ v = {lo, hi}; return __builtin_bit_cast(unsigned, __builtin_convertvector(v, bf16x2c_)); }
__device__ __forceinline__ float bf_lo(unsigned w) { return __uint_as_float(w << 16); }
__device__ __forceinline__ float bf_hi(unsigned w) { return __uint_as_float(w & 0xffff0000u); }

__device__ __forceinline__ void transpose_item(const float* W, int K, int ldw, const float* gain, bf16* WT, int n0, int drow0, int k0, LAS float* scr, int lane) {
    f32x4 wv[8];
#pragma unroll
    for (int i = 0; i < 8; ++i) wv[i] = *(const GAS f32x4*)(W + (size_t)(k0 + 8 * i + (lane >> 3)) * ldw + n0 + (lane & 7) * 4);
#pragma unroll
    for (int i = 0; i < 8; ++i) { const int kk = 8 * i + (lane >> 3); const float gk = gain ? gain[k0 + kk] : 1.0f; LAS float* d = scr + kk * 33 + (lane & 7) * 4;
        d[0] = wv[i][0] * gk; d[1] = wv[i][1] * gk; d[2] = wv[i][2] * gk; d[3] = wv[i][3] * gk; }
    LDS_WAIT(); asm volatile("" ::: "memory");
    const int c = lane & 7;
#pragma unroll
    for (int j = 0; j < 4; ++j) { const int n = (lane >> 3) + 8 * j; const LAS float* s = scr + (8 * c) * 33 + n;
        v4u o; o.x = pk2(s[0 * 33], s[1 * 33]); o.y = pk2(s[2 * 33], s[3 * 33]); o.z = pk2(s[4 * 33], s[5 * 33]); o.w = pk2(s[6 * 33], s[7 * 33]);
        *(GAS v4u*)(WT + (size_t)(drow0 + n) * K + k0 + 8 * c) = o; }
    LDS_WAIT(); asm volatile("" ::: "memory");
}

__device__ __forceinline__ const float* ld_ptr(LAS unsigned long long* t, int i) { const unsigned long long v = t[i];
    const unsigned lo = __builtin_amdgcn_readfirstlane((unsigned)v), hi = __builtin_amdgcn_readfirstlane((unsigned)(v >> 32)); return (const float*)(const GAS float*)(((unsigned long long)hi << 32) | lo); }

__device__ __forceinline__ float reduce16(float (&v)[16], int lane) {
    { const bool hb5 = (lane & 32) != 0;
#pragma unroll
      for (int i = 0; i < 8; ++i) { const float snd = hb5 ? v[i] : v[i + 8], kp = hb5 ? v[i + 8] : v[i]; v[i] = kp + __shfl_xor(snd, 32); } }
    { const bool hb4 = (lane & 16) != 0;
#pragma unroll
      for (int i = 0; i < 4; ++i) { const float snd = hb4 ? v[i] : v[i + 4], kp = hb4 ? v[i + 4] : v[i]; v[i] = kp + __shfl_xor(snd, 16); } }
    { const bool hb3 = (lane & 8) != 0;
#pragma unroll
      for (int i = 0; i < 2; ++i) { const float snd = hb3 ? v[i] : v[i + 2], kp = hb3 ? v[i + 2] : v[i]; v[i] = kp + __shfl_xor(snd, 8); } }
    { const bool hb2 = (lane & 4) != 0; const float snd = hb2 ? v[0] : v[1], kp = hb2 ? v[1] : v[0]; v[0] = kp + __shfl_xor(snd, 4); }
    float tot = v[0]; tot += __shfl_xor(tot, 2); tot += __shfl_xor(tot, 1); return tot;
}
__device__ __forceinline__ void sv_pass(float (&acc)[16], LAS float* inT, const float* in, size_t in_stride, int K, const float* gain, const float* W, int ldw, int col, int tk, int KG, int lane, int wave) {
    for (int k0 = 0; k0 < K; k0 += 1024) {
        const int kc = (K - k0) < 1024 ? (K - k0) : 1024;
        __syncthreads();
        for (int rr = 0; rr < 2; ++rr) { const int r = 2 * wave + rr; const float* src = in + (size_t)r * in_stride + k0;
            f32x4 v[4]; float ss = 0.f;
#pragma unroll
            for (int i = 0; i < 4; ++i) { const int k4 = lane + 64 * i; v[i] = (f32x4){0.f, 0.f, 0.f, 0.f}; if (4 * k4 < kc) v[i] = *(const GAS f32x4*)(src + 4 * k4); ss += (v[i][0] * v[i][0] + v[i][1] * v[i][1]) + (v[i][2] * v[i][2] + v[i][3] * v[i][3]); }
            float sc = 1.f; if (gain) { ss = wave_sum(ss); sc = rsqrtf(ss * (1.0f / 1024.0f) + 1e-6f); }
#pragma unroll
            for (int i = 0; i < 4; ++i) { const int k4 = lane + 64 * i; if (4 * k4 < kc) { f32x4 g = (f32x4){1.f, 1.f, 1.f, 1.f}; if (gain) g = *(const GAS f32x4*)(gain + k0 + 4 * k4);
#pragma unroll
                for (int e = 0; e < 4; ++e) inT[(4 * k4 + e) * 16 + r] = v[i][e] * sc * g[e]; } } }
        __syncthreads();
#pragma unroll 4
        for (int k = tk; k < kc; k += KG) { const float w = W[(size_t)(k0 + k) * ldw + col]; const LAS f32x4* ip = (const LAS f32x4*)(inT + k * 16); const f32x4 a0 = ip[0], a1 = ip[1], a2 = ip[2], a3 = ip[3];
            acc[0] += w * a0[0]; acc[1] += w * a0[1]; acc[2] += w * a0[2]; acc[3] += w * a0[3]; acc[4] += w * a1[0]; acc[5] += w * a1[1]; acc[6] += w * a1[2]; acc[7] += w * a1[3];
            acc[8] += w * a2[0]; acc[9] += w * a2[1]; acc[10] += w * a2[2]; acc[11] += w * a2[3]; acc[12] += w * a3[0]; acc[13] += w * a3[1]; acc[14] += w * a3[2]; acc[15] += w * a3[3]; }
    }
}
__device__ __forceinline__ void sv_stage(LAS unsigned char* ldsl, int mode, int N, const float* in0, size_t st0, int K0, const float* gain0, const float* W0, int ldw0, int c00,
                                         const float* in1, size_t st1, int K1, const float* W1, int ldw1, int c01, const float* res, size_t rst, float* out, int ost, int tid, int lane, int wave, int G) {
    const int cw = N / 256, KG = 512 / cw, tc = tid % cw, tk = tid / cw;
    LAS float* inT = (LAS float*)ldsl; LAS float* red0 = inT + 16384; LAS float* red1 = inT + 24576;
    for (int cb = blockIdx.x; cb < 256; cb += G) { const int n0 = ((G == 256) ? ((cb & 7) << 5) + (cb >> 3) : cb) * cw;
        float a0[16], a1[16];
#pragma unroll
        for (int r = 0; r < 16; ++r) { a0[r] = 0.f; a1[r] = 0.f; }
        sv_pass(a0, inT, in0, st0, K0, gain0, W0, ldw0, c00 + n0 + tc, tk, KG, lane, wave);
        if (K1 > 0) sv_pass(a1, inT, in1, st1, K1, nullptr, W1, ldw1, c01 + n0 + tc, tk, KG, lane, wave);
        __syncthreads();
#pragma unroll
        for (int r = 0; r < 16; ++r) { red0[tid * 16 + r] = a0[r]; red1[tid * 16 + r] = a1[r]; }
        __syncthreads();
        if (tid < 16 * cw) { const int r = tid / cw, c = tid % cw; float s0 = 0.f, s1 = 0.f;
            for (int g = 0; g < KG; ++g) { s0 += red0[(g * cw + c) * 16 + r]; s1 += red1[(g * cw + c) * 16 + r]; }
            const int n = n0 + c; float o;
            if (mode == 0) o = s0; else if (mode == 1) o = res[(size_t)r * rst + n] + s0; else if (mode == 2) { const float t = fmaxf(s0, 0.f); o = t * t; }
            else if (mode == 3) o = s0 * sigmoid_f(s1); else o = res[(size_t)r * rst + n] + s1 * sigmoid_f(s0);
            out[(size_t)r * ost + n] = o; }
    }
    __syncthreads();
}
struct Args { const float* in[29]; float* out; unsigned char* ws; int ph_lo, ph_hi; };
constexpr int N_PHASES = 38;
enum { T_PROLOGUE = 0, T_INPROJ, T_MIX1, T_MIX2, T_OUTPROJ, T_UP0, T_DOWN0, T_UP1, T_DOWN1, T_PLE, T_FINAL };

__global__ void __launch_bounds__(NWAVES * 64, 2) trunk_fwd(Args args) {
    extern __shared__ __attribute__((aligned(16))) unsigned char lds[];
    LAS unsigned char* const ldsl = (LAS unsigned char*)lds;
    volatile LAS unsigned* MISC = (volatile LAS unsigned*)(ldsl + MISC_OFF);
    const int tid0 = threadIdx.x;
#define tid tid0
    for (int u = tid; u < (LDS_BYTES - LDSCTL_OFF) / 4; u += NWAVES * 64) ((LAS unsigned*)(ldsl + LDSCTL_OFF))[u] = 0u;
    __syncthreads();
    LAS unsigned long long* const ptab = (LAS unsigned long long*)(ldsl + LDSCTL_OFF + 64);
    if (tid == 0) {
#define PT_(i) ptab[i] = (unsigned long long)args.in[i];
        PT_(0) PT_(1) PT_(2) PT_(3) PT_(4) PT_(5) PT_(6) PT_(7) PT_(8) PT_(9) PT_(10) PT_(11) PT_(12) PT_(13) PT_(14) PT_(15) PT_(16) PT_(17) PT_(18) PT_(19) PT_(20) PT_(21) PT_(22) PT_(23) PT_(24) PT_(25) PT_(26) PT_(27) PT_(28)
        ptab[29] = (unsigned long long)args.ws; ptab[30] = (unsigned long long)args.out;
#undef PT_
    }
    __syncthreads();
#define INP(i) ld_ptr(ptab, (i))
#define ws ((unsigned char*)ld_ptr(ptab, 29))
#define h ((float*)ld_ptr(ptab, 30))
#define Wb ((bf16*)(ws + WS_W))
#define HB ((bf16*)(ws + WS_HB))
#define PB ((bf16*)(ws + WS_PB))
#define PP ((bf16*)(ws + WS_PP))
#define BIG ((bf16*)(ws + WS_BIG))
#define FLOG ((float*)(ws + WS_FLOG))
#define NEGF ((float*)(ws + WS_NEGF))
#if !MK_PER_PHASE
    cg::grid_group grid = cg::this_grid();
#if !MK_USE_CG
    XcdBarrier bar = xcd_barrier_post((unsigned*)(ws + WS_CTL) + CW_BAR, MISC + 8);
#endif
#endif
    (void)MISC;

#undef tid
    for (int ph = args.ph_lo; ph < args.ph_hi; ++ph) {
        int tid = tid0; asm volatile("" : "+v"(tid));
        const int lane = tid & 63, wave = __builtin_amdgcn_readfirstlane(tid >> 6);
        const int G = gridDim.x, gw = blockIdx.x * NWAVES + wave, NGW = G * NWAVES, gtid = blockIdx.x * (NWAVES * 64) + tid, NT = G * NWAVES * 64;
        int type, layer = 0;
        if (ph == 0) type = T_PROLOGUE; else if (ph >= 37) type = T_FINAL; else { layer = (ph - 1) / 9; type = T_INPROJ + (ph - 1) % 9; }
        const int mixer = layer % 3, jm = layer / 3;
#define SSQ_(k) ((float*)(ws + (((3 * layer + (k)) & 1) ? WS_SSQB : WS_SSQA)))
#define ssq0 SSQ_(0)
#define ssq1 SSQ_(1)
#define ssq2 SSQ_(2)
#define ssq3 SSQ_(3)


        for (int rep_ = 0; rep_ < (((type == T_MIX2 && mixer == 1) || type == T_FINAL) ? 1 : MK_DUP_NG); ++rep_) {
        if (rep_) __syncthreads();
        int tid_o = tid; asm volatile("" : "+v"(tid_o));
        { const int tid = tid_o, lane = tid & 63, wave = __builtin_amdgcn_readfirstlane(tid >> 6), gw = blockIdx.x * NWAVES + wave, gtid = blockIdx.x * (NWAVES * 64) + tid; (void)gtid; (void)gw; (void)lane;
        { const int sk = ph - 1;
          if (sk >= 0 && sk < 13) {
            float* const SVH0 = (float*)(ws + WS_SV); float* const SVH1 = SVH0 + 16384; float* const SVA = SVH0 + 32768; float* const SVB = SVH0 + 98304;
            const size_t XS = (size_t)T * D, PS = (size_t)T * 256;
            if (sk == 0) sv_stage(ldsl, 0, 1024, INP(0), XS, 1024, INP(2), INP(5), 1024, 0, nullptr, 0, 0, nullptr, 0, 0, nullptr, 0, SVA, 1024, tid, lane, wave, G);
            else if (sk == 1) {
                for (int item = gw; item < 1024; item += NGW) { const int b = item >> 6, g = item & 63, n = lane; const size_t gn = (size_t)g * 64 + n;
                    const float dt = expf(INP(8)[g]), lr = INP(6)[gn], li = INP(7)[gn];
                    const float mag = expf(lr * dt), are = mag * cosf(li * dt), aim = mag * sinf(li * dt), den = lr * lr + li * li, nr = are - 1.0f;
                    const float cre = (nr * lr + aim * li) / den, cim = (aim * lr - nr * li) / den;
                    float xre = 0.f, xim = 0.f; const float* uu = SVA + b * 1024 + g * 16;
#pragma unroll
                    for (int c = 0; c < 16; ++c) { const float br = INP(9)[gn * 16 + c], bi = INP(10)[gn * 16 + c]; xre += (cre * br - cim * bi) * uu[c]; xim += (cre * bi + cim * br) * uu[c]; }
                    float v[16];
#pragma unroll
                    for (int c = 0; c < 16; ++c) { const size_t ci = (size_t)g * 1024 + c * 64 + n; v[c] = INP(11)[ci] * xre - INP(12)[ci] * xim; }
                    const float tot = reduce16(v, lane);
                    const int ch = ((lane >> 5) & 1) * 8 + ((lane >> 4) & 1) * 4 + ((lane >> 3) & 1) * 2 + ((lane >> 2) & 1);
                    if ((lane & 3) == 0) SVB[b * 1024 + g * 16 + ch] = gelu_tanh_f(tot + INP(13)[g * 16 + ch] * uu[ch]); } }
            else if (sk == 2) sv_stage(ldsl, 3, 1024, SVB, 1024, 1024, nullptr, INP(14), 2048, 0, SVB, 1024, 1024, INP(14), 2048, 1024, nullptr, 0, SVA, 1024, tid, lane, wave, G);
            else if (sk == 3) sv_stage(ldsl, 1, 1024, SVA, 1024, 1024, nullptr, INP(15), 1024, 0, nullptr, 0, 0, nullptr, 0, 0, INP(0), XS, SVH1, 1024, tid, lane, wave, G);
            else if (sk == 4 || sk == 9) { const int L = (sk == 9); sv_stage(ldsl, 2, 4096, L ? SVH0 : SVH1, 1024, 1024, INP(3) + L * 1024, INP(24) + (size_t)L * 4 * ME, 4096, 0, nullptr, 0, 0, nullptr, 0, 0, nullptr, 0, SVA, 4096, tid, lane, wave, G); }
            else if (sk == 5 || sk == 10) { const int L = (sk == 10); sv_stage(ldsl, 1, 1024, SVA, 4096, 4096, nullptr, INP(25) + (size_t)L * 4 * ME, 1024, 0, nullptr, 0, 0, nullptr, 0, 0, L ? SVH0 : SVH1, 1024, L ? SVH1 : SVH0, 1024, tid, lane, wave, G); }
            else if (sk == 6 || sk == 11) { const int L = (sk == 11); const float* hin = L ? SVH1 : SVH0;
                sv_stage(ldsl, 4, 1024, hin, 1024, 1024, INP(4) + L * 1024, INP(27) + (size_t)L * ME, 1024, 0, INP(1) + (size_t)L * M * 256, PS, 256, INP(26) + (size_t)L * (ME / 4), 1024, 0, hin, 1024, L ? SVH0 : SVH1, 1024, tid, lane, wave, G); }
            else if (sk == 7) sv_stage(ldsl, 0, 1024, SVH1, 1024, 1024, INP(2) + 1024, INP(16), 3088, 2048, nullptr, 0, 0, nullptr, 0, 0, nullptr, 0, SVA, 1024, tid, lane, wave, G);
            else if (sk == 8) sv_stage(ldsl, 1, 1024, SVA, 1024, 1024, nullptr, INP(18), 1024, 0, nullptr, 0, 0, nullptr, 0, 0, SVH1, 1024, SVH0, 1024, tid, lane, wave, G);
            else if (sk == 12) sv_stage(ldsl, 0, 1024, SVH0, 1024, 1024, INP(2) + 2 * 1024, INP(19), 3088, 0, nullptr, 0, 0, nullptr, 0, 0, nullptr, 0, SVA, 1024, tid, lane, wave, G);
          } }
        if (type == T_PROLOGUE) {
            LAS float* scr = (LAS float*)(ldsl + RING_OFF + wave * 16384);
            for (int gi = gw; gi < 27136 + 512; gi += NGW) {
                int mi, it;
                if (gi < 4096) { const int j = gi >> 11, r = gi & 2047; const int w = (r < 512) ? 0 : (r < 1536) ? 1 : 2; mi = 3 * j + w; it = r - ((w == 0) ? 0 : (w == 1) ? 512 : 1536); }
                else if (gi < 8192) { const int r = gi - 4096; if (r < 1536) { mi = 6; it = r; } else if (r < 2048) { mi = 7; it = r - 1536; } else if (r < 3584) { mi = 8; it = r - 2048; } else { mi = 9; it = r - 3584; } }
                else if (gi < 16384) { mi = 10 + ((gi - 8192) >> 11); it = (gi - 8192) & 2047; }
                else if (gi < 24576) { mi = 14 + ((gi - 16384) >> 11); it = (gi - 16384) & 2047; }
                else if (gi < 26624) { mi = 18 + ((gi - 24576) >> 9); it = (gi - 24576) & 511; }
                else if (gi < 27136) { mi = 22 + ((gi - 26624) >> 7); it = (gi - 26624) & 127; }
                else { mi = (gi - 27136 < 256) ? 6 : 8; it = -1 - ((gi - 27136) & 255); }
                const float* src; int K = 1024, ldw = 1024, ncols = 1024, glu = 0; const float* gain = nullptr; bf16* dst;
                if (mi < 6) { const int j = mi / 3, w = mi % 3;
                    if (w == 0) { src = INP(5) + (size_t)j * ME; gain = INP(2) + (size_t)(3 * j) * 1024; dst = Wb + W_S5IN + j * W_S5STRIDE; }
                    else if (w == 1) { src = INP(14) + (size_t)j * 2 * ME; ldw = 2048; ncols = 2048; glu = 1; dst = Wb + W_S5GLU + j * W_S5STRIDE; }
                    else { src = INP(15) + (size_t)j * ME; dst = Wb + W_S5OUT + j * W_S5STRIDE; } }
                else if (mi == 6) { src = INP(16); ldw = 3088; ncols = 3072; gain = INP(2) + 1 * 1024; dst = Wb + W_FOXIN; }
                else if (mi == 7) { src = INP(18); dst = Wb + W_FOXOUT; }
                else if (mi == 8) { src = INP(19); ldw = 3088; ncols = 3072; gain = INP(2) + 2 * 1024; dst = Wb + W_GLAIN; }
                else if (mi == 9) { src = INP(23); dst = Wb + W_GLAOUT; }
                else if (mi < 14) { const int i = mi - 10; src = INP(24) + (size_t)i * 4 * ME; ldw = 4096; ncols = 4096; gain = INP(3) + (size_t)i * 1024; dst = Wb + W_MLP1 + i * W_MLPSTRIDE; }
                else if (mi < 18) { const int i = mi - 14; src = INP(25) + (size_t)i * 4 * ME; K = 4096; dst = Wb + W_MLP2 + i * W_MLPSTRIDE; }
                else if (mi < 22) { const int i = mi - 18; src = INP(27) + (size_t)i * ME; gain = INP(4) + (size_t)i * 1024; dst = Wb + W_PLEG + i * W_PLESTRIDE; }
                else { const int i = mi - 22; src = INP(26) + (size_t)i * (ME / 4); K = 256; dst = Wb + W_PLEP + i * W_PLESTRIDE; }
                const int nblk = ncols / 32;
                if (it >= 0) { const int kb = it / nblk, nb = it % nblk, n0 = 32 * nb; int drow0 = n0;
                    if (glu) { const int c = n0 & 1023; drow0 = 256 * (c >> 7) + (c & 127) + ((n0 >= 1024) ? 128 : 0); }
                    transpose_item(src, K, ldw, gain, dst, n0, drow0, 64 * kb, scr, lane); }
                else { const int n = 3072 + (-1 - it);
#pragma unroll 4
                    for (int k = lane; k < 1024; k += 64) { const float v = (n < 3088) ? src[(size_t)k * 3088 + n] * gain[k] : 0.f; dst[(size_t)n * 1024 + k] = (bf16)f2bf(v); } }
            }
            float* ssqA = (float*)(ws + WS_SSQA);
            for (int m = gw; m < M; m += NGW) {
                const GAS f32x4* xr = (const GAS f32x4*)(INP(0) + (size_t)m * D) + lane; f32x4 v[4]; float s = 0.f;
#pragma unroll
                for (int j = 0; j < 4; ++j) { v[j] = xr[64 * j]; s += (v[j].x * v[j].x + v[j].y * v[j].y) + (v[j].z * v[j].z + v[j].w * v[j].w); }
                s = wave_sum(s);
                GAS unsigned long long* o8 = (GAS unsigned long long*)(PB + (size_t)m * D) + lane;
#pragma unroll
                for (int j = 0; j < 4; ++j) o8[64 * j] = (unsigned long long)pk2(v[j].x, v[j].y) | ((unsigned long long)pk2(v[j].z, v[j].w) << 32);
                if (lane < 16) ssqA[(size_t)m * 16 + lane] = (lane == 0) ? s : 0.f;
            }
        }
        else if (type == T_MIX1 && mixer == 0) {
            {
                const int q = wave & 3; const bool helper = wave >= 4;
                LAS float* xs = (LAS float*)(ldsl + q * 25664);
                LAS unsigned short* ssb = (LAS unsigned short*)(ldsl + q * 25664 + 16896);
                volatile LAS unsigned* fl = (volatile LAS unsigned*)(ldsl + q * 25664 + 25600);
                const bf16* U = BIG; bf16* Y = BIG + (size_t)32 * ME;
                const int fr = lane & 15, fq = lane >> 4;
                typedef float f32x2s __attribute__((ext_vector_type(2)));
#define S5_WAIT(idx, target) { while ((int)fl[idx] < (int)(target)) __builtin_amdgcn_s_sleep(1); asm volatile("" ::: "memory"); }
#define S5_POST(idx, val) { asm volatile("s_waitcnt lgkmcnt(0)" ::: "memory"); if (lane == 0) fl[idx] = (unsigned)(val); }
                for (int pair = blockIdx.x * 4 + q; pair < 1024; pair += G * 4) {
                    const int b = pair >> 6, g = pair & 63;
                    __syncthreads();
                    if (!helper && lane == 0) { fl[0] = 0u; fl[1] = 0u; fl[2] = 0u; }
                    __syncthreads();
                    const float dt = expf(INP(8)[jm * 64 + g]);
                    if (!helper) {
                        float are, aim;
                        { const size_t gn = (size_t)jm * 4096 + g * 64 + lane; const float lr = INP(6)[gn], li = INP(7)[gn], mag = expf(lr * dt); are = mag * cosf(li * dt); aim = mag * sinf(li * dt); }
                        float sre = 0.f, sim = 0.f;
#pragma unroll 1
                        for (int blk = 0; blk < 128; ++blk) {
                            S5_WAIT(0, blk + 1) S5_WAIT(2, blk - 1)
                            const LAS float* xrd = xs + (blk & 1) * 2112; LAS unsigned* sw = (LAS unsigned*)(ssb + (blk & 1) * 2176);
                            f32x2s xv[16];
#pragma unroll
                            for (int s = 0; s < 16; ++s) xv[s] = *(const LAS f32x2s*)(xrd + s * 132 + 2 * lane);
#pragma unroll
                            for (int s = 0; s < 16; ++s) { const float nre = are * sre - aim * sim + xv[s].x, nim = are * sim + aim * sre + xv[s].y; sre = nre; sim = nim;
                                sw[s * 68 + lane] = cvtpk_c(sre, sim); }
                            S5_POST(1, blk + 1)
                        }
                    } else {
                        bf16x8 bfr[8];
#pragma unroll
                    for (int j = 0; j < 8; ++j) {
                        const size_t gn = (size_t)jm * 4096 + g * 64 + 8 * j + (fr >> 1); const float lr = INP(6)[gn], li = INP(7)[gn];
                        const float mag = expf(lr * dt), ar = mag * cosf(li * dt), ai = mag * sinf(li * dt), den = lr * lr + li * li, nr = ar - 1.0f;
                        const float cre = (nr * lr + ai * li) / den, cim = (ai * lr - nr * li) / den;
                        const float ca = (fr & 1) ? cim : cre, cb = (fr & 1) ? cre : -cim;
                        unsigned w4[4] = {0u, 0u, 0u, 0u};
                        if (fq < 2) { const f32x4 b0 = *(const GAS f32x4*)(INP(9) + gn * 16 + 8 * fq), b1 = *(const GAS f32x4*)(INP(9) + gn * 16 + 8 * fq + 4), i0 = *(const GAS f32x4*)(INP(10) + gn * 16 + 8 * fq), i1 = *(const GAS f32x4*)(INP(10) + gn * 16 + 8 * fq + 4);
                            w4[0] = pk2(ca * b0[0] + cb * i0[0], ca * b0[1] + cb * i0[1]); w4[1] = pk2(ca * b0[2] + cb * i0[2], ca * b0[3] + cb * i0[3]);
                            w4[2] = pk2(ca * b1[0] + cb * i1[0], ca * b1[1] + cb * i1[1]); w4[3] = pk2(ca * b1[2] + cb * i1[2], ca * b1[3] + cb * i1[3]); }
                        bfr[j] = __builtin_bit_cast(bf16x8, (v4u){w4[0], w4[1], w4[2], w4[3]}); }
                    bf16x8 cfr[4];
#pragma unroll
                    for (int kk = 0; kk < 4; ++kk) { const size_t cb = ((size_t)jm * 64 + g) * 1024 + fr * 64 + 16 * kk + 4 * fq;
                        const f32x4 c0 = *(const GAS f32x4*)(INP(11) + cb), c1 = *(const GAS f32x4*)(INP(12) + cb);
                        cfr[kk] = __builtin_bit_cast(bf16x8, (v4u){pk2(c0[0], -c1[0]), pk2(c0[1], -c1[1]), pk2(c0[2], -c1[2]), pk2(c0[3], -c1[3])}); }
                    bf16x8 dfr;
                    { const float dv = INP(13)[jm * 1024 + g * 16 + fr]; unsigned dw[4] = {0u, 0u, 0u, 0u};
                      if (fq < 2 && (fr >> 3) == fq) { const int e = fr & 7; dw[e >> 1] = (e & 1) ? (f2bf(dv) << 16) : f2bf(dv); }
                      dfr = __builtin_bit_cast(bf16x8, (v4u){dw[0], dw[1], dw[2], dw[3]}); }

                        const bf16* up = U + (size_t)(b * T) * D + g * 16 + 8 * fq;
                        v4u ur0 = (v4u){0u, 0u, 0u, 0u}, ur1 = ur0, ur2 = ur0, ur3 = ur0;
                        if (fq < 2) { ur0 = *(const GAS v4u*)(up + (size_t)fr * D); ur1 = *(const GAS v4u*)(up + (size_t)(16 + fr) * D); ur2 = *(const GAS v4u*)(up + (size_t)(32 + fr) * D); ur3 = *(const GAS v4u*)(up + (size_t)(48 + fr) * D); }
                        bf16x8 u0 = __builtin_bit_cast(bf16x8, (v4u){0u, 0u, 0u, 0u}), u1 = u0;
#define S5_HSTEP(J, UR) { const int blk = i4 + (J); u1 = u0; u0 = __builtin_bit_cast(bf16x8, UR); \
                            if (blk + 4 < 128 && fq < 2) UR = *(const GAS v4u*)(up + (size_t)((blk + 4) * 16 + fr) * D); \
                            if (blk < 128) { S5_WAIT(1, blk - 1) LAS float* xw = xs + (blk & 1) * 2112; \
_Pragma("unroll") \
                                for (int nt = 0; nt < 8; ++nt) { const f32x4 xd = __builtin_amdgcn_mfma_f32_16x16x32_bf16(bfr[nt], u0, (f32x4){0.f, 0.f, 0.f, 0.f}, 0, 0, 0); \
                                    *(LAS f32x4*)(xw + fr * 132 + 16 * nt + 4 * fq) = xd; } \
                                S5_POST(0, blk + 1) } \
                            if (blk >= 1 && blk <= 128) { S5_WAIT(1, blk) const LAS unsigned short* srd = ssb + ((blk - 1) & 1) * 2176; bf16x8 af[4]; \
_Pragma("unroll") \
                                for (int kk = 0; kk < 4; ++kk) af[kk] = *(const LAS bf16x8*)(srd + fr * 136 + 32 * kk + 8 * fq); \
                                S5_POST(2, blk) \
                                f32x4 ya = (f32x4){0.f, 0.f, 0.f, 0.f}; \
_Pragma("unroll") \
                                for (int kk = 0; kk < 4; ++kk) ya = __builtin_amdgcn_mfma_f32_16x16x32_bf16(cfr[kk], af[kk], ya, 0, 0, 0); \
                                ya = __builtin_amdgcn_mfma_f32_16x16x32_bf16(dfr, u1, ya, 0, 0, 0); \
                                float go[4]; \
_Pragma("unroll") \
                                for (int e = 0; e < 4; ++e) { const float yv = ya[e], uu2 = -2.0f * LOG2E * 0.7978845608028654f * (yv + 0.044715f * yv * yv * yv); go[e] = yv * __builtin_amdgcn_rcpf(1.0f + __builtin_amdgcn_exp2f(uu2)); } \
                                { u32x2g w; w.x = cvtpk_c(go[0], go[1]); w.y = cvtpk_c(go[2], go[3]); *(GAS u32x2g*)(Y + (size_t)(b * T + (blk - 1) * 16 + fr) * D + g * 16 + 4 * fq) = w; } } }
#pragma unroll 1
                        for (int i4 = 0; i4 < 132; i4 += 4) { S5_HSTEP(0, ur0) S5_HSTEP(1, ur1) S5_HSTEP(2, ur2) S5_HSTEP(3, ur3) }
#undef S5_HSTEP
                    }
                }
#undef S5_WAIT
#undef S5_POST
            }
        }
        else if (type == T_MIX1 && mixer == 1) {
            if (wave == 0) {
                for (int pair = blockIdx.x; pair < 256; pair += G) { const int b = pair >> 4, hh = pair & 15; const float bf = INP(17)[jm * 16 + hh];
                    float c[32]; float run = 0.f;
#pragma unroll
                    for (int i = 0; i < 32; ++i) { const float x = FLOG[(size_t)(b * T + 32 * lane + i) * 16 + hh] + bf; run += log_sigmoid_f(x); c[i] = run; }
                    float incl = run;
#pragma unroll
                    for (int o = 1; o < 64; o <<= 1) { const float nb = __shfl_up(incl, o); if (lane >= o) incl += nb; }
                    const float excl = incl - run;
#pragma unroll
                    for (int i = 0; i < 32; ++i) NEGF[(size_t)pair * T + 32 * lane + i] = -(c[i] + excl) * LOG2E;
                }
            }
        }
        else if (type == T_MIX2 && mixer == 1) {
            const attn_body::AttnTensors AT{(const attn_body::bf16*)BIG, (const attn_body::bf16*)(BIG + 32 * ME), (const attn_body::bf16*)(BIG + 64 * ME), (attn_body::bf16*)BIG, NEGF};
            const attn_body::StaticOrder S((int)G, (int)blockIdx.x);
            attn_body::attn_phase<attn_body::StaticOrder>((char*)lds + RING_OFF, AT, S);
        }
        else if (type == T_MIX1 && mixer == 2) {
            constexpr int PQD = 136, PSS = 72;
            LAS unsigned short* QD = (LAS unsigned short*)ldsl; LAS unsigned short* KI = QD + 64 * PQD; LAS unsigned short* KUT = KI + 64 * PQD; LAS unsigned short* VT = KUT + 128 * PSS;
            LAS unsigned short* ST = VT + 64 * PSS; LAS unsigned short* ATT = ST + 64 * PQD; LAS float* EB = (LAS float*)(ATT + 64 * PSS); LAS float* PS = EB + 128; LAS float* pq = PS + 512; LAS float* GLs = pq + 256;
            const bf16* QKV = BIG; bf16* OB = PP;
            const int fr = lane & 15, fq = lane >> 4, kk = tid & 127, tq = tid >> 7;
            for (int unit = blockIdx.x; unit < 256; unit += G) {
                const int b = unit >> 4, hh = (unit >> 2) & 3, vsp = unit & 3;
                __syncthreads();
                float wgr[16];
#pragma unroll
                for (int j = 0; j < 16; ++j) wgr[j] = INP(20)[(size_t)jm * 16 * 512 + j * 512 + hh * 128 + kk];
                const float bgr = INP(21)[jm * 512 + hh * 128 + kk];
                if (tid < 256) pq[tid] = ((const float*)(ws + WS_SV) + 32768)[b * 1024 + (tid < 128 ? hh * 128 + tid : 512 + hh * 128 + (tid - 128))];
                for (int i = tid; i < 64 * PQD / 2; i += 512) ((LAS unsigned*)ST)[i] = 0u;
                __syncthreads();
                float c_exact = 0.f;
                if (wave == 0) c_exact = wave_sum(pq[lane] * pq[128 + lane] + pq[64 + lane] * pq[192 + lane]) * 0.08838834764831845f;
                f32x4 Sacc[4];
#pragma unroll
                for (int nt = 0; nt < 4; ++nt) Sacc[nt] = (f32x4){0.f, 0.f, 0.f, 0.f};
                unsigned short qh[16], kh[16]; v4u vreg; f32x4 greg = (f32x4){0.f, 0.f, 0.f, 0.f};
                { const size_t m0 = (size_t)b * T;
#pragma unroll
                  for (int i = 0; i < 16; ++i) { const bf16* rp = QKV + (m0 + 16 * tq + i) * 3072 + hh * 128 + kk; qh[i] = rp[0]; kh[i] = rp[512]; }
                  vreg = *(const GAS v4u*)(QKV + (m0 + (tid >> 3)) * 3072 + 1024 + hh * 256 + vsp * 64 + (tid & 7) * 8);
                  if (tid < 256) greg = *(const GAS f32x4*)(FLOG + (m0 + (tid >> 2)) * 16 + (tid & 3) * 4); }
                for (int c = 0; c < 32; ++c) {
                    const size_t mb = (size_t)b * T + c * 64;
                    if (tid < 256) *(LAS f32x4*)(GLs + tid * 4) = greg;
                    __syncthreads();
                    float bc[16]; float run = 0.f;
#pragma unroll
                    for (int i = 0; i < 16; ++i) { const LAS f32x4* gp = (const LAS f32x4*)(GLs + (16 * tq + i) * 16); const f32x4 g0 = gp[0], g1 = gp[1], g2 = gp[2], g3 = gp[3];
                        float x = bgr;
                        x += g0[0] * wgr[0] + g0[1] * wgr[1] + g0[2] * wgr[2] + g0[3] * wgr[3]; x += g1[0] * wgr[4] + g1[1] * wgr[5] + g1[2] * wgr[6] + g1[3] * wgr[7];
                        x += g2[0] * wgr[8] + g2[1] * wgr[9] + g2[2] * wgr[10] + g2[3] * wgr[11]; x += g3[0] * wgr[12] + g3[1] * wgr[13] + g3[2] * wgr[14] + g3[3] * wgr[15];
                        run -= __builtin_amdgcn_logf(1.0f + __builtin_amdgcn_exp2f(-x * LOG2E)) * (0.6931471805599453f / 16.0f); bc[i] = run; }
                    PS[tq * 128 + kk] = run;
                    __syncthreads();
                    const float p0 = PS[kk], p1 = PS[128 + kk], p2 = PS[256 + kk], p3 = PS[384 + kk];
                    const float off = (tq > 0 ? p0 : 0.f) + (tq > 1 ? p1 : 0.f) + (tq > 2 ? p2 : 0.f), blast = (p0 + p1) + (p2 + p3);
                    if (tq == 0) EB[kk] = __builtin_amdgcn_exp2f(blast * LOG2E);
                    const float ebl = __builtin_amdgcn_exp2f(blast * LOG2E);
                    float kuv[16];
#pragma unroll
                    for (int i = 0; i < 16; ++i) { const int t = 16 * tq + i; const float bcu = bc[i] + off, e1 = __builtin_amdgcn_exp2f(bcu * LOG2E), ie1 = __builtin_amdgcn_rcpf(e1), qv = __uint_as_float((unsigned)qh[i] << 16), kv = __uint_as_float((unsigned)kh[i] << 16);
                        const float ki = kv * ie1;
                        const unsigned pk = cvtpk_c(qv * 0.08838834764831845f * e1, ki); QD[t * PQD + kk] = (unsigned short)pk; KI[t * PQD + kk] = (unsigned short)(pk >> 16);
                        kuv[i] = ki * ebl; }
                    { v4u w0, w1; w0.x = cvtpk_c(kuv[0], kuv[1]); w0.y = cvtpk_c(kuv[2], kuv[3]); w0.z = cvtpk_c(kuv[4], kuv[5]); w0.w = cvtpk_c(kuv[6], kuv[7]); w1.x = cvtpk_c(kuv[8], kuv[9]); w1.y = cvtpk_c(kuv[10], kuv[11]); w1.z = cvtpk_c(kuv[12], kuv[13]); w1.w = cvtpk_c(kuv[14], kuv[15]);
                      *(LAS v4u*)(KUT + kk * PSS + 16 * tq) = w0; *(LAS v4u*)(KUT + kk * PSS + 16 * tq + 8) = w1; }
                    { const int s = tid >> 3, v8 = (tid & 7) * 8; const unsigned w4[4] = {vreg.x, vreg.y, vreg.z, vreg.w};
#pragma unroll
                      for (int e = 0; e < 8; ++e) VT[(v8 + e) * PSS + s] = (unsigned short)((e & 1) ? (w4[e >> 1] >> 16) : (w4[e >> 1] & 0xffffu)); }
                    if (c + 1 < 32) { const size_t m1 = mb + 64;
#pragma unroll
                        for (int i = 0; i < 16; ++i) { const bf16* rp = QKV + (m1 + 16 * tq + i) * 3072 + hh * 128 + kk; qh[i] = rp[0]; kh[i] = rp[512]; }
                        vreg = *(const GAS v4u*)(QKV + (m1 + (tid >> 3)) * 3072 + 1024 + hh * 256 + vsp * 64 + (tid & 7) * 8);
                        if (tid < 256) greg = *(const GAS f32x4*)(FLOG + (m1 + (tid >> 2)) * 16 + (tid & 3) * 4); }
                    __syncthreads();
                    { const int mt = wave >> 1;
#pragma unroll
                      for (int n2 = 0; n2 < 2; ++n2) { const int nt = 2 * (wave & 1) + n2; f32x4 acc = (f32x4){0.f, 0.f, 0.f, 0.f};
                          if (nt <= mt) {
#pragma unroll
                              for (int k4 = 0; k4 < 4; ++k4) { const bf16x8 a = *(const LAS bf16x8*)(QD + (16 * mt + fr) * PQD + 32 * k4 + 8 * fq), bb = *(const LAS bf16x8*)(KI + (16 * nt + fr) * PQD + 32 * k4 + 8 * fq);
                                  acc = __builtin_amdgcn_mfma_f32_16x16x32_bf16(a, bb, acc, 0, 0, 0); }
                              if (nt == mt) {
#pragma unroll
                                  for (int e = 0; e < 4; ++e) if (fr > 4 * fq + e) acc[e] = 0.f; }
                              if (c == 0 && mt == 0 && nt == 0 && lane == 0) acc[0] = c_exact; }
                          { const unsigned p01 = cvtpk_c(acc[0], acc[1]), p23 = cvtpk_c(acc[2], acc[3]); unsigned short* dummy_ = nullptr; (void)dummy_;
                            ATT[(16 * mt + 4 * fq + 0) * PSS + 16 * nt + fr] = (unsigned short)p01; ATT[(16 * mt + 4 * fq + 1) * PSS + 16 * nt + fr] = (unsigned short)(p01 >> 16);
                            ATT[(16 * mt + 4 * fq + 2) * PSS + 16 * nt + fr] = (unsigned short)p23; ATT[(16 * mt + 4 * fq + 3) * PSS + 16 * nt + fr] = (unsigned short)(p23 >> 16); } } }
                    __syncthreads();
                    { const int mt = wave >> 1;
#pragma unroll
                      for (int n2 = 0; n2 < 2; ++n2) { const int nt = 2 * (wave & 1) + n2; f32x4 acc = (f32x4){0.f, 0.f, 0.f, 0.f};
#pragma unroll
                          for (int ks = 0; ks < 2; ++ks) { const bf16x8 a = *(const LAS bf16x8*)(ATT + (16 * mt + fr) * PSS + 32 * ks + 8 * fq), bb = *(const LAS bf16x8*)(VT + (16 * nt + fr) * PSS + 32 * ks + 8 * fq);
                              acc = __builtin_amdgcn_mfma_f32_16x16x32_bf16(a, bb, acc, 0, 0, 0); }
#pragma unroll
                          for (int k4 = 0; k4 < 4; ++k4) { const bf16x8 a = *(const LAS bf16x8*)(QD + (16 * mt + fr) * PQD + 32 * k4 + 8 * fq), bb = *(const LAS bf16x8*)(ST + (16 * nt + fr) * PQD + 32 * k4 + 8 * fq);
                              acc = __builtin_amdgcn_mfma_f32_16x16x32_bf16(a, bb, acc, 0, 0, 0); }
                          { const unsigned p01 = cvtpk_c(acc[0], acc[1]), p23 = cvtpk_c(acc[2], acc[3]); bf16* op = OB + (mb + 16 * mt + 4 * fq) * D + hh * 256 + vsp * 64 + 16 * nt + fr;
                            op[0] = (bf16)p01; op[D] = (bf16)(p01 >> 16); op[2 * D] = (bf16)p23; op[3 * D] = (bf16)(p23 >> 16); } } }
                    { const int mt = wave;
                      const f32x4 ebv = *(const LAS f32x4*)(EB + 16 * mt + 4 * fq);
#pragma unroll
                      for (int nt = 0; nt < 4; ++nt) { f32x4 acc = Sacc[nt] * ebv;
#pragma unroll
                          for (int ks = 0; ks < 2; ++ks) { const bf16x8 a = *(const LAS bf16x8*)(KUT + (16 * mt + fr) * PSS + 32 * ks + 8 * fq), bb = *(const LAS bf16x8*)(VT + (16 * nt + fr) * PSS + 32 * ks + 8 * fq);
                              acc = __builtin_amdgcn_mfma_f32_16x16x32_bf16(a, bb, acc, 0, 0, 0); }
                          Sacc[nt] = acc; } }
                    __syncthreads();
                    { const int mt = wave;
#pragma unroll
                      for (int nt = 0; nt < 4; ++nt) { u32x2g w; w.x = cvtpk_c(Sacc[nt][0], Sacc[nt][1]); w.y = cvtpk_c(Sacc[nt][2], Sacc[nt][3]); *(LAS u32x2g*)(ST + (16 * nt + fr) * PQD + 16 * mt + 4 * fq) = w; } }
                }
            }
        }
        else if (type == T_MIX2 && mixer == 2) {
            const bf16* OB = PP; const bf16* R = BIG + 2048; bf16* AO = PP;
            for (int it = gw; it < M * 4; it += NGW) { const size_t m = (size_t)(it >> 2); const int hh = it & 3, col = hh * 256 + 4 * lane;
                const u32x2g ow = *(const GAS u32x2g*)(OB + m * D + col), rw = *(const GAS u32x2g*)(R + m * 3072 + col);
                const f32x4 gn = *(const GAS f32x4*)(INP(22) + jm * 1024 + col);
                const float o0 = bf_lo(ow.x), o1 = bf_hi(ow.x), o2 = bf_lo(ow.y), o3 = bf_hi(ow.y);
                const float ss = wave_sum((o0 * o0 + o1 * o1) + (o2 * o2 + o3 * o3)); const float rn = rsqrtf(ss * (1.0f / 256.0f) + 1e-6f);
                const float r0 = bf_lo(rw.x), r1 = bf_hi(rw.x), r2 = bf_lo(rw.y), r3 = bf_hi(rw.y);
                u32x2g w; w.x = pk2(o0 * rn * gn[0] * r0 * sigmoid_f(r0), o1 * rn * gn[1] * r1 * sigmoid_f(r1)); w.y = pk2(o2 * rn * gn[2] * r2 * sigmoid_f(r2), o3 * rn * gn[3] * r3 * sigmoid_f(r3));
                *(GAS u32x2g*)(AO + m * D + col) = w; }
        }
        else if (type == T_UP0) {
            const float* P = INP(1) + (size_t)layer * M * 256;
            for (size_t idx = (size_t)gtid * 8; idx < (size_t)M * 256; idx += (size_t)NT * 8) { const f32x4 a = *(const GAS f32x4*)(P + idx), b2 = *(const GAS f32x4*)(P + idx + 4);
                v4u o; o.x = pk2(a[0], a[1]); o.y = pk2(a[2], a[3]); o.z = pk2(b2[0], b2[1]); o.w = pk2(b2[2], b2[3]); *(GAS v4u*)(PB + idx) = o; }
        }
        else if (type == T_FINAL) {
            const float* ssq = (const float*)(ws + WS_SSQA);
            const GAS f32x4* gf = (const GAS f32x4*)INP(28) + lane; const f32x4 g0 = gf[0], g1 = gf[64], g2 = gf[128], g3 = gf[192];
            for (int m = gw; m < M; m += NGW) { GAS f32x4* hr = (GAS f32x4*)(h + (size_t)m * D) + lane; const GAS u32x2g* br = (const GAS u32x2g*)(PB + (size_t)m * D) + lane;
                const float s = wave_sum(lane < 16 ? ssq[(size_t)m * 16 + lane] : 0.f); const float rs = rsqrtf(s * (1.0f / 1024.0f) + 1e-6f);
                const u32x2g w0 = br[0], w1 = br[64], w2 = br[128], w3 = br[192];
                hr[0] = (f32x4){bf_lo(w0.x), bf_hi(w0.x), bf_lo(w0.y), bf_hi(w0.y)} * rs * g0; hr[64] = (f32x4){bf_lo(w1.x), bf_hi(w1.x), bf_lo(w1.y), bf_hi(w1.y)} * rs * g1;
                hr[128] = (f32x4){bf_lo(w2.x), bf_hi(w2.x), bf_lo(w2.y), bf_hi(w2.y)} * rs * g2; hr[192] = (f32x4){bf_lo(w3.x), bf_hi(w3.x), bf_lo(w3.y), bf_hi(w3.y)} * rs * g3; }
        }

        } }
        for (int job = 0; job < 2; ++job) {
            int kind = -1;
            pg8::Gemm g{nullptr, nullptr, M, D, D};
            pg8::bf16_t* aO = nullptr; int aldc = D; const float* assq = nullptr; int asplit = 0; size_t astride = 0; float ascale = 1.f; float* aft = nullptr; int afc = 1 << 30;
            const pg8::bf16_t* rbase = HB; pg8::bf16_t* rhb = HB; const float* rssi = nullptr; float* rsso = nullptr;
            if (job == 0) {
                if (type == T_INPROJ) { kind = 0; g.A = PB; assq = ssq0;
                    if (mixer == 0) { g.Bt = Wb + W_S5IN + jm * W_S5STRIDE; g.N = 1024; aO = BIG; aldc = 1024; }
                    else if (mixer == 1) { g.Bt = Wb + W_FOXIN; g.N = 3328; aO = BIG; aldc = 1024; asplit = 1024; astride = 32 * ME; ascale = attn_body::C2; aft = FLOG; afc = 3072; }
                    else { g.Bt = Wb + W_GLAIN; g.N = 3328; aO = BIG; aldc = 3072; aft = FLOG; afc = 3072; } }
                else if (type == T_MIX2 && mixer == 0) { kind = 2; g.A = BIG + 32 * ME; g.Bt = Wb + W_S5GLU + jm * W_S5STRIDE; g.N = 2048; aO = BIG + 64 * ME; aldc = 1024; }
                else if (type == T_OUTPROJ) { kind = 3; g.A = (mixer == 0) ? BIG + 64 * ME : (mixer == 1) ? BIG : PP; g.Bt = Wb + ((mixer == 0) ? W_S5OUT + jm * W_S5STRIDE : (mixer == 1) ? W_FOXOUT : W_GLAOUT);
                    rbase = PB; rsso = ssq1; }
                else if (type == T_UP0 || type == T_UP1) { const int hf = (type == T_UP1); kind = 1; g.A = HB + (size_t)hf * 16 * ME; g.Bt = Wb + W_MLP1 + layer * W_MLPSTRIDE; g.M = M / 2; g.N = FF;
                    aO = BIG; aldc = FF; assq = ssq1 + (size_t)hf * (M / 2) * 16; }
                else if (type == T_DOWN0 || type == T_DOWN1) { const int hf = (type == T_DOWN1); kind = 3; g.A = BIG; g.Bt = Wb + W_MLP2 + layer * W_MLPSTRIDE; g.M = M / 2; g.K = FF;
                    rbase = HB + (size_t)hf * 16 * ME; rhb = HB + (size_t)hf * 16 * ME; rsso = ssq2 + (size_t)hf * (M / 2) * 16; }
                else if (type == T_PLE) { kind = 4; g.A = HB; g.Bt = Wb + W_PLEG + layer * W_PLESTRIDE; rssi = ssq2; rsso = ssq3; rhb = PB; }
            } else {
                if (type == T_DOWN0) { kind = 0; g.A = PB; g.Bt = Wb + W_PLEP + layer * W_PLESTRIDE; g.K = 256; aO = PP; aldc = 1024; }
            }
            if (kind < 0) continue;
            pg8::StaticOrder S; S.init(g.M, g.N, G, (int)blockIdx.x);
            for (int grep_ = 0; grep_ < ((kind <= 2) ? MK_DUP_G : 1); ++grep_)
            if (kind == 0) { pg8::EpiAct<0> E{aO, aldc, assq, asplit, astride, ascale, aft, afc}; pg8::gemm_phase<pg8::EpiAct<0>, pg8::StaticOrder, true, true>(ldsl + RING_OFF, g, S, E); }
            else if (kind == 1) { pg8::EpiAct<1> E{aO, aldc, assq, 0, 0, 1.f, nullptr, 1 << 30}; pg8::gemm_phase<pg8::EpiAct<1>, pg8::StaticOrder, true, true>(ldsl + RING_OFF, g, S, E); }
            else if (kind == 2) { pg8::EpiAct<2> E{aO, aldc, nullptr, 0, 0, 1.f, nullptr, 1 << 30}; pg8::gemm_phase<pg8::EpiAct<2>, pg8::StaticOrder, true, true>(ldsl + RING_OFF, g, S, E); }
            else if (kind == 3) { pg8::EpiRes<0> E{rbase, rhb, nullptr, rsso, nullptr, D}; pg8::gemm_phase<pg8::EpiRes<0>, pg8::StaticOrder, true, true>(ldsl + RING_OFF, g, S, E); }
            else { pg8::EpiRes<1> E{rbase, rhb, rssi, rsso, PP, D}; pg8::gemm_phase<pg8::EpiRes<1>, pg8::StaticOrder, true, true>(ldsl + RING_OFF, g, S, E); }
        }

        if (ph + 1 < args.ph_hi) {
#if !MK_PER_PHASE
#if MK_USE_CG
            grid.sync();
#else
            if (args.ph_hi > 100000) grid.sync();
            xcd_barrier(bar);
#endif
#endif
        }
    }
}

#undef ws
#undef h
#undef Wb
#undef HB
#undef PB
#undef PP
#undef BIG
#undef FLOG
#undef NEGF
#undef ssq0
#undef ssq1
#undef ssq2
#undef ssq3
extern "C" void kernel_launch(void* const* d_in, const int* in_sizes, int n_in, void* d_out, int out_size, void* d_ws, size_t ws_size, hipStream_t stream) {
    static int grid = 0;
    if (grid == 0) {
        if (n_in != 29 || in_sizes[0] != M * D || out_size != M * D || ws_size < WS_END) { fprintf(stderr, "kernel_launch: unexpected shapes: n_in %d in0 %d out %d ws %zu (need %zu)\n", n_in, n_in > 0 ? in_sizes[0] : -1, out_size, ws_size, (size_t)WS_END); grid = -1; return; }
        int dev = 0, cus = 0, per_cu = 0;
        if (hipGetDevice(&dev) != hipSuccess || hipDeviceGetAttribute(&cus, hipDeviceAttributeMultiprocessorCount, dev) != hipSuccess) { grid = -1; return; }
        if (hipFuncSetAttribute((const void*)trunk_fwd, hipFuncAttributeMaxDynamicSharedMemorySize, LDS_BYTES) != hipSuccess) { fprintf(stderr, "kernel_launch: hipFuncSetAttribute failed\n"); grid = -1; return; }
        if (hipOccupancyMaxActiveBlocksPerMultiprocessor(&per_cu, (const void*)trunk_fwd, NWAVES * 64, LDS_BYTES) != hipSuccess || per_cu < 1) { fprintf(stderr, "kernel_launch: occupancy query says %d\n", per_cu); per_cu = 1; }
        (void)hipGetLastError();
        grid = cus;
    }
    if (grid < 0) return;
    (void)hipMemsetAsync((char*)d_ws + WS_CTL, 0, CTL_ZERO_BYTES, stream);
    Args a{};
    for (int i = 0; i < 29; ++i) a.in[i] = (const float*)d_in[i];
    a.out = (float*)d_out; a.ws = (unsigned char*)d_ws;
#if MK_PER_PHASE
    for (int ph = 0; ph < N_PHASES; ++ph) { a.ph_lo = ph; a.ph_hi = ph + 1; hipLaunchKernelGGL(trunk_fwd, dim3(grid), dim3(NWAVES * 64), LDS_BYTES, stream, a); }
#else
    a.ph_lo = 0; a.ph_hi = N_PHASES;
    void* kargs[] = {&a};
    hipError_t e = hipLaunchCooperativeKernel((const void*)trunk_fwd, dim3(grid), dim3(NWAVES * 64), kargs, LDS_BYTES, stream);
    if (e != hipSuccess) fprintf(stderr, "kernel_launch: cooperative launch failed: %s (grid %d)\n", hipGetErrorString(e), grid);
#endif
}
```

```cpp
#include <hip/hip_runtime.h>
#include <hip/hip_cooperative_groups.h>
#include <cstdio>
#include <cstdint>
#include <hip/hip_bf16.h>
#include <cmath>
namespace pg8 {
#define PG8_LAS __attribute__((address_space(3)))
typedef unsigned short bf16_t;
typedef short bf16x8 __attribute__((ext_vector_type(8)));
typedef float f32x4 __attribute__((ext_vector_type(4)));
typedef unsigned u32x4 __attribute__((ext_vector_type(4)));
constexpr int BM = 256, BK = 64, HALF = 128, HTB = HALF * BK * 2  , STAGE_BYTES = 8 * HTB, NXCD = 8, WGM = 8;

__host__ __device__ __forceinline__ int lds_byte(int r, int c) { const int st = (r >> 4) * 2 + (c >> 5), rr = r & 15, cc = c & 31, ob = rr * 64 + cc * 2; return st * 1024 + (ob ^ (((ob >> 9) & 1) << 5)); }
__host__ __device__ __forceinline__ void stage_rc(int b, int& R, int& C) { const int st = b / 1024, sb = b % 1024, swz = sb ^ (((sb >> 9) & 1) << 5); R = (st >> 1) * 16 + swz / 64; C = (st & 1) * 32 + (swz % 64) / 2; }
__host__ __device__ __forceinline__ int perm32(int rho) { const int n = rho >> 4, i = rho & 15; return 8 * (i >> 2) + 4 * n + (i & 3); }

struct Unit { int pm, pn; };
struct Gemm { const bf16_t* A; const bf16_t* Bt; int M, N, K; };

struct StaticOrder {
    int nM, nN, nwg, G, c;
    __host__ __device__ void init(int M, int N, int G_, int c_) { nM = M / BM; nN = N / BM; nwg = nM * nN; G = G_; c = c_; }
    __host__ __device__ bool next(int i, Unit& u) const {
        const long L = (long)i * G + c; if (L >= nwg) return false;
        int wgid = (int)L; { const int q = nwg / NXCD, r = nwg % NXCD, xcd = wgid % NXCD, off = wgid / NXCD; wgid = (xcd < r ? xcd * (q + 1) : r * (q + 1) + (xcd - r) * q) + off; }
        const int nig = WGM * nN, gid = wgid / nig, fm = gid * WGM, gsz = (nM - fm) < WGM ? (nM - fm) : WGM;
        u.pm = fm + ((wgid % nig) % gsz); u.pn = (wgid % nig) / gsz; return true;
    }
    __device__ __forceinline__ void a_ready(const Unit&) const {}
    __device__ __forceinline__ void done(const Unit&) const {}
};

__device__ __forceinline__ unsigned cvt_pk_bf16(float lo, float hi) { unsigned r; asm volatile("v_cvt_pk_bf16_f32 %0, %1, %2" : "=v"(r) : "v"(lo), "v"(hi)); return r; }
typedef float f32x2 __attribute__((ext_vector_type(2)));
typedef unsigned u32x2 __attribute__((ext_vector_type(2)));
__device__ __forceinline__ float sigm(float x) { return 1.0f / (1.0f + __expf(-x)); }
__device__ __forceinline__ float row_rstd(const float* ssq, size_t row) {
    const f32x4* s = (const f32x4*)(ssq + row * 16); const f32x4 a = (s[0] + s[1]) + (s[2] + s[3]);
    return rsqrtf(((a[0] + a[1]) + (a[2] + a[3])) * (1.0f / 1024.0f) + 1e-6f);
}
template <int MODE> struct EpiAct {
    static constexpr bool PERM = true, AFTER_DRAIN = false;
    bf16_t* O; int ldc; const float* ssq; int split_cols; size_t split_stride; float scale0; float* ftile; int fcol0;
    __device__ __forceinline__ void operator()(const f32x4 (&acc)[2][2][4][2], const Unit& u, int wr, int wc, int fr, int fq) const {
        const int row0 = u.pm * BM + wr * 64 + fr; int colt = u.pn * BM; bf16_t* base = O;
        float rs[2][4];
#pragma unroll
        for (int ai = 0; ai < 2; ++ai)
#pragma unroll
            for (int m = 0; m < 4; ++m) rs[ai][m] = ssq ? row_rstd(ssq, (size_t)(row0 + ai * HALF + m * 16)) : 1.0f;
        if (MODE == 0 && ftile != nullptr && colt >= fcol0) {
            if (wc == 0 && fq < 2) {
#pragma unroll
                for (int ai = 0; ai < 2; ++ai)
#pragma unroll
                    for (int m = 0; m < 4; ++m) { float* dst = ftile + (size_t)(row0 + ai * HALF + m * 16) * 16 + 8 * fq;
                        *(f32x4*)dst = acc[ai][0][m][0] * rs[ai][m]; *(f32x4*)(dst + 4) = acc[ai][0][m][1] * rs[ai][m]; }
            }
            return;
        }
        if (MODE == 2) {
            const int col0 = u.pn * HALF + wc * 32 + 8 * fq;
#pragma unroll
            for (int ai = 0; ai < 2; ++ai)
#pragma unroll
                for (int m = 0; m < 4; ++m) { bf16_t* rowp = base + (size_t)(row0 + ai * HALF + m * 16) * ldc + col0;
                    const f32x4 a0 = acc[ai][0][m][0], a1 = acc[ai][0][m][1], g0 = acc[ai][1][m][0], g1 = acc[ai][1][m][1];
                    u32x4 w; w.x = cvt_pk_bf16(a0[0] * sigm(g0[0]), a0[1] * sigm(g0[1])); w.y = cvt_pk_bf16(a0[2] * sigm(g0[2]), a0[3] * sigm(g0[3]));
                    w.z = cvt_pk_bf16(a1[0] * sigm(g1[0]), a1[1] * sigm(g1[1])); w.w = cvt_pk_bf16(a1[2] * sigm(g1[2]), a1[3] * sigm(g1[3]));
                    *(u32x4*)rowp = w; }
            return;
        }
        float sc = 1.f; if (split_cols) { const int t = colt / split_cols; base += (size_t)t * split_stride; colt -= t * split_cols; if (t == 0) sc = scale0; }
        const int col0 = colt + wc * 32 + 8 * fq;
#pragma unroll
        for (int ai = 0; ai < 2; ++ai)
#pragma unroll
            for (int m = 0; m < 4; ++m) { bf16_t* rowp = base + (size_t)(row0 + ai * HALF + m * 16) * ldc + col0; const float s = rs[ai][m] * sc;
#pragma unroll
                for (int bj = 0; bj < 2; ++bj) { f32x4 v0 = acc[ai][bj][m][0] * s, v1 = acc[ai][bj][m][1] * s;
                    if (MODE == 1) {
#pragma unroll
                        for (int e = 0; e < 4; ++e) { const float a = fmaxf(v0[e], 0.f), b = fmaxf(v1[e], 0.f); v0[e] = a * a; v1[e] = b * b; } }
                    u32x4 w; w.x = cvt_pk_bf16(v0[0], v0[1]); w.y = cvt_pk_bf16(v0[2], v0[3]); w.z = cvt_pk_bf16(v1[0], v1[1]); w.w = cvt_pk_bf16(v1[2], v1[3]);
                    *(u32x4*)(rowp + bj * HALF) = w; } }
    }
};
#ifndef MK_BF16_RES
#define MK_BF16_RES 1
#endif
template <int MODE> struct EpiRes {
    static constexpr bool PERM = true, AFTER_DRAIN = false;
    const bf16_t* baseb; bf16_t* hb; const float* ssq_in; float* ssq_out; const bf16_t* pp; int ldc;
    __device__ __forceinline__ void operator()(const f32x4 (&acc)[2][2][4][2], const Unit& u, int wr, int wc, int fr, int fq) const {
        const int col0 = u.pn * BM + wc * 32 + 8 * fq;
        constexpr int MB = (MODE == 1) ? 2 : 4;
#pragma unroll
        for (int ai = 0; ai < 2; ++ai)
#pragma unroll
            for (int m0 = 0; m0 < 4; m0 += MB) {
                u32x4 pre[MB][2]; u32x4 ppw[MB][2]; float rs[MB];
#pragma unroll
                for (int mm = 0; mm < MB; ++mm) { const int r = u.pm * BM + ai * HALF + wr * 64 + (m0 + mm) * 16 + fr; const size_t off = (size_t)r * ldc + col0;
                    rs[mm] = 1.f; if (MODE == 1) rs[mm] = row_rstd(ssq_in, (size_t)r);
#pragma unroll
                    for (int bj = 0; bj < 2; ++bj) { pre[mm][bj] = *(const u32x4*)(baseb + off + bj * HALF); if (MODE == 1) ppw[mm][bj] = *(const u32x4*)(pp + off + bj * HALF); } }
#pragma unroll
                for (int mm = 0; mm < MB; ++mm) { const int m = m0 + mm; const int r = u.pm * BM + ai * HALF + wr * 64 + m * 16 + fr; const size_t off = (size_t)r * ldc + col0;
                    float q = 0.f;
#pragma unroll
                    for (int bj = 0; bj < 2; ++bj) { const size_t o2 = off + bj * HALF; f32x4 v[2];
#pragma unroll
                        for (int n = 0; n < 2; ++n) { const unsigned b0 = n ? pre[mm][bj].z : pre[mm][bj].x, b1 = n ? pre[mm][bj].w : pre[mm][bj].y;
                            const f32x4 b = (f32x4){__uint_as_float(b0 << 16), __uint_as_float(b0 & 0xffff0000u), __uint_as_float(b1 << 16), __uint_as_float(b1 & 0xffff0000u)}; const f32x4 a = acc[ai][bj][m][n];
                            if (MODE == 1) { const unsigned w0 = n ? ppw[mm][bj].z : ppw[mm][bj].x, w1 = n ? ppw[mm][bj].w : ppw[mm][bj].y;
                                const float p0 = __uint_as_float(w0 << 16), p1 = __uint_as_float(w0 & 0xffff0000u), p2 = __uint_as_float(w1 << 16), p3 = __uint_as_float(w1 & 0xffff0000u);
                                v[n][0] = b[0] + p0 * sigm(a[0] * rs[mm]); v[n][1] = b[1] + p1 * sigm(a[1] * rs[mm]); v[n][2] = b[2] + p2 * sigm(a[2] * rs[mm]); v[n][3] = b[3] + p3 * sigm(a[3] * rs[mm]); }
                            else v[n] = b + a; }
                        u32x4 w; w.x = cvt_pk_bf16(v[0][0], v[0][1]); w.y = cvt_pk_bf16(v[0][2], v[0][3]); w.z = cvt_pk_bf16(v[1][0], v[1][1]); w.w = cvt_pk_bf16(v[1][2], v[1][3]); *(u32x4*)(hb + o2) = w;
                        const float r0 = __uint_as_float(w.x << 16), r1 = __uint_as_float(w.x & 0xffff0000u), r2 = __uint_as_float(w.y << 16), r3 = __uint_as_float(w.y & 0xffff0000u);
                        const float r4 = __uint_as_float(w.z << 16), r5 = __uint_as_float(w.z & 0xffff0000u), r6 = __uint_as_float(w.w << 16), r7 = __uint_as_float(w.w & 0xffff0000u);
                        q += ((r0 * r0 + r1 * r1) + (r2 * r2 + r3 * r3)) + ((r4 * r4 + r5 * r5) + (r6 * r6 + r7 * r7)); }
                    q += __shfl_xor(q, 16); q += __shfl_xor(q, 32);
                    if (fq == 0) ssq_out[(size_t)r * 16 + u.pn * 4 + wc] = q; }
                asm volatile("" ::: "memory"); }
    }
};
template <class Epi, class Sched, bool ALIGN_EPI = false, bool SP2 = false>
__device__ __forceinline__ void gemm_phase(PG8_LAS unsigned char* lds, const Gemm g, const Sched& S, const Epi& E) {
    int tid_ = threadIdx.x; asm volatile("" : "+v"(tid_)); const int tid = tid_, wid = __builtin_amdgcn_readfirstlane(tid >> 6), lane = tid & 63, wr = wid >> 2, wc = wid & 3, fr = lane & 15, fq = lane >> 4;
    const int K = g.K, nt = K / BK;
    unsigned voffA[2], voffB[2];
#pragma unroll
    for (int i = 0; i < 2; ++i) { int R, C; stage_rc(tid * 16 + i * 8192, R, C); const int Rb = Epi::PERM ? ((R & ~31) + perm32(R & 31)) : R;
        voffA[i] = (unsigned)(R * K + C) * 2u; voffB[i] = (unsigned)(Rb * K + C) * 2u; }
    const size_t kstep = (size_t)(BK * 2);
    const size_t hstep = (size_t)HALF * K * 2;
    const size_t tstep = 2 * hstep;
    const unsigned ldsw = (unsigned)wid * 1024u;
    const int aoff = lds_byte(wr * 64 + fr, fq * 8), boff = lds_byte(wc * 32 + fr, fq * 8);
#define PG8_SA(b, h) (((b) * 2 + (h)) * HTB)
#define PG8_SB(b, h) ((4 + (b) * 2 + (h)) * HTB)
#define PG8_STAGE(bufoff, gbase, voff) do { _Pragma("unroll") for (int _i = 0; _i < 2; ++_i) \
        __builtin_amdgcn_global_load_lds((const unsigned*)((const char*)(gbase) + (voff)[_i]), (PG8_LAS unsigned*)(lds + (bufoff) + ldsw + _i * 8192), 16, 0, 0); } while (0)
#define PG8_LDA(dst, b, h) do { _Pragma("unroll") for (int m = 0; m < 4; ++m) _Pragma("unroll") for (int k = 0; k < 2; ++k) dst[m][k] = *(const PG8_LAS bf16x8*)(lds + PG8_SA(b, h) + aoff + m * 2048 + k * 1024); } while (0)
#define PG8_LDB(dst, b, h) do { _Pragma("unroll") for (int n = 0; n < 2; ++n) _Pragma("unroll") for (int k = 0; k < 2; ++k) dst[n][k] = *(const PG8_LAS bf16x8*)(lds + PG8_SB(b, h) + boff + n * 2048 + k * 1024); } while (0)
#define PG8_MMA(ai, bj, At, Bt) do { __builtin_amdgcn_s_setprio(1); _Pragma("unroll") for (int m = 0; m < 4; ++m) _Pragma("unroll") for (int n = 0; n < 2; ++n) _Pragma("unroll") for (int k = 0; k < 2; ++k) \
        acc[ai][bj][m][n] = __builtin_amdgcn_mfma_f32_16x16x32_bf16(Bt[n][k], At[m][k], acc[ai][bj][m][n], 0, 0, 0); __builtin_amdgcn_s_setprio(0); } while (0)
#define PG8_WAIT_V(n) asm volatile("s_waitcnt vmcnt(" #n ")" ::: "memory")
#define PG8_WAIT_L(n) asm volatile("s_waitcnt lgkmcnt(" #n ")" ::: "memory")
#define PG8_BAR __builtin_amdgcn_s_barrier()
#define PG8_SCHED __builtin_amdgcn_sched_barrier(0)
    Unit cur, nxt; int ui = 0;
    if (!S.next(0, cur)) return;
    f32x4 acc[2][2][4][2];
#pragma unroll
    for (int a = 0; a < 2; ++a)
#pragma unroll
        for (int b = 0; b < 2; ++b)
#pragma unroll
            for (int m = 0; m < 4; ++m)
#pragma unroll
                for (int n = 0; n < 2; ++n) acc[a][b][m][n] = (f32x4){0.f, 0.f, 0.f, 0.f};
    bf16x8 At[4][2], B0[2][2], B1[2][2];
    const char* cA = (const char*)g.A + (size_t)cur.pm * tstep; const char* cB = (const char*)g.Bt + (size_t)cur.pn * tstep;
    S.a_ready(cur);
    if constexpr (SP2) {
        PG8_STAGE(PG8_SB(0, 0), cB, voffB); PG8_STAGE(PG8_SB(0, 1), cB + hstep, voffB); PG8_STAGE(PG8_SA(0, 0), cA, voffA); PG8_STAGE(PG8_SA(0, 1), cA + hstep, voffA);
        if (wr == 1) PG8_BAR;
        PG8_WAIT_V(2); PG8_BAR;
        PG8_STAGE(PG8_SB(1, 0), cB + kstep, voffB); PG8_STAGE(PG8_SA(1, 0), cA + kstep, voffA); PG8_STAGE(PG8_SB(1, 1), cB + hstep + kstep, voffB);
        PG8_WAIT_V(6); PG8_BAR;
    } else {
        PG8_STAGE(PG8_SB(0, 0), cB, voffB); PG8_STAGE(PG8_SA(0, 0), cA, voffA); PG8_STAGE(PG8_SB(0, 1), cB + hstep, voffB); PG8_STAGE(PG8_SA(0, 1), cA + hstep, voffA);
        if (wr == 1) PG8_BAR;
        PG8_WAIT_V(4); PG8_BAR;
        PG8_STAGE(PG8_SB(1, 0), cB + kstep, voffB); PG8_STAGE(PG8_SA(1, 0), cA + kstep, voffA); PG8_STAGE(PG8_SB(1, 1), cB + hstep + kstep, voffB);
        PG8_WAIT_V(6); PG8_BAR;
    }
    for (;;) {
        const bool has_next = S.next(ui + 1, nxt);
        const char* nA = has_next ? (const char*)g.A + (size_t)nxt.pm * tstep : cA; const char* nB = has_next ? (const char*)g.Bt + (size_t)nxt.pn * tstep : cB;
        for (int t = 0; t < nt; t += 2) {
            const bool last = (t == nt - 2);
            const char* a1 = cA + (size_t)(t + 1) * kstep;
            const char* a2 = last ? nA : cA + (size_t)(t + 2) * kstep; const char* b2 = last ? nB : cB + (size_t)(t + 2) * kstep;
            const char* a3 = a2 + kstep; const char* b3 = b2 + kstep;
            if (last && has_next) S.a_ready(nxt);
            if constexpr (SP2) {
            PG8_LDB(B0, 0, 0); PG8_LDB(B1, 0, 1); PG8_SCHED; PG8_LDA(At, 0, 0); PG8_STAGE(PG8_SA(1, 1), a1 + hstep, voffA);
            PG8_WAIT_V(8); PG8_WAIT_L(0); PG8_BAR; PG8_MMA(0, 0, At, B0); PG8_MMA(0, 1, At, B1); PG8_BAR; PG8_SCHED;
            PG8_LDA(At, 0, 1); PG8_STAGE(PG8_SB(0, 0), b2, voffB); PG8_STAGE(PG8_SB(0, 1), b2 + hstep, voffB); PG8_STAGE(PG8_SA(0, 0), a2, voffA);
            PG8_WAIT_V(8); PG8_WAIT_L(0); PG8_BAR; PG8_MMA(1, 0, At, B0); PG8_MMA(1, 1, At, B1); PG8_BAR; PG8_SCHED;
            PG8_LDB(B0, 1, 0); PG8_LDB(B1, 1, 1); PG8_SCHED; PG8_LDA(At, 1, 0); PG8_STAGE(PG8_SA(0, 1), a2 + hstep, voffA);
            PG8_WAIT_V(8); PG8_WAIT_L(0); PG8_BAR; PG8_MMA(0, 0, At, B0); PG8_MMA(0, 1, At, B1); PG8_BAR; PG8_SCHED;
            PG8_LDA(At, 1, 1); PG8_STAGE(PG8_SB(1, 0), b3, voffB); PG8_STAGE(PG8_SB(1, 1), b3 + hstep, voffB); PG8_STAGE(PG8_SA(1, 0), a3, voffA);
            PG8_WAIT_V(8); PG8_WAIT_L(0); PG8_BAR; PG8_MMA(1, 0, At, B0); PG8_MMA(1, 1, At, B1); PG8_BAR; PG8_SCHED;
            } else {
            PG8_LDB(B0, 0, 0); PG8_SCHED; PG8_LDA(At, 0, 0); PG8_STAGE(PG8_SA(1, 1), a1 + hstep, voffA);
            PG8_WAIT_L(8); PG8_BAR; PG8_WAIT_L(0); PG8_MMA(0, 0, At, B0); PG8_BAR; PG8_SCHED;
            PG8_LDB(B1, 0, 1); PG8_STAGE(PG8_SB(0, 0), b2, voffB);
            PG8_BAR; PG8_WAIT_L(0); PG8_MMA(0, 1, At, B1); PG8_BAR;
            PG8_LDA(At, 0, 1); PG8_STAGE(PG8_SA(0, 0), a2, voffA);
            PG8_BAR; PG8_WAIT_L(0); PG8_MMA(1, 0, At, B0); PG8_BAR; PG8_SCHED;
            PG8_STAGE(PG8_SB(0, 1), b2 + hstep, voffB);
            PG8_WAIT_V(6); PG8_BAR; PG8_MMA(1, 1, At, B1); PG8_BAR;
            PG8_LDB(B0, 1, 0); PG8_SCHED; PG8_LDA(At, 1, 0); PG8_STAGE(PG8_SA(0, 1), a2 + hstep, voffA);
            PG8_WAIT_L(8); PG8_BAR; PG8_WAIT_L(0); PG8_MMA(0, 0, At, B0); PG8_BAR; PG8_SCHED;
            PG8_LDB(B1, 1, 1); PG8_STAGE(PG8_SB(1, 0), b3, voffB);
            PG8_BAR; PG8_WAIT_L(0); PG8_MMA(0, 1, At, B1); PG8_BAR;
            PG8_LDA(At, 1, 1); PG8_STAGE(PG8_SA(1, 0), a3, voffA);
            PG8_BAR; PG8_WAIT_L(0); PG8_MMA(1, 0, At, B0); PG8_BAR; PG8_SCHED;
            PG8_STAGE(PG8_SB(1, 1), b3 + hstep, voffB);
            PG8_WAIT_V(6); PG8_BAR; PG8_MMA(1, 1, At, B1); PG8_BAR;
            }
        }
        if constexpr (ALIGN_EPI) { if (wr == 0) PG8_BAR; }
        if constexpr (!Epi::AFTER_DRAIN) { E(acc, cur, wr, wc, fr, fq); S.done(cur); }
        if (!has_next) break;
#pragma unroll
        for (int a = 0; a < 2; ++a)
#pragma unroll
            for (int b = 0; b < 2; ++b)
#pragma unroll
                for (int m = 0; m < 4; ++m)
#pragma unroll
                    for (int n = 0; n < 2; ++n) acc[a][b][m][n] = (f32x4){0.f, 0.f, 0.f, 0.f};
        cur = nxt; cA = nA; cB = nB; ++ui;
        if constexpr (ALIGN_EPI) { if (wr == 1) PG8_BAR; }
    }
    PG8_WAIT_V(0);
    if constexpr (!ALIGN_EPI) { if (wr == 0) PG8_BAR; }
    PG8_BAR;
    if constexpr (Epi::AFTER_DRAIN) { E.fused(acc, cur, wr, wc, fr, fq, lds, wid, lane); S.done(cur); }
#undef PG8_SA
#undef PG8_SB
#undef PG8_STAGE
#undef PG8_LDA
#undef PG8_LDB
#undef PG8_MMA
#undef PG8_WAIT_V
#undef PG8_WAIT_L
#undef PG8_BAR
#undef PG8_SCHED
}
}
#include <hip/hip_bf16.h>
#include <cmath>
namespace attn_body {
using bf16=__hip_bfloat16;
using bf16x8=__attribute__((ext_vector_type(8)))short;
using s16x4=__attribute__((ext_vector_type(4)))short;
using f32x16=__attribute__((ext_vector_type(16)))float;
using u32x4=__attribute__((ext_vector_type(4)))unsigned;
constexpr int BATCH=16,NHEAD=16,SEQ=2048,D=64,DM=NHEAD*D;
constexpr int NW=8,QBLK=32,QB=QBLK*NW,KVBLK=64,NQB=SEQ/QB;
constexpr int ATTN_PITCH=DM, ATTN_UNIT_ROWS=QB;
__device__ __forceinline__ int crow(int r,int hi){return (r&3)+8*(r>>2)+4*hi;}
#define SBAR() __builtin_amdgcn_sched_barrier(0)
__device__ __forceinline__ void cmask(f32x16&p0,f32x16&p1,int jb,int qrel,int hi){
  const float NEG=-INFINITY; int kb=64*jb+4*hi;
  #pragma unroll
  for(int r=0;r<16;++r){int kv=kb+(r&3)+8*(r>>2); if(kv>qrel)p0[r]=NEG; if(kv+32>qrel)p1[r]=NEG;}
}

constexpr int NSLOT=3, SLOTB=8192;
constexpr int LDS_K=0, LDS_V=NSLOT*SLOTB, LDS_WS=2*NSLOT*SLOTB, LDS_OST=LDS_WS+NW*64*4, LDS_BIAS=LDS_OST+NW*4096, LDS_BYTES=LDS_BIAS+SEQ*4;
constexpr float C2=0.125f*1.4426950408889634f;
__device__ __forceinline__ void glds16(const void*gsrc,unsigned lds_dst){unsigned keep;
  asm volatile("s_mov_b32 %0, m0\n\ts_mov_b32 m0, %2\n\ts_nop 0\n\tglobal_load_lds_dwordx4 %1, off\n\ts_mov_b32 m0, %0":"=&s"(keep):"v"(gsrc),"s"(lds_dst):"memory");}
__device__ __forceinline__ float max3f(float a,float b,float c){float r;asm("v_max3_f32 %0, %1, %2, %3":"=v"(r):"v"(a),"v"(b),"v"(c));return r;}
__device__ __forceinline__ float max2f(float a,float b){float r;asm("v_max_f32_e32 %0, %1, %2":"=v"(r):"v"(a),"v"(b));return r;}
__device__ __forceinline__ float fadd_s(float a,float b){float r;asm("v_add_f32_e32 %0, %1, %2":"=v"(r):"v"(a),"v"(b));return r;}
__device__ __forceinline__ float fsub_s(float a,float b){float r;asm("v_sub_f32_e32 %0, %1, %2":"=v"(r):"v"(a),"v"(b));return r;}
typedef float f32x2_t __attribute__((ext_vector_type(2))); typedef __bf16 bf16x2_t __attribute__((ext_vector_type(2)));
__device__ __forceinline__ unsigned cvtpk_s(float lo,float hi){f32x2_t v={lo,hi};bf16x2_t b=__builtin_convertvector(v,bf16x2_t);return __builtin_bit_cast(unsigned,b);}
#define WAIT_BAR(N) asm volatile("s_waitcnt vmcnt(" #N ") lgkmcnt(0)\n\ts_barrier":::"memory")

__device__ __forceinline__ void qkt(f32x16&p0,f32x16&p1,const char*Kslot,const bf16x8*qr,const f32x16&negm,int r32,int hi){
  const char*kb=Kslot+hi*1024+r32*16;
  #pragma unroll
  for(int d0=0;d0<4;++d0){
    const bf16x8 b0=*reinterpret_cast<const bf16x8*>(kb+d0*2048);
    const bf16x8 b1=*reinterpret_cast<const bf16x8*>(kb+d0*2048+512);
    if(d0==0){p0=__builtin_amdgcn_mfma_f32_32x32x16_bf16(b0,qr[0],negm,0,0,0);p1=__builtin_amdgcn_mfma_f32_32x32x16_bf16(b1,qr[0],negm,0,0,0);}
    else{p0=__builtin_amdgcn_mfma_f32_32x32x16_bf16(b0,qr[d0],p0,0,0,0);p1=__builtin_amdgcn_mfma_f32_32x32x16_bf16(b1,qr[d0],p1,0,0,0);}}
}
typedef __attribute__((address_space(3))) const char* lds_cptr;
typedef short v4i16_t __attribute__((ext_vector_type(4)));
__device__ __forceinline__ void kload8(bf16x8*kf,lds_cptr kp){
  kf[0]=*(const __attribute__((address_space(3))) bf16x8*)(kp);      kf[1]=*(const __attribute__((address_space(3))) bf16x8*)(kp+512);
  kf[2]=*(const __attribute__((address_space(3))) bf16x8*)(kp+2048); kf[3]=*(const __attribute__((address_space(3))) bf16x8*)(kp+2560);
  kf[4]=*(const __attribute__((address_space(3))) bf16x8*)(kp+4096); kf[5]=*(const __attribute__((address_space(3))) bf16x8*)(kp+4608);
  kf[6]=*(const __attribute__((address_space(3))) bf16x8*)(kp+6144); kf[7]=*(const __attribute__((address_space(3))) bf16x8*)(kp+6656);
}
__device__ __forceinline__ void kload2(bf16x8*kf,lds_cptr kp,int j){ kf[2*j]=*(const __attribute__((address_space(3))) bf16x8*)(kp+j*2048); kf[2*j+1]=*(const __attribute__((address_space(3))) bf16x8*)(kp+j*2048+512); }
__device__ __forceinline__ s16x4 vtr(lds_cptr p){ return __builtin_bit_cast(s16x4,__builtin_amdgcn_ds_read_tr16_b64_v4i16((__attribute__((address_space(3))) v4i16_t*)p)); }
__device__ __forceinline__ float rowmax(const f32x16&p0,const f32x16&p1){
  float a=max3f(p0[0],p0[1],p1[0]),b=max3f(p0[2],p0[3],p1[1]);a=max3f(a,p1[2],p1[3]);
  #pragma unroll
  for(int r=4;r<16;r+=4){a=max3f(a,p0[r],p0[r+1]);b=max3f(b,p0[r+2],p0[r+3]);a=max3f(a,p1[r],p1[r+1]);b=max3f(b,p1[r+2],p1[r+3]);}
  const float m=max2f(a,b);
  auto rr=__builtin_amdgcn_permlane32_swap(__float_as_uint(m),__float_as_uint(m),false,false);
  return max2f(__uint_as_float(rr[0]),__uint_as_float(rr[1]));
}
__device__ __forceinline__ void pv(f32x16*o,int vb,bf16x8 pa0,bf16x8 pa1,bf16x8 pa2,bf16x8 pa3){
  #pragma unroll
  for(int d0=0;d0<2;++d0){s16x4 lo[4],hi[4];
    #pragma unroll
    for(int ks=0;ks<4;++ks){
      asm volatile("ds_read_b64_tr_b16 %0,%1 offset:%c2":"=&v"(lo[ks]):"v"(vb),"i"(d0*4096+ks*1024):"memory");
      asm volatile("ds_read_b64_tr_b16 %0,%1 offset:%c2":"=&v"(hi[ks]):"v"(vb),"i"(d0*4096+ks*1024+512):"memory");}
    asm volatile("s_waitcnt lgkmcnt(0)":::"memory");SBAR();
    #define PK(k) (bf16x8){lo[k][0],lo[k][1],lo[k][2],lo[k][3],hi[k][0],hi[k][1],hi[k][2],hi[k][3]}
    o[d0]=__builtin_amdgcn_mfma_f32_32x32x16_bf16(pa0,PK(0),o[d0],0,0,0);
    o[d0]=__builtin_amdgcn_mfma_f32_32x32x16_bf16(pa1,PK(1),o[d0],0,0,0);
    o[d0]=__builtin_amdgcn_mfma_f32_32x32x16_bf16(pa2,PK(2),o[d0],0,0,0);
    o[d0]=__builtin_amdgcn_mfma_f32_32x32x16_bf16(pa3,PK(3),o[d0],0,0,0);
    #undef PK
  }
}

#ifndef ATTN_STORE16
#define ATTN_STORE16(p,v) (*(u32x4*)(p)=(v))
#endif
typedef float f32x4_t __attribute__((ext_vector_type(4)));
template<int THRL> __device__ __forceinline__ void attn_unit(int b,int h,int qb,const bf16*Q,const bf16*__restrict__ K,const bf16*__restrict__ V,bf16*O,const float*NEGF,char*shm){
  int tid_=threadIdx.x; asm volatile("":"+v"(tid_)); const int tid=tid_,lane=tid&63,r32=lane&31,hi=lane>>5; const int wid=__builtin_amdgcn_readfirstlane(tid>>6);
  const long rowbase=(long)b*SEQ; const int q0=qb*QB;
  const bf16*Qw=Q+(rowbase+q0+wid*QBLK)*DM+h*D;
  const bf16*Kh=K+rowbase*DM+h*D,*Vh=V+rowbase*DM+h*D;
  const unsigned lds0=(unsigned)(uintptr_t)shm;
  float*wsf=(float*)(shm+LDS_WS)+wid*64;
  const bf16*ksrc=Kh+(long)lane*DM+wid*8;
  const bf16*vsrc=Vh+(long)(16*(wid&3)+(lane>>2))*DM+(wid>>2)*32+(lane&3)*8;
  const unsigned kdst=lds0+LDS_K+wid*1024, vdst=lds0+LDS_V+wid*1024;
  #define DMA_K(t,slot) glds16(ksrc+(long)(t)*KVBLK*DM,(unsigned)__builtin_amdgcn_readfirstlane(kdst+(slot)))
  #define DMA_V(t,slot) glds16(vsrc+(long)(t)*KVBLK*DM,(unsigned)__builtin_amdgcn_readfirstlane(vdst+(slot)))
  const int vb0=(int)(lds0+LDS_V)+((lane>>4)&1)*32+(lane&3)*8+(4*hi+((lane&15)>>2))*64;
  const char*Kbase=shm+LDS_K; bf16x8 kf[8];
  const lds_cptr shm3=(lds_cptr)shm; const lds_cptr kp0=shm3+LDS_K+hi*1024+r32*16; const lds_cptr vp0=shm3+LDS_V+((lane>>4)&1)*32+(lane&3)*8+(4*hi+((lane&15)>>2))*64;
  const int NT=(q0+QB)/KVBLK;
  { const f32x4_t bv_=*(const f32x4_t*)(NEGF+(long)(b*NHEAD+h)*SEQ+tid*4); *(__attribute__((address_space(3))) f32x4_t*)((__attribute__((address_space(3))) char*)shm+LDS_BIAS+tid*16)=bv_; }
  #define KBIAS(P0,P1,t) do{ const lds_cptr bq_=shm3+LDS_BIAS+((t)*64+4*hi)*4; \
    _Pragma("unroll") for(int j_=0;j_<4;++j_){ { const f32x4_t x0_=*(const __attribute__((address_space(3))) f32x4_t*)(bq_+32*j_); \
      P0[4*j_]+=x0_[0]-mhat;P0[4*j_+1]+=x0_[1]-mhat;P0[4*j_+2]+=x0_[2]-mhat;P0[4*j_+3]+=x0_[3]-mhat; } \
      { const f32x4_t x1_=*(const __attribute__((address_space(3))) f32x4_t*)(bq_+32*j_+128); \
      P1[4*j_]+=x1_[0]-mhat;P1[4*j_+1]+=x1_[1]-mhat;P1[4*j_+2]+=x1_[2]-mhat;P1[4*j_+3]+=x1_[3]-mhat; } } }while(0)
  DMA_K(0,0);DMA_V(0,0);DMA_K(1,SLOTB);
  bf16x8 qr[4];
  #pragma unroll
  for(int d0=0;d0<4;++d0)qr[d0]=*reinterpret_cast<const bf16x8*>(&Qw[(long)r32*DM+d0*16+hi*8]);
  float mhat=0.f,l_reg=0.f;f32x16 o[2];o[0]=f32x16{};o[1]=f32x16{};const f32x16 negm=f32x16{};
  const int qrel=wid*QBLK+r32;
  #define CMASK(P0,P1,t) do{int jb_=(t)-(NT-4); if(jb_>=0)cmask(P0,P1,jb_,qrel,hi);}while(0)
  bool resc=false;
  #define START(P0,P1) do{ const float rm=rowmax(P0,P1); resc=false; \
    { const float dl=rm; mhat=fadd_s(mhat,dl); \
      _Pragma("unroll") for(int r=0;r<16;++r){P0[r]=fsub_s(P0[r],dl);P1[r]=fsub_s(P1[r],dl);} \
       } \
    _Pragma("unroll") for(int r=0;r<16;++r)P0[r]=__builtin_amdgcn_exp2f(P0[r]); }while(0)
  #define RESC() do{ if(resc){ asm volatile("s_waitcnt lgkmcnt(0)":::"memory"); \
      _Pragma("unroll") for(int d_=0;d_<2;++d_) _Pragma("unroll") for(int r=0;r<16;++r)o[d_][r]*=wsf[crow(r,hi)]; } }while(0)
  f32x16 pA0,pA1,pB0,pB1;
  int sl_prev=0,sl_cur=0,sl_next=SLOTB;
  #define ROT() do{sl_prev=sl_cur;sl_cur=sl_next;sl_next=(sl_next==(NSLOT-1)*SLOTB)?0:sl_next+SLOTB;}while(0)
  DMA_K(2,2*SLOTB);
  WAIT_BAR(3);
  qkt(pA0,pA1,Kbase,qr,negm,r32,hi);asm volatile("s_nop 15\n\ts_nop 7":"+v"(pA0),"+v"(pA1));KBIAS(pA0,pA1,0);CMASK(pA0,pA1,0);
  START(pA0,pA1);
  _Pragma("unroll") for(int r=0;r<16;++r)pA1[r]=__builtin_amdgcn_exp2f(pA1[r]);
  WAIT_BAR(0);
  DMA_K(3,0);DMA_V(1,SLOTB);
  ROT();
  kload8(kf,kp0+sl_cur);
  WAIT_BAR(2);
  s16x4 vlo[8],vhi[8]; u32x4 pw0,pw1,pw2,pw3;
  #define PKW(P,B) cvtpk_s(P[B],P[B+1])
  #define PAF(k) __builtin_bit_cast(bf16x8,pw##k)
  #define VFR(i) (bf16x8){vlo[i][0],vlo[i][1],vlo[i][2],vlo[i][3],vhi[i][0],vhi[i][1],vhi[i][2],vhi[i][3]}
  #define PIN(x) asm volatile("":"+v"(x))
  #define MX3(a,b,c) __builtin_fmaxf(__builtin_fmaxf((a),(b)),(c))
  #define GAPA(MF,A0,A1,A2,A3,W0,W1,PW) do{ MF; sacc+=A0; sacc+=A1; sacc+=A2; sacc+=A3; PIN(sacc); W0; W1; PIN(PW); SBAR(); }while(0)
  #define EX(v) __builtin_amdgcn_exp2f(v)
  #define GAPB(MF,X,B) do{ MF; X[B]=EX(X[B]); X[B+1]=EX(X[B+1]); X[B+2]=EX(X[B+2]); X[B+3]=EX(X[B+3]); PIN(X); SBAR(); }while(0)
  #define VRD(i) do{ vlo[i]=vtr(vp_+(((i)>>2)*4096+((i)&3)*1024)); vhi[i]=vtr(vp_+(((i)>>2)*4096+((i)&3)*1024+512)); }while(0)
  #define KRD(G,j) do{ if(G){ kload2(kf,kp0+sl_next,j); SBAR(); } }while(0)
  #define STEP(C0,C1,P0,P1,t,GK,GV,GL) do{ SBAR(); \
    const lds_cptr vp_=vp0+sl_prev; \
    VRD(0); SBAR(); float sacc=(P0[0]+P0[1]); \
    GAPA(C0=__builtin_amdgcn_mfma_f32_32x32x16_bf16(kf[0],qr[0],negm,0,0,0), P0[2],P0[3],P0[4],P0[5],     pw0[0]=PKW(P0,0), pw0[1]=PKW(P0,2), pw0); \
    VRD(4); SBAR(); GAPA(C1=__builtin_amdgcn_mfma_f32_32x32x16_bf16(kf[1],qr[0],negm,0,0,0), P0[6],P0[7],P0[8],P0[9],     pw0[2]=PKW(P0,4), pw0[3]=PKW(P0,6), pw0); \
    VRD(1); SBAR(); GAPA(C0=__builtin_amdgcn_mfma_f32_32x32x16_bf16(kf[2],qr[1],C0,0,0,0),   P0[10],P0[11],P0[12],P0[13], pw1[0]=PKW(P0,8), pw1[1]=PKW(P0,10), pw1); \
    VRD(5); SBAR(); GAPA(C1=__builtin_amdgcn_mfma_f32_32x32x16_bf16(kf[3],qr[1],C1,0,0,0),   P0[14],P0[15],P1[0],P1[1],   pw1[2]=PKW(P0,12),pw1[3]=PKW(P0,14), pw1); \
    VRD(2); SBAR(); GAPA(C0=__builtin_amdgcn_mfma_f32_32x32x16_bf16(kf[4],qr[2],C0,0,0,0),   P1[2],P1[3],P1[4],P1[5],     pw2[0]=PKW(P1,0), pw2[1]=PKW(P1,2), pw2); \
    VRD(6); SBAR(); GAPA(C1=__builtin_amdgcn_mfma_f32_32x32x16_bf16(kf[5],qr[2],C1,0,0,0),   P1[6],P1[7],P1[8],P1[9],     pw2[2]=PKW(P1,4), pw2[3]=PKW(P1,6), pw2); \
    VRD(3); SBAR(); GAPA(C0=__builtin_amdgcn_mfma_f32_32x32x16_bf16(kf[6],qr[3],C0,0,0,0),   P1[10],P1[11],P1[12],P1[13], pw3[0]=PKW(P1,8), pw3[1]=PKW(P1,10), pw3); \
    VRD(7); SBAR(); GAPA(C1=__builtin_amdgcn_mfma_f32_32x32x16_bf16(kf[7],qr[3],C1,0,0,0),   P1[14],P1[15],0.f,0.f,       pw3[2]=PKW(P1,12),pw3[3]=PKW(P1,14), pw3); \
    l_reg+=sacc; \
    if(GK){DMA_K((t)+3,sl_cur);} if(GV){DMA_V((t)+1,sl_next);} \
    KBIAS(C0,C1,t); CMASK(C0,C1,t); \
    { float a=MX3(C0[0],C0[1],C1[0]),b=MX3(C0[2],C0[3],C1[1]); a=MX3(a,C1[2],C1[3]); \
      _Pragma("unroll") for(int r=4;r<16;r+=4){a=MX3(a,C0[r],C0[r+1]);b=MX3(b,C0[r+2],C0[r+3]);a=MX3(a,C1[r],C1[r+1]);b=MX3(b,C1[r+2],C1[r+3]);} \
      float rm=__builtin_fmaxf(a,b); { auto rr=__builtin_amdgcn_permlane32_swap(__float_as_uint(rm),__float_as_uint(rm),false,false); rm=__builtin_fmaxf(__uint_as_float(rr[0]),__uint_as_float(rr[1])); } \
      resc=false; \
      if(__builtin_expect(__any(rm>(float)THRL),0)){ const float dl=__builtin_fmaxf(rm,0.f); mhat+=dl; \
        _Pragma("unroll") for(int r=0;r<16;++r){C0[r]-=dl;C1[r]-=dl;} \
         \
        const float f=__builtin_amdgcn_exp2f(-dl); l_reg*=f; if(hi==0)wsf[r32]=f; resc=true; } } \
    SBAR(); \
    GAPB(o[0]=__builtin_amdgcn_mfma_f32_32x32x16_bf16(PAF(0),VFR(0),o[0],0,0,0), C0,0); \
    GAPB(o[1]=__builtin_amdgcn_mfma_f32_32x32x16_bf16(PAF(0),VFR(4),o[1],0,0,0), C0,4); \
    KRD(GL,0); GAPB(o[0]=__builtin_amdgcn_mfma_f32_32x32x16_bf16(PAF(1),VFR(1),o[0],0,0,0), C0,8); \
    KRD(GL,1); GAPB(o[1]=__builtin_amdgcn_mfma_f32_32x32x16_bf16(PAF(1),VFR(5),o[1],0,0,0), C0,12); \
    KRD(GL,2); GAPB(o[0]=__builtin_amdgcn_mfma_f32_32x32x16_bf16(PAF(2),VFR(2),o[0],0,0,0), C1,0); \
    KRD(GL,3); GAPB(o[1]=__builtin_amdgcn_mfma_f32_32x32x16_bf16(PAF(2),VFR(6),o[1],0,0,0), C1,4); \
    GAPB(o[0]=__builtin_amdgcn_mfma_f32_32x32x16_bf16(PAF(3),VFR(3),o[0],0,0,0), C1,8); \
    GAPB(o[1]=__builtin_amdgcn_mfma_f32_32x32x16_bf16(PAF(3),VFR(7),o[1],0,0,0), C1,12); \
    }while(0)
  int t=1;
  #undef CMASK
  #define CMASK(P0,P1,t) do{}while(0)
  for(;t+5<NT;t+=2){
    STEP(pB0,pB1,pA0,pA1,t,true,true,true);     WAIT_BAR(2); RESC(); ROT();
    STEP(pA0,pA1,pB0,pB1,t+1,true,true,true);   WAIT_BAR(2); RESC(); ROT();
  }
  #undef CMASK
  #define CMASK(P0,P1,t) do{int jb_=(t)-(NT-4); if(jb_>=0)cmask(P0,P1,jb_,qrel,hi);}while(0)
  #define ENDW(tt) do{ if((tt)+3<NT){WAIT_BAR(2);} else if((tt)+2<NT){WAIT_BAR(1);} else {WAIT_BAR(0);} }while(0)
  for(;t+1<NT;t+=2){
    STEP(pB0,pB1,pA0,pA1,t,(t+3<NT),(t+1<NT),(t+1<NT));       ENDW(t);   RESC(); ROT();
    STEP(pA0,pA1,pB0,pB1,t+1,(t+4<NT),(t+2<NT),(t+2<NT));     ENDW(t+1); RESC(); ROT();
  }
  STEP(pB0,pB1,pA0,pA1,NT-1,false,false,false); RESC();
  { float sacc=pB0[0]+pB0[1]; _Pragma("unroll") for(int r=2;r<16;++r)sacc+=pB0[r]; _Pragma("unroll") for(int r=0;r<16;++r)sacc+=pB1[r]; l_reg+=sacc;
    pw0=(u32x4){PKW(pB0,0),PKW(pB0,2),PKW(pB0,4),PKW(pB0,6)};pw1=(u32x4){PKW(pB0,8),PKW(pB0,10),PKW(pB0,12),PKW(pB0,14)};pw2=(u32x4){PKW(pB1,0),PKW(pB1,2),PKW(pB1,4),PKW(pB1,6)};pw3=(u32x4){PKW(pB1,8),PKW(pB1,10),PKW(pB1,12),PKW(pB1,14)};
    SBAR(); pv(o,vb0+sl_cur,PAF(0),PAF(1),PAF(2),PAF(3)); }
  #undef PKW
  #undef PAF
  #undef VFR
  #undef PIN
  #undef MX3
  #undef GAPA
  #undef GAPB
  #undef EX
  #undef VRD
  #undef KRD
  #undef STEP
  #undef ENDW
  {auto rr=__builtin_amdgcn_permlane32_swap(__float_as_uint(l_reg),__float_as_uint(l_reg),false,false);l_reg=__uint_as_float(rr[0])+__uint_as_float(rr[1]);}
  if(hi==0)wsf[32+r32]=l_reg;asm volatile("s_waitcnt lgkmcnt(0)":::"memory");
  float rli[16];
  #pragma unroll
  for(int r=0;r<16;++r)rli[r]=__builtin_amdgcn_rcpf(wsf[32+crow(r,hi)]);
  bf16*Ow=O+(rowbase+q0+wid*QBLK)*DM+h*D;
  { bf16*stg=(bf16*)(shm+LDS_OST)+wid*2048;
    #pragma unroll
    for(int r=0;r<16;++r){const int orow=crow(r,hi);
      #pragma unroll
      for(int d0=0;d0<2;++d0)stg[orow*64+d0*32+r32]=__float2bfloat16(o[d0][r]*rli[r]);}
    asm volatile("s_waitcnt lgkmcnt(0)":::"memory");
    #pragma unroll
    for(int i=0;i<4;++i){const int row=i*8+(lane>>3),ch=lane&7; const u32x4 v=*(const u32x4*)(stg+row*64+ch*8); ATTN_STORE16(Ow+(long)row*DM+ch*8,v);} }
  asm volatile("s_waitcnt lgkmcnt(0)\n\ts_barrier":::"memory");
  #undef KBIAS
  #undef DMA_K
  #undef DMA_V
  #undef CMASK
  #undef START
  #undef RESC
  #undef ROT
}
constexpr int ATTN_LDS_BYTES=LDS_BYTES;
struct AttnTensors { const bf16* Q; const bf16* K; const bf16* V; bf16* O; const float* NEGF; };
struct AttnUnit { int bh; int qb; };
struct StaticOrder {
  int c,G;
  __device__ __forceinline__ explicit StaticOrder(int grid,int block):c(block),G(grid){}
  __device__ __forceinline__ bool next(int i,AttnUnit&u)const{ const int bh=c+(i>>3)*G; if(bh>=BATCH*NHEAD)return false; u.bh=bh; u.qb=7-(i&7); return true; }
  __device__ __forceinline__ void a_ready(const AttnUnit&)const{}
  __device__ __forceinline__ void done(const AttnUnit&)const{}
};
template<class Sched,int THRL=8> __device__ __forceinline__ void attn_phase(char*lds,const AttnTensors&T,const Sched&S){
  AttnUnit u;
  for(int i=0;S.next(i,u);++i){ S.a_ready(u); attn_unit<THRL>(u.bh/NHEAD,u.bh%NHEAD,u.qb,T.Q,T.K,T.V,T.O,T.NEGF,lds); S.done(u); }
}
#undef SBAR
#undef WAIT_BAR
}
#define GAS __attribute__((address_space(1)))
#define LAS __attribute__((address_space(3)))
typedef unsigned short bf16;
typedef unsigned v4u __attribute__((ext_vector_type(4)));
typedef float f32x4 __attribute__((ext_vector_type(4)));
typedef short bf16x8 __attribute__((ext_vector_type(8)));
typedef GAS unsigned gu32;
typedef GAS unsigned long long gu64;
#define RLX_AGENT __ATOMIC_RELAXED, __HIP_MEMORY_SCOPE_AGENT
#define LDS_WAIT() asm volatile("s_waitcnt lgkmcnt(0)" ::: "memory")
#define VM_WAIT() asm volatile("s_waitcnt vmcnt(0)" ::: "memory")
__device__ __forceinline__ unsigned long long rt() { return __builtin_amdgcn_s_memrealtime(); }
__device__ __forceinline__ unsigned f2bf(float f) { unsigned u = __builtin_bit_cast(unsigned, f); return (u + 0x7fffu + ((u >> 16) & 1u)) >> 16; }
__device__ __forceinline__ unsigned pk2(float lo, float hi) { return f2bf(lo) | (f2bf(hi) << 16); }

#define XB_TMO      128
#define XB_XCNT(j)  (256  + 64 * (j))
#define XB_XSUB(j)  (1280 + 64 * (j))
#define XB_XGEN(j)  (2304 + 64 * (j))
#define XB_TOP      3328
#define XB_TOPGEN   3392
#define XCD_BAR_WORDS 3456
#define XB_SPIN_CAP (1u << 18)

__device__ __forceinline__ unsigned xb_ld(unsigned* p)              { return __hip_atomic_load(p, __ATOMIC_RELAXED, __HIP_MEMORY_SCOPE_AGENT); }
__device__ __forceinline__ unsigned xb_add(unsigned* p, unsigned v) { return __hip_atomic_fetch_add(p, v, __ATOMIC_RELAXED, __HIP_MEMORY_SCOPE_AGENT); }
__device__ __forceinline__ unsigned xb_xcc_id() { return (unsigned)__builtin_amdgcn_s_getreg((3 << 11) | 20) & 0xFu; }
#define XB_SPIN(cond, bar) do { unsigned _sp = 0; while (cond) { __builtin_amdgcn_s_sleep(1); \
    if ((++_sp & 255u) == 0u) { if (xb_ld(&(bar)[XB_TMO])) break; if (_sp > XB_SPIN_CAP) { atomicAdd(&(bar)[XB_TMO], 1u); break; } } } } while (0)

struct XcdBarrier {
    unsigned* bar; unsigned x;
    volatile LAS unsigned* st;
};

__device__ __forceinline__ XcdBarrier xcd_barrier_post(unsigned* bar, volatile LAS unsigned* st) {
    XcdBarrier b; b.bar = bar; b.x = xb_xcc_id(); b.st = st;
    if (threadIdx.x == 0) (void)xb_add(&bar[XB_XCNT(b.x)], 1u);
    return b;
}
__device__ __forceinline__ void xcd_barrier_complete(unsigned* bar, unsigned x, unsigned& nloc, unsigned& nx) {
    const unsigned G = gridDim.x * gridDim.y * gridDim.z;
    unsigned sum, cnt, mine, sp = 0u;
    for (;;) {
        sum = 0u; cnt = 0u; mine = 0u;
#pragma unroll
        for (unsigned j = 0; j < 16; ++j) { const unsigned c = xb_ld(&bar[XB_XCNT(j)]); sum += c; cnt += (c > 0u) ? 1u : 0u; mine = (j == x) ? c : mine; }
        if (sum == G) break;
        __builtin_amdgcn_s_sleep(1);
        if ((++sp & 255u) == 0u) { if (xb_ld(&bar[XB_TMO])) break; if (sp > XB_SPIN_CAP) { atomicAdd(&bar[XB_TMO], 1u); break; } }
    }
    nloc = mine > 0u ? mine : 1u; nx = cnt > 0u ? cnt : 1u;
}

__device__ __forceinline__ void xcd_barrier(const XcdBarrier& b) {
    asm volatile("s_waitcnt vmcnt(0)" ::: "memory");
    __syncthreads();
    if (threadIdx.x == 0) {
        unsigned* bar = b.bar;
        __builtin_amdgcn_s_waitcnt(0);
        unsigned nloc = b.st[0], nx = b.st[1];
        if (nloc == 0u) { xcd_barrier_complete(bar, b.x, nloc, nx); b.st[0] = nloc; b.st[1] = nx; }
        const unsigned old = xb_add(&bar[XB_XSUB(b.x)], 1u);
        const unsigned gen = old / nloc;
        if (old + 1u == (gen + 1u) * nloc) {
            __builtin_amdgcn_fence(__ATOMIC_RELEASE, "agent");
            asm volatile("s_waitcnt vmcnt(0)" ::: "memory");
            const unsigned og = xb_add(&bar[XB_TOP], 1u);
            const unsigned tg = og / nx;
            if (og + 1u == (tg + 1u) * nx) xb_add(&bar[XB_TOPGEN], 1u);
            else XB_SPIN(xb_ld(&bar[XB_TOPGEN]) == tg, bar);
            __builtin_amdgcn_fence(__ATOMIC_ACQUIRE, "agent");
            xb_add(&bar[XB_XGEN(b.x)], 1u);
            asm volatile("s_waitcnt vmcnt(0)" ::: "memory");
        } else {
            XB_SPIN(xb_ld(&bar[XB_XGEN(b.x)]) == gen, bar);
            __builtin_amdgcn_fence(__ATOMIC_ACQUIRE, "agent");
            asm volatile("s_waitcnt vmcnt(0)" ::: "memory");
        }
    }
    __syncthreads();
}
namespace cg = cooperative_groups;
constexpr int NWAVES = 8;
#ifndef MK_PER_PHASE
#define MK_PER_PHASE 0
#endif
#ifndef MK_USE_CG
#define MK_USE_CG 0
#endif
#ifndef MK_DUP_NG
#define MK_DUP_NG 1
#endif
#ifndef MK_DUP_G
#define MK_DUP_G 1
#endif
constexpr int BATCH = 16, T = 2048, D = 1024, FF = 4096, M = BATCH * T;
constexpr size_t MiB = 1u << 20;
constexpr size_t WS_CTL = 0, CTL_ZERO_BYTES = 32768  , WS_SSQA = 1 * MiB, WS_SSQB = 3 * MiB, WS_FLOG = 5 * MiB, WS_NEGF = 7 * MiB, WS_SV = 9 * MiB, WS_W = 10 * MiB,
                 WS_HB = 118 * MiB, WS_PB = 182 * MiB, WS_PP = 246 * MiB, WS_BIG = 310 * MiB, WS_END = 510 * MiB;
constexpr size_t ME = 1u << 20;
constexpr size_t W_S5IN = 0, W_S5GLU = 1 * ME, W_S5OUT = 3 * ME, W_S5STRIDE = 4 * ME, W_FOXIN = 8 * ME, W_FOXOUT = W_FOXIN + 3328 * 1024, W_GLAIN = W_FOXOUT + ME, W_GLAOUT = W_GLAIN + 3328 * 1024,
                 W_MLP1 = W_GLAOUT + ME, W_MLP2 = W_MLP1 + 4 * ME, W_MLPSTRIDE = 8 * ME, W_PLEG = W_MLP1 + 32 * ME, W_PLEP = W_PLEG + ME, W_PLESTRIDE = ME + ME / 4, W_TOTAL = W_PLEG + 4 * W_PLESTRIDE;
static_assert(W_TOTAL * 2 <= 108 * MiB, "weights region");
constexpr int CW_BAR = 4096;
constexpr int RING_OFF = 0, RING_BYTES = 131072, LDSCTL_OFF = RING_BYTES, MISC_OFF = LDSCTL_OFF + 320, LDS_BYTES = 147456;
constexpr float LOG2E = 1.4426950408889634f;
typedef unsigned u32x2g __attribute__((ext_vector_type(2)));

__device__ __forceinline__ float wave_sum(float v) {
#pragma unroll
    for (int o = 1; o < 64; o <<= 1) v += __shfl_xor(v, o);
    return v;
}
__device__ __forceinline__ float sigmoid_f(float x) { return 1.0f / (1.0f + __expf(-x)); }
__device__ __forceinline__ float log_sigmoid_f(float x) { return fminf(x, 0.f) - log1pf(__expf(-fabsf(x))); }
__device__ __forceinline__ float gelu_tanh_f(float x) { const float uu = 0.7978845608028654f * (x + 0.044715f * x * x * x); const float th = 1.0f - 2.0f / (__expf(2.0f * uu) + 1.0f); return 0.5f * x * (1.0f + th); }
typedef float f32x2c_ __attribute__((ext_vector_type(2))); typedef __bf16 bf16x2c_ __attribute__((ext_vector_type(2)));
__device__ __forceinline__ unsigned cvtpk_c(float lo, float hi) { const f32x2c_ v = {lo, hi}; return __builtin_bit_cast(unsigned, __builtin_convertvector(v, bf16x2c_)); }
__device__ __forceinline__ float bf_lo(unsigned w) { return __uint_as_float(w << 16); }
__device__ __forceinline__ float bf_hi(unsigned w) { return __uint_as_float(w & 0xffff0000u); }

__device__ __forceinline__ void transpose_item(const float* W, int K, int ldw, const float* gain, bf16* WT, int n0, int drow0, int k0, LAS float* scr, int lane) {
    f32x4 wv[8];
#pragma unroll
    for (int i = 0; i < 8; ++i) wv[i] = *(const GAS f32x4*)(W + (size_t)(k0 + 8 * i + (lane >> 3)) * ldw + n0 + (lane & 7) * 4);
#pragma unroll
    for (int i = 0; i < 8; ++i) { const int kk = 8 * i + (lane >> 3); const float gk = gain ? gain[k0 + kk] : 1.0f; LAS float* d = scr + kk * 33 + (lane & 7) * 4;
        d[0] = wv[i][0] * gk; d[1] = wv[i][1] * gk; d[2] = wv[i][2] * gk; d[3] = wv[i][3] * gk; }
    LDS_WAIT(); asm volatile("" ::: "memory");
    const int c = lane & 7;
#pragma unroll
    for (int j = 0; j < 4; ++j) { const int n = (lane >> 3) + 8 * j; const LAS float* s = scr + (8 * c) * 33 + n;
        v4u o; o.x = pk2(s[0 * 33], s[1 * 33]); o.y = pk2(s[2 * 33], s[3 * 33]); o.z = pk2(s[4 * 33], s[5 * 33]); o.w = pk2(s[6 * 33], s[7 * 33]);
        *(GAS v4u*)(WT + (size_t)(drow0 + n) * K + k0 + 8 * c) = o; }
    LDS_WAIT(); asm volatile("" ::: "memory");
}

__device__ __forceinline__ const float* ld_ptr(LAS unsigned long long* t, int i) { const unsigned long long v = t[i];
    const unsigned lo = __builtin_amdgcn_readfirstlane((unsigned)v), hi = __builtin_amdgcn_readfirstlane((unsigned)(v >> 32)); return (const float*)(const GAS float*)(((unsigned long long)hi << 32) | lo); }

__device__ __forceinline__ float reduce16(float (&v)[16], int lane) {
    { const bool hb5 = (lane & 32) != 0;
#pragma unroll
      for (int i = 0; i < 8; ++i) { const float snd = hb5 ? v[i] : v[i + 8], kp = hb5 ? v[i + 8] : v[i]; v[i] = kp + __shfl_xor(snd, 32); } }
    { const bool hb4 = (lane & 16) != 0;
#pragma unroll
      for (int i = 0; i < 4; ++i) { const float snd = hb4 ? v[i] : v[i + 4], kp = hb4 ? v[i + 4] : v[i]; v[i] = kp + __shfl_xor(snd, 16); } }
    { const bool hb3 = (lane & 8) != 0;
#pragma unroll
      for (int i = 0; i < 2; ++i) { const float snd = hb3 ? v[i] : v[i + 2], kp = hb3 ? v[i + 2] : v[i]; v[i] = kp + __shfl_xor(snd, 8); } }
    { const bool hb2 = (lane & 4) != 0; const float snd = hb2 ? v[0] : v[1], kp = hb2 ? v[1] : v[0]; v[0] = kp + __shfl_xor(snd, 4); }
    float tot = v[0]; tot += __shfl_xor(tot, 2); tot += __shfl_xor(tot, 1); return tot;
}
__device__ __forceinline__ void sv_pass(float (&acc)[16], LAS float* inT, const float* in, size_t in_stride, int K, const float* gain, const float* W, int ldw, int col, int tk, int KG, int lane, int wave) {
    for (int k0 = 0; k0 < K; k0 += 1024) {
        const int kc = (K - k0) < 1024 ? (K - k0) : 1024;
        __syncthreads();
        for (int rr = 0; rr < 2; ++rr) { const int r = 2 * wave + rr; const float* src = in + (size_t)r * in_stride + k0;
            f32x4 v[4]; float ss = 0.f;
#pragma unroll
            for (int i = 0; i < 4; ++i) { const int k4 = lane + 64 * i; v[i] = (f32x4){0.f, 0.f, 0.f, 0.f}; if (4 * k4 < kc) v[i] = *(const GAS f32x4*)(src + 4 * k4); ss += (v[i][0] * v[i][0] + v[i][1] * v[i][1]) + (v[i][2] * v[i][2] + v[i][3] * v[i][3]); }
            float sc = 1.f; if (gain) { ss = wave_sum(ss); sc = rsqrtf(ss * (1.0f / 1024.0f) + 1e-6f); }
#pragma unroll
            for (int i = 0; i < 4; ++i) { const int k4 = lane + 64 * i; if (4 * k4 < kc) { f32x4 g = (f32x4){1.f, 1.f, 1.f, 1.f}; if (gain) g = *(const GAS f32x4*)(gain + k0 + 4 * k4);
#pragma unroll
                for (int e = 0; e < 4; ++e) inT[(4 * k4 + e) * 16 + r] = v[i][e] * sc * g[e]; } } }
        __syncthreads();
#pragma unroll 4
        for (int k = tk; k < kc; k += KG) { const float w = W[(size_t)(k0 + k) * ldw + col]; const LAS f32x4* ip = (const LAS f32x4*)(inT + k * 16); const f32x4 a0 = ip[0], a1 = ip[1], a2 = ip[2], a3 = ip[3];
            acc[0] += w * a0[0]; acc[1] += w * a0[1]; acc[2] += w * a0[2]; acc[3] += w * a0[3]; acc[4] += w * a1[0]; acc[5] += w * a1[1]; acc[6] += w * a1[2]; acc[7] += w * a1[3];
            acc[8] += w * a2[0]; acc[9] += w * a2[1]; acc[10] += w * a2[2]; acc[11] += w * a2[3]; acc[12] += w * a3[0]; acc[13] += w * a3[1]; acc[14] += w * a3[2]; acc[15] += w * a3[3]; }
    }
}
__device__ __forceinline__ void sv_stage(LAS unsigned char* ldsl, int mode, int N, const float* in0, size_t st0, int K0, const float* gain0, const float* W0, int ldw0, int c00,
                                         const float* in1, size_t st1, int K1, const float* W1, int ldw1, int c01, const float* res, size_t rst, float* out, int ost, int tid, int lane, int wave, int G) {
    const int cw = N / 256, KG = 512 / cw, tc = tid % cw, tk = tid / cw;
    LAS float* inT = (LAS float*)ldsl; LAS float* red0 = inT + 16384; LAS float* red1 = inT + 24576;
    for (int cb = blockIdx.x; cb < 256; cb += G) { const int n0 = ((G == 256) ? ((cb & 7) << 5) + (cb >> 3) : cb) * cw;
        float a0[16], a1[16];
#pragma unroll
        for (int r = 0; r < 16; ++r) { a0[r] = 0.f; a1[r] = 0.f; }
        sv_pass(a0, inT, in0, st0, K0, gain0, W0, ldw0, c00 + n0 + tc, tk, KG, lane, wave);
        if (K1 > 0) sv_pass(a1, inT, in1, st1, K1, nullptr, W1, ldw1, c01 + n0 + tc, tk, KG, lane, wave);
        __syncthreads();
#pragma unroll
        for (int r = 0; r < 16; ++r) { red0[tid * 16 + r] = a0[r]; red1[tid * 16 + r] = a1[r]; }
        __syncthreads();
        if (tid < 16 * cw) { const int r = tid / cw, c = tid % cw; float s0 = 0.f, s1 = 0.f;
            for (int g = 0; g < KG; ++g) { s0 += red0[(g * cw + c) * 16 + r]; s1 += red1[(g * cw + c) * 16 + r]; }
            const int n = n0 + c; float o;
            if (mode == 0) o = s0; else if (mode == 1) o = res[(size_t)r * rst + n] + s0; else if (mode == 2) { const float t = fmaxf(s0, 0.f); o = t * t; }
            else if (mode == 3) o = s0 * sigmoid_f(s1); else o = res[(size_t)r * rst + n] + s1 * sigmoid_f(s0);
            out[(size_t)r * ost + n] = o; }
    }
    __syncthreads();
}
struct Args { const float* in[29]; float* out; unsigned char* ws; int ph_lo, ph_hi; };
constexpr int N_PHASES = 38;
enum { T_PROLOGUE = 0, T_INPROJ, T_MIX1, T_MIX2, T_OUTPROJ, T_UP0, T_DOWN0, T_UP1, T_DOWN1, T_PLE, T_FINAL };

__global__ void __launch_bounds__(NWAVES * 64, 2) trunk_fwd(Args args) {
    extern __shared__ __attribute__((aligned(16))) unsigned char lds[];
    LAS unsigned char* const ldsl = (LAS unsigned char*)lds;
    volatile LAS unsigned* MISC = (volatile LAS unsigned*)(ldsl + MISC_OFF);
    const int tid0 = threadIdx.x;
#define tid tid0
    for (int u = tid; u < (LDS_BYTES - LDSCTL_OFF) / 4; u += NWAVES * 64) ((LAS unsigned*)(ldsl + LDSCTL_OFF))[u] = 0u;
    __syncthreads();
    LAS unsigned long long* const ptab = (LAS unsigned long long*)(ldsl + LDSCTL_OFF + 64);
    if (tid == 0) {
#define PT_(i) ptab[i] = (unsigned long long)args.in[i];
        PT_(0) PT_(1) PT_(2) PT_(3) PT_(4) PT_(5) PT_(6) PT_(7) PT_(8) PT_(9) PT_(10) PT_(11) PT_(12) PT_(13) PT_(14) PT_(15) PT_(16) PT_(17) PT_(18) PT_(19) PT_(20) PT_(21) PT_(22) PT_(23) PT_(24) PT_(25) PT_(26) PT_(27) PT_(28)
        ptab[29] = (unsigned long long)args.ws; ptab[30] = (unsigned long long)args.out;
#undef PT_
    }
    __syncthreads();
#define INP(i) ld_ptr(ptab, (i))
#define ws ((unsigned char*)ld_ptr(ptab, 29))
#define h ((float*)ld_ptr(ptab, 30))
#define Wb ((bf16*)(ws + WS_W))
#define HB ((bf16*)(ws + WS_HB))
#define PB ((bf16*)(ws + WS_PB))
#define PP ((bf16*)(ws + WS_PP))
#define BIG ((bf16*)(ws + WS_BIG))
#define FLOG ((float*)(ws + WS_FLOG))
#define NEGF ((float*)(ws + WS_NEGF))
#if !MK_PER_PHASE
    cg::grid_group grid = cg::this_grid();
#if !MK_USE_CG
    XcdBarrier bar = xcd_barrier_post((unsigned*)(ws + WS_CTL) + CW_BAR, MISC + 8);
#endif
#endif
    (void)MISC;

#undef tid
    for (int ph = args.ph_lo; ph < args.ph_hi; ++ph) {
        int tid = tid0; asm volatile("" : "+v"(tid));
        const int lane = tid & 63, wave = __builtin_amdgcn_readfirstlane(tid >> 6);
        const int G = gridDim.x, gw = blockIdx.x * NWAVES + wave, NGW = G * NWAVES, gtid = blockIdx.x * (NWAVES * 64) + tid, NT = G * NWAVES * 64;
        int type, layer = 0;
        if (ph == 0) type = T_PROLOGUE; else if (ph >= 37) type = T_FINAL; else { layer = (ph - 1) / 9; type = T_INPROJ + (ph - 1) % 9; }
        const int mixer = layer % 3, jm = layer / 3;
#define SSQ_(k) ((float*)(ws + (((3 * layer + (k)) & 1) ? WS_SSQB : WS_SSQA)))
#define ssq0 SSQ_(0)
#define ssq1 SSQ_(1)
#define ssq2 SSQ_(2)
#define ssq3 SSQ_(3)


        for (int rep_ = 0; rep_ < (((type == T_MIX2 && mixer == 1) || type == T_FINAL) ? 1 : MK_DUP_NG); ++rep_) {
        if (rep_) __syncthreads();
        int tid_o = tid; asm volatile("" : "+v"(tid_o));
        { const int tid = tid_o, lane = tid & 63, wave = __builtin_amdgcn_readfirstlane(tid >> 6), gw = blockIdx.x * NWAVES + wave, gtid = blockIdx.x * (NWAVES * 64) + tid; (void)gtid; (void)gw; (void)lane;
        { const int sk = ph - 1;
          if (sk >= 0 && sk < 13) {
            float* const SVH0 = (float*)(ws + WS_SV); float* const SVH1 = SVH0 + 16384; float* const SVA = SVH0 + 32768; float* const SVB = SVH0 + 98304;
            const size_t XS = (size_t)T * D, PS = (size_t)T * 256;
            if (sk == 0) sv_stage(ldsl, 0, 1024, INP(0), XS, 1024, INP(2), INP(5), 1024, 0, nullptr, 0, 0, nullptr, 0, 0, nullptr, 0, SVA, 1024, tid, lane, wave, G);
            else if (sk == 1) {
                for (int item = gw; item < 1024; item += NGW) { const int b = item >> 6, g = item & 63, n = lane; const size_t gn = (size_t)g * 64 + n;
                    const float dt = expf(INP(8)[g]), lr = INP(6)[gn], li = INP(7)[gn];
                    const float mag = expf(lr * dt), are = mag * cosf(li * dt), aim = mag * sinf(li * dt), den = lr * lr + li * li, nr = are - 1.0f;
                    const float cre = (nr * lr + aim * li) / den, cim = (aim * lr - nr * li) / den;
                    float xre = 0.f, xim = 0.f; const float* uu = SVA + b * 1024 + g * 16;
#pragma unroll
                    for (int c = 0; c < 16; ++c) { const float br = INP(9)[gn * 16 + c], bi = INP(10)[gn * 16 + c]; xre += (cre * br - cim * bi) * uu[c]; xim += (cre * bi + cim * br) * uu[c]; }
                    float v[16];
#pragma unroll
                    for (int c = 0; c < 16; ++c) { const size_t ci = (size_t)g * 1024 + c * 64 + n; v[c] = INP(11)[ci] * xre - INP(12)[ci] * xim; }
                    const float tot = reduce16(v, lane);
                    const int ch = ((lane >> 5) & 1) * 8 + ((lane >> 4) & 1) * 4 + ((lane >> 3) & 1) * 2 + ((lane >> 2) & 1);
                    if ((lane & 3) == 0) SVB[b * 1024 + g * 16 + ch] = gelu_tanh_f(tot + INP(13)[g * 16 + ch] * uu[ch]); } }
            else if (sk == 2) sv_stage(ldsl, 3, 1024, SVB, 1024, 1024, nullptr, INP(14), 2048, 0, SVB, 1024, 1024, INP(14), 2048, 1024, nullptr, 0, SVA, 1024, tid, lane, wave, G);
            else if (sk == 3) sv_stage(ldsl, 1, 1024, SVA, 1024, 1024, nullptr, INP(15), 1024, 0, nullptr, 0, 0, nullptr, 0, 0, INP(0), XS, SVH1, 1024, tid, lane, wave, G);
            else if (sk == 4 || sk == 9) { const int L = (sk == 9); sv_stage(ldsl, 2, 4096, L ? SVH0 : SVH1, 1024, 1024, INP(3) + L * 1024, INP(24) + (size_t)L * 4 * ME, 4096, 0, nullptr, 0, 0, nullptr, 0, 0, nullptr, 0, SVA, 4096, tid, lane, wave, G); }
            else if (sk == 5 || sk == 10) { const int L = (sk == 10); sv_stage(ldsl, 1, 1024, SVA, 4096, 4096, nullptr, INP(25) + (size_t)L * 4 * ME, 1024, 0, nullptr, 0, 0, nullptr, 0, 0, L ? SVH0 : SVH1, 1024, L ? SVH1 : SVH0, 1024, tid, lane, wave, G); }
            else if (sk == 6 || sk == 11) { const int L = (sk == 11); const float* hin = L ? SVH1 : SVH0;
                sv_stage(ldsl, 4, 1024, hin, 1024, 1024, INP(4) + L * 1024, INP(27) + (size_t)L * ME, 1024, 0, INP(1) + (size_t)L * M * 256, PS, 256, INP(26) + (size_t)L * (ME / 4), 1024, 0, hin, 1024, L ? SVH0 : SVH1, 1024, tid, lane, wave, G); }
            else if (sk == 7) sv_stage(ldsl, 0, 1024, SVH1, 1024, 1024, INP(2) + 1024, INP(16), 3088, 2048, nullptr, 0, 0, nullptr, 0, 0, nullptr, 0, SVA, 1024, tid, lane, wave, G);
            else if (sk == 8) sv_stage(ldsl, 1, 1024, SVA, 1024, 1024, nullptr, INP(18), 1024, 0, nullptr, 0, 0, nullptr, 0, 0, SVH1, 1024, SVH0, 1024, tid, lane, wave, G);
            else if (sk == 12) sv_stage(ldsl, 0, 1024, SVH0, 1024, 1024, INP(2) + 2 * 1024, INP(19), 3088, 0, nullptr, 0, 0, nullptr, 0, 0, nullptr, 0, SVA, 1024, tid, lane, wave, G);
          } }
        if (type == T_PROLOGUE) {
            LAS float* scr = (LAS float*)(ldsl + RING_OFF + wave * 16384);
            for (int gi = gw; gi < 27136 + 512; gi += NGW) {
                int mi, it;
                if (gi < 4096) { const int j = gi >> 11, r = gi & 2047; const int w = (r < 512) ? 0 : (r < 1536) ? 1 : 2; mi = 3 * j + w; it = r - ((w == 0) ? 0 : (w == 1) ? 512 : 1536); }
                else if (gi < 8192) { const int r = gi - 4096; if (r < 1536) { mi = 6; it = r; } else if (r < 2048) { mi = 7; it = r - 1536; } else if (r < 3584) { mi = 8; it = r - 2048; } else { mi = 9; it = r - 3584; } }
                else if (gi < 16384) { mi = 10 + ((gi - 8192) >> 11); it = (gi - 8192) & 2047; }
                else if (gi < 24576) { mi = 14 + ((gi - 16384) >> 11); it = (gi - 16384) & 2047; }
                else if (gi < 26624) { mi = 18 + ((gi - 24576) >> 9); it = (gi - 24576) & 511; }
                else if (gi < 27136) { mi = 22 + ((gi - 26624) >> 7); it = (gi - 26624) & 127; }
                else { mi = (gi - 27136 < 256) ? 6 : 8; it = -1 - ((gi - 27136) & 255); }
                const float* src; int K = 1024, ldw = 1024, ncols = 1024, glu = 0; const float* gain = nullptr; bf16* dst;
                if (mi < 6) { const int j = mi / 3, w = mi % 3;
                    if (w == 0) { src = INP(5) + (size_t)j * ME; gain = INP(2) + (size_t)(3 * j) * 1024; dst = Wb + W_S5IN + j * W_S5STRIDE; }
                    else if (w == 1) { src = INP(14) + (size_t)j * 2 * ME; ldw = 2048; ncols = 2048; glu = 1; dst = Wb + W_S5GLU + j * W_S5STRIDE; }
                    else { src = INP(15) + (size_t)j * ME; dst = Wb + W_S5OUT + j * W_S5STRIDE; } }
                else if (mi == 6) { src = INP(16); ldw = 3088; ncols = 3072; gain = INP(2) + 1 * 1024; dst = Wb + W_FOXIN; }
                else if (mi == 7) { src = INP(18); dst = Wb + W_FOXOUT; }
                else if (mi == 8) { src = INP(19); ldw = 3088; ncols = 3072; gain = INP(2) + 2 * 1024; dst = Wb + W_GLAIN; }
                else if (mi == 9) { src = INP(23); dst = Wb + W_GLAOUT; }
                else if (mi < 14) { const int i = mi - 10; src = INP(24) + (size_t)i * 4 * ME; ldw = 4096; ncols = 4096; gain = INP(3) + (size_t)i * 1024; dst = Wb + W_MLP1 + i * W_MLPSTRIDE; }
                else if (mi < 18) { const int i = mi - 14; src = INP(25) + (size_t)i * 4 * ME; K = 4096; dst = Wb + W_MLP2 + i * W_MLPSTRIDE; }
                else if (mi < 22) { const int i = mi - 18; src = INP(27) + (size_t)i * ME; gain = INP(4) + (size_t)i * 1024; dst = Wb + W_PLEG + i * W_PLESTRIDE; }
                else { const int i = mi - 22; src = INP(26) + (size_t)i * (ME / 4); K = 256; dst = Wb + W_PLEP + i * W_PLESTRIDE; }
                const int nblk = ncols / 32;
                if (it >= 0) { const int kb = it / nblk, nb = it % nblk, n0 = 32 * nb; int drow0 = n0;
                    if (glu) { const int c = n0 & 1023; drow0 = 256 * (c >> 7) + (c & 127) + ((n0 >= 1024) ? 128 : 0); }
                    transpose_item(src, K, ldw, gain, dst, n0, drow0, 64 * kb, scr, lane); }
                else { const int n = 3072 + (-1 - it);
#pragma unroll 4
                    for (int k = lane; k < 1024; k += 64) { const float v = (n < 3088) ? src[(size_t)k * 3088 + n] * gain[k] : 0.f; dst[(size_t)n * 1024 + k] = (bf16)f2bf(v); } }
            }
            float* ssqA = (float*)(ws + WS_SSQA);
            for (int m = gw; m < M; m += NGW) {
                const GAS f32x4* xr = (const GAS f32x4*)(INP(0) + (size_t)m * D) + lane; f32x4 v[4]; float s = 0.f;
#pragma unroll
                for (int j = 0; j < 4; ++j) { v[j] = xr[64 * j]; s += (v[j].x * v[j].x + v[j].y * v[j].y) + (v[j].z * v[j].z + v[j].w * v[j].w); }
                s = wave_sum(s);
                GAS unsigned long long* o8 = (GAS unsigned long long*)(PB + (size_t)m * D) + lane;
#pragma unroll
                for (int j = 0; j < 4; ++j) o8[64 * j] = (unsigned long long)pk2(v[j].x, v[j].y) | ((unsigned long long)pk2(v[j].z, v[j].w) << 32);
                if (lane < 16) ssqA[(size_t)m * 16 + lane] = (lane == 0) ? s : 0.f;
            }
        }
        else if (type == T_MIX1 && mixer == 0) {
            {
                const int q = wave & 3; const bool helper = wave >= 4;
                LAS float* xs = (LAS float*)(ldsl + q * 25664);
                LAS unsigned short* ssb = (LAS unsigned short*)(ldsl + q * 25664 + 16896);
                volatile LAS unsigned* fl = (volatile LAS unsigned*)(ldsl + q * 25664 + 25600);
                const bf16* U = BIG; bf16* Y = BIG + (size_t)32 * ME;
                const int fr = lane & 15, fq = lane >> 4;
                typedef float f32x2s __attribute__((ext_vector_type(2)));
#define S5_WAIT(idx, target) { while ((int)fl[idx] < (int)(target)) __builtin_amdgcn_s_sleep(1); asm volatile("" ::: "memory"); }
#define S5_POST(idx, val) { asm volatile("s_waitcnt lgkmcnt(0)" ::: "memory"); if (lane == 0) fl[idx] = (unsigned)(val); }
                for (int pair = blockIdx.x * 4 + q; pair < 1024; pair += G * 4) {
                    const int b = pair >> 6, g = pair & 63;
                    __syncthreads();
                    if (!helper && lane == 0) { fl[0] = 0u; fl[1] = 0u; fl[2] = 0u; }
                    __syncthreads();
                    const float dt = expf(INP(8)[jm * 64 + g]);
                    if (!helper) {
                        float are, aim;
                        { const size_t gn = (size_t)jm * 4096 + g * 64 + lane; const float lr = INP(6)[gn], li = INP(7)[gn], mag = expf(lr * dt); are = mag * cosf(li * dt); aim = mag * sinf(li * dt); }
                        float sre = 0.f, sim = 0.f;
#pragma unroll 1
                        for (int blk = 0; blk < 128; ++blk) {
                            S5_WAIT(0, blk + 1) S5_WAIT(2, blk - 1)
                            const LAS float* xrd = xs + (blk & 1) * 2112; LAS unsigned* sw = (LAS unsigned*)(ssb + (blk & 1) * 2176);
                            f32x2s xv[16];
#pragma unroll
                            for (int s = 0; s < 16; ++s) xv[s] = *(const LAS f32x2s*)(xrd + s * 132 + 2 * lane);
#pragma unroll
                            for (int s = 0; s < 16; ++s) { const float nre = are * sre - aim * sim + xv[s].x, nim = are * sim + aim * sre + xv[s].y; sre = nre; sim = nim;
                                sw[s * 68 + lane] = cvtpk_c(sre, sim); }
                            S5_POST(1, blk + 1)
                        }
                    } else {
                        bf16x8 bfr[8];
#pragma unroll
                    for (int j = 0; j < 8; ++j) {
                        const size_t gn = (size_t)jm * 4096 + g * 64 + 8 * j + (fr >> 1); const float lr = INP(6)[gn], li = INP(7)[gn];
                        const float mag = expf(lr * dt), ar = mag * cosf(li * dt), ai = mag * sinf(li * dt), den = lr * lr + li * li, nr = ar - 1.0f;
                        const float cre = (nr * lr + ai * li) / den, cim = (ai * lr - nr * li) / den;
                        const float ca = (fr & 1) ? cim : cre, cb = (fr & 1) ? cre : -cim;
                        unsigned w4[4] = {0u, 0u, 0u, 0u};
                        if (fq < 2) { const f32x4 b0 = *(const GAS f32x4*)(INP(9) + gn * 16 + 8 * fq), b1 = *(const GAS f32x4*)(INP(9) + gn * 16 + 8 * fq + 4), i0 = *(const GAS f32x4*)(INP(10) + gn * 16 + 8 * fq), i1 = *(const GAS f32x4*)(INP(10) + gn * 16 + 8 * fq + 4);
                            w4[0] = pk2(ca * b0[0] + cb * i0[0], ca * b0[1] + cb * i0[1]); w4[1] = pk2(ca * b0[2] + cb * i0[2], ca * b0[3] + cb * i0[3]);
                            w4[2] = pk2(ca * b1[0] + cb * i1[0], ca * b1[1] + cb * i1[1]); w4[3] = pk2(ca * b1[2] + cb * i1[2], ca * b1[3] + cb * i1[3]); }
                        bfr[j] = __builtin_bit_cast(bf16x8, (v4u){w4[0], w4[1], w4[2], w4[3]}); }
                    bf16x8 cfr[4];
#pragma unroll
                    for (int kk = 0; kk < 4; ++kk) { const size_t cb = ((size_t)jm * 64 + g) * 1024 + fr * 64 + 16 * kk + 4 * fq;
                        const f32x4 c0 = *(const GAS f32x4*)(INP(11) + cb), c1 = *(const GAS f32x4*)(INP(12) + cb);
                        cfr[kk] = __builtin_bit_cast(bf16x8, (v4u){pk2(c0[0], -c1[0]), pk2(c0[1], -c1[1]), pk2(c0[2], -c1[2]), pk2(c0[3], -c1[3])}); }
                    bf16x8 dfr;
                    { const float dv = INP(13)[jm * 1024 + g * 16 + fr]; unsigned dw[4] = {0u, 0u, 0u, 0u};
                      if (fq < 2 && (fr >> 3) == fq) { const int e = fr & 7; dw[e >> 1] = (e & 1) ? (f2bf(dv) << 16) : f2bf(dv); }
                      dfr = __builtin_bit_cast(bf16x8, (v4u){dw[0], dw[1], dw[2], dw[3]}); }

                        const bf16* up = U + (size_t)(b * T) * D + g * 16 + 8 * fq;
                        v4u ur0 = (v4u){0u, 0u, 0u, 0u}, ur1 = ur0, ur2 = ur0, ur3 = ur0;
                        if (fq < 2) { ur0 = *(const GAS v4u*)(up + (size_t)fr * D); ur1 = *(const GAS v4u*)(up + (size_t)(16 + fr) * D); ur2 = *(const GAS v4u*)(up + (size_t)(32 + fr) * D); ur3 = *(const GAS v4u*)(up + (size_t)(48 + fr) * D); }
                        bf16x8 u0 = __builtin_bit_cast(bf16x8, (v4u){0u, 0u, 0u, 0u}), u1 = u0;
#define S5_HSTEP(J, UR) { const int blk = i4 + (J); u1 = u0; u0 = __builtin_bit_cast(bf16x8, UR); \
                            if (blk + 4 < 128 && fq < 2) UR = *(const GAS v4u*)(up + (size_t)((blk + 4) * 16 + fr) * D); \
                            if (blk < 128) { S5_WAIT(1, blk - 1) LAS float* xw = xs + (blk & 1) * 2112; \
_Pragma("unroll") \
                                for (int nt = 0; nt < 8; ++nt) { const f32x4 xd = __builtin_amdgcn_mfma_f32_16x16x32_bf16(bfr[nt], u0, (f32x4){0.f, 0.f, 0.f, 0.f}, 0, 0, 0); \
                                    *(LAS f32x4*)(xw + fr * 132 + 16 * nt + 4 * fq) = xd; } \
                                S5_POST(0, blk + 1) } \
                            if (blk >= 1 && blk <= 128) { S5_WAIT(1, blk) const LAS unsigned short* srd = ssb + ((blk - 1) & 1) * 2176; bf16x8 af[4]; \
_Pragma("unroll") \
                                for (int kk = 0; kk < 4; ++kk) af[kk] = *(const LAS bf16x8*)(srd + fr * 136 + 32 * kk + 8 * fq); \
                                S5_POST(2, blk) \
                                f32x4 ya = (f32x4){0.f, 0.f, 0.f, 0.f}; \
_Pragma("unroll") \
                                for (int kk = 0; kk < 4; ++kk) ya = __builtin_amdgcn_mfma_f32_16x16x32_bf16(cfr[kk], af[kk], ya, 0, 0, 0); \
                                ya = __builtin_amdgcn_mfma_f32_16x16x32_bf16(dfr, u1, ya, 0, 0, 0); \
                                float go[4]; \
_Pragma("unroll") \
                                for (int e = 0; e < 4; ++e) { const float yv = ya[e], uu2 = -2.0f * LOG2E * 0.7978845608028654f * (yv + 0.044715f * yv * yv * yv); go[e] = yv * __builtin_amdgcn_rcpf(1.0f + __builtin_amdgcn_exp2f(uu2)); } \
                                { u32x2g w; w.x = cvtpk_c(go[0], go[1]); w.y = cvtpk_c(go[2], go[3]); *(GAS u32x2g*)(Y + (size_t)(b * T + (blk - 1) * 16 + fr) * D + g * 16 + 4 * fq) = w; } } }
#pragma unroll 1
                        for (int i4 = 0; i4 < 132; i4 += 4) { S5_HSTEP(0, ur0) S5_HSTEP(1, ur1) S5_HSTEP(2, ur2) S5_HSTEP(3, ur3) }
#undef S5_HSTEP
                    }
                }
#undef S5_WAIT
#undef S5_POST
            }
        }
        else if (type == T_MIX1 && mixer == 1) {
            if (wave == 0) {
                for (int pair = blockIdx.x; pair < 256; pair += G) { const int b = pair >> 4, hh = pair & 15; const float bf = INP(17)[jm * 16 + hh];
                    float c[32]; float run = 0.f;
#pragma unroll
                    for (int i = 0; i < 32; ++i) { const float x = FLOG[(size_t)(b * T + 32 * lane + i) * 16 + hh] + bf; run += log_sigmoid_f(x); c[i] = run; }
                    float incl = run;
#pragma unroll
                    for (int o = 1; o < 64; o <<= 1) { const float nb = __shfl_up(incl, o); if (lane >= o) incl += nb; }
                    const float excl = incl - run;
#pragma unroll
                    for (int i = 0; i < 32; ++i) NEGF[(size_t)pair * T + 32 * lane + i] = -(c[i] + excl) * LOG2E;
                }
            }
        }
        else if (type == T_MIX2 && mixer == 1) {
            const attn_body::AttnTensors AT{(const attn_body::bf16*)BIG, (const attn_body::bf16*)(BIG + 32 * ME), (const attn_body::bf16*)(BIG + 64 * ME), (attn_body::bf16*)BIG, NEGF};
            const attn_body::StaticOrder S((int)G, (int)blockIdx.x);
            attn_body::attn_phase<attn_body::StaticOrder>((char*)lds + RING_OFF, AT, S);
        }
        else if (type == T_MIX1 && mixer == 2) {
            constexpr int PQD = 136, PSS = 72;
            LAS unsigned short* QD = (LAS unsigned short*)ldsl; LAS unsigned short* KI = QD + 64 * PQD; LAS unsigned short* KUT = KI + 64 * PQD; LAS unsigned short* VT = KUT + 128 * PSS;
            LAS unsigned short* ST = VT + 64 * PSS; LAS unsigned short* ATT = ST + 64 * PQD; LAS float* EB = (LAS float*)(ATT + 64 * PSS); LAS float* PS = EB + 128; LAS float* pq = PS + 512; LAS float* GLs = pq + 256;
            const bf16* QKV = BIG; bf16* OB = PP;
            const int fr = lane & 15, fq = lane >> 4, kk = tid & 127, tq = tid >> 7;
            for (int unit = blockIdx.x; unit < 256; unit += G) {
                const int b = unit >> 4, hh = (unit >> 2) & 3, vsp = unit & 3;
                __syncthreads();
                float wgr[16];
#pragma unroll
                for (int j = 0; j < 16; ++j) wgr[j] = INP(20)[(size_t)jm * 16 * 512 + j * 512 + hh * 128 + kk];
                const float bgr = INP(21)[jm * 512 + hh * 128 + kk];
                if (tid < 256) pq[tid] = ((const float*)(ws + WS_SV) + 32768)[b * 1024 + (tid < 128 ? hh * 128 + tid : 512 + hh * 128 + (tid - 128))];
                for (int i = tid; i < 64 * PQD / 2; i += 512) ((LAS unsigned*)ST)[i] = 0u;
                __syncthreads();
                float c_exact = 0.f;
                if (wave == 0) c_exact = wave_sum(pq[lane] * pq[128 + lane] + pq[64 + lane] * pq[192 + lane]) * 0.08838834764831845f;
                f32x4 Sacc[4];
#pragma unroll
                for (int nt = 0; nt < 4; ++nt) Sacc[nt] = (f32x4){0.f, 0.f, 0.f, 0.f};
                unsigned short qh[16], kh[16]; v4u vreg; f32x4 greg = (f32x4){0.f, 0.f, 0.f, 0.f};
                { const size_t m0 = (size_t)b * T;
#pragma unroll
                  for (int i = 0; i < 16; ++i) { const bf16* rp = QKV + (m0 + 16 * tq + i) * 3072 + hh * 128 + kk; qh[i] = rp[0]; kh[i] = rp[512]; }
                  vreg = *(const GAS v4u*)(QKV + (m0 + (tid >> 3)) * 3072 + 1024 + hh * 256 + vsp * 64 + (tid & 7) * 8);
                  if (tid < 256) greg = *(const GAS f32x4*)(FLOG + (m0 + (tid >> 2)) * 16 + (tid & 3) * 4); }
                for (int c = 0; c < 32; ++c) {
                    const size_t mb = (size_t)b * T + c * 64;
                    if (tid < 256) *(LAS f32x4*)(GLs + tid * 4) = greg;
                    __syncthreads();
                    float bc[16]; float run = 0.f;
#pragma unroll
                    for (int i = 0; i < 16; ++i) { const LAS f32x4* gp = (const LAS f32x4*)(GLs + (16 * tq + i) * 16); const f32x4 g0 = gp[0], g1 = gp[1], g2 = gp[2], g3 = gp[3];
                        float x = bgr;
                        x += g0[0] * wgr[0] + g0[1] * wgr[1] + g0[2] * wgr[2] + g0[3] * wgr[3]; x += g1[0] * wgr[4] + g1[1] * wgr[5] + g1[2] * wgr[6] + g1[3] * wgr[7];
                        x += g2[0] * wgr[8] + g2[1] * wgr[9] + g2[2] * wgr[10] + g2[3] * wgr[11]; x += g3[0] * wgr[12] + g3[1] * wgr[13] + g3[2] * wgr[14] + g3[3] * wgr[15];
                        run -= __builtin_amdgcn_logf(1.0f + __builtin_amdgcn_exp2f(-x * LOG2E)) * (0.6931471805599453f / 16.0f); bc[i] = run; }
                    PS[tq * 128 + kk] = run;
                    __syncthreads();
                    const float p0 = PS[kk], p1 = PS[128 + kk], p2 = PS[256 + kk], p3 = PS[384 + kk];
                    const float off = (tq > 0 ? p0 : 0.f) + (tq > 1 ? p1 : 0.f) + (tq > 2 ? p2 : 0.f), blast = (p0 + p1) + (p2 + p3);
                    if (tq == 0) EB[kk] = __builtin_amdgcn_exp2f(blast * LOG2E);
                    const float ebl = __builtin_amdgcn_exp2f(blast * LOG2E);
                    float kuv[16];
#pragma unroll
                    for (int i = 0; i < 16; ++i) { const int t = 16 * tq + i; const float bcu = bc[i] + off, e1 = __builtin_amdgcn_exp2f(bcu * LOG2E), ie1 = __builtin_amdgcn_rcpf(e1), qv = __uint_as_float((unsigned)qh[i] << 16), kv = __uint_as_float((unsigned)kh[i] << 16);
                        const float ki = kv * ie1;
                        const unsigned pk = cvtpk_c(qv * 0.08838834764831845f * e1, ki); QD[t * PQD + kk] = (unsigned short)pk; KI[t * PQD + kk] = (unsigned short)(pk >> 16);
                        kuv[i] = ki * ebl; }
                    { v4u w0, w1; w0.x = cvtpk_c(kuv[0], kuv[1]); w0.y = cvtpk_c(kuv[2], kuv[3]); w0.z = cvtpk_c(kuv[4], kuv[5]); w0.w = cvtpk_c(kuv[6], kuv[7]); w1.x = cvtpk_c(kuv[8], kuv[9]); w1.y = cvtpk_c(kuv[10], kuv[11]); w1.z = cvtpk_c(kuv[12], kuv[13]); w1.w = cvtpk_c(kuv[14], kuv[15]);
                      *(LAS v4u*)(KUT + kk * PSS + 16 * tq) = w0; *(LAS v4u*)(KUT + kk * PSS + 16 * tq + 8) = w1; }
                    { const int s = tid >> 3, v8 = (tid & 7) * 8; const unsigned w4[4] = {vreg.x, vreg.y, vreg.z, vreg.w};
#pragma unroll
                      for (int e = 0; e < 8; ++e) VT[(v8 + e) * PSS + s] = (unsigned short)((e & 1) ? (w4[e >> 1] >> 16) : (w4[e >> 1] & 0xffffu)); }
                    if (c + 1 < 32) { const size_t m1 = mb + 64;
#pragma unroll
                        for (int i = 0; i < 16; ++i) { const bf16* rp = QKV + (m1 + 16 * tq + i) * 3072 + hh * 128 + kk; qh[i] = rp[0]; kh[i] = rp[512]; }
                        vreg = *(const GAS v4u*)(QKV + (m1 + (tid >> 3)) * 3072 + 1024 + hh * 256 + vsp * 64 + (tid & 7) * 8);
                        if (tid < 256) greg = *(const GAS f32x4*)(FLOG + (m1 + (tid >> 2)) * 16 + (tid & 3) * 4); }
                    __syncthreads();
                    { const int mt = wave >> 1;
#pragma unroll
                      for (int n2 = 0; n2 < 2; ++n2) { const int nt = 2 * (wave & 1) + n2; f32x4 acc = (f32x4){0.f, 0.f, 0.f, 0.f};
                          if (nt <= mt) {
#pragma unroll
                              for (int k4 = 0; k4 < 4; ++k4) { const bf16x8 a = *(const LAS bf16x8*)(QD + (16 * mt + fr) * PQD + 32 * k4 + 8 * fq), bb = *(const LAS bf16x8*)(KI + (16 * nt + fr) * PQD + 32 * k4 + 8 * fq);
                                  acc = __builtin_amdgcn_mfma_f32_16x16x32_bf16(a, bb, acc, 0, 0, 0); }
                              if (nt == mt) {
#pragma unroll
                                  for (int e = 0; e < 4; ++e) if (fr > 4 * fq + e) acc[e] = 0.f; }
                              if (c == 0 && mt == 0 && nt == 0 && lane == 0) acc[0] = c_exact; }
                          { const unsigned p01 = cvtpk_c(acc[0], acc[1]), p23 = cvtpk_c(acc[2], acc[3]); unsigned short* dummy_ = nullptr; (void)dummy_;
                            ATT[(16 * mt + 4 * fq + 0) * PSS + 16 * nt + fr] = (unsigned short)p01; ATT[(16 * mt + 4 * fq + 1) * PSS + 16 * nt + fr] = (unsigned short)(p01 >> 16);
                            ATT[(16 * mt + 4 * fq + 2) * PSS + 16 * nt + fr] = (unsigned short)p23; ATT[(16 * mt + 4 * fq + 3) * PSS + 16 * nt + fr] = (unsigned short)(p23 >> 16); } } }
                    __syncthreads();
                    { const int mt = wave >> 1;
#pragma unroll
                      for (int n2 = 0; n2 < 2; ++n2) { const int nt = 2 * (wave & 1) + n2; f32x4 acc = (f32x4){0.f, 0.f, 0.f, 0.f};
#pragma unroll
                          for (int ks = 0; ks < 2; ++ks) { const bf16x8 a = *(const LAS bf16x8*)(ATT + (16 * mt + fr) * PSS + 32 * ks + 8 * fq), bb = *(const LAS bf16x8*)(VT + (16 * nt + fr) * PSS + 32 * ks + 8 * fq);
                              acc = __builtin_amdgcn_mfma_f32_16x16x32_bf16(a, bb, acc, 0, 0, 0); }
#pragma unroll
                          for (int k4 = 0; k4 < 4; ++k4) { const bf16x8 a = *(const LAS bf16x8*)(QD + (16 * mt + fr) * PQD + 32 * k4 + 8 * fq), bb = *(const LAS bf16x8*)(ST + (16 * nt + fr) * PQD + 32 * k4 + 8 * fq);
                              acc = __builtin_amdgcn_mfma_f32_16x16x32_bf16(a, bb, acc, 0, 0, 0); }
                          { const unsigned p01 = cvtpk_c(acc[0], acc[1]), p23 = cvtpk_c(acc[2], acc[3]); bf16* op = OB + (mb + 16 * mt + 4 * fq) * D + hh * 256 + vsp * 64 + 16 * nt + fr;
                            op[0] = (bf16)p01; op[D] = (bf16)(p01 >> 16); op[2 * D] = (bf16)p23; op[3 * D] = (bf16)(p23 >> 16); } } }
                    { const int mt = wave;
                      const f32x4 ebv = *(const LAS f32x4*)(EB + 16 * mt + 4 * fq);
#pragma unroll
                      for (int nt = 0; nt < 4; ++nt) { f32x4 acc = Sacc[nt] * ebv;
#pragma unroll
                          for (int ks = 0; ks < 2; ++ks) { const bf16x8 a = *(const LAS bf16x8*)(KUT + (16 * mt + fr) * PSS + 32 * ks + 8 * fq), bb = *(const LAS bf16x8*)(VT + (16 * nt + fr) * PSS + 32 * ks + 8 * fq);
                              acc = __builtin_amdgcn_mfma_f32_16x16x32_bf16(a, bb, acc, 0, 0, 0); }
                          Sacc[nt] = acc; } }
                    __syncthreads();
                    { const int mt = wave;
#pragma unroll
                      for (int nt = 0; nt < 4; ++nt) { u32x2g w; w.x = cvtpk_c(Sacc[nt][0], Sacc[nt][1]); w.y = cvtpk_c(Sacc[nt][2], Sacc[nt][3]); *(LAS u32x2g*)(ST + (16 * nt + fr) * PQD + 16 * mt + 4 * fq) = w; } }
                }
            }
        }
        else if (type == T_MIX2 && mixer == 2) {
            const bf16* OB = PP; const bf16* R = BIG + 2048; bf16* AO = PP;
            for (int it = gw; it < M * 4; it += NGW) { const size_t m = (size_t)(it >> 2); const int hh = it & 3, col = hh * 256 + 4 * lane;
                const u32x2g ow = *(const GAS u32x2g*)(OB + m * D + col), rw = *(const GAS u32x2g*)(R + m * 3072 + col);
                const f32x4 gn = *(const GAS f32x4*)(INP(22) + jm * 1024 + col);
                const float o0 = bf_lo(ow.x), o1 = bf_hi(ow.x), o2 = bf_lo(ow.y), o3 = bf_hi(ow.y);
                const float ss = wave_sum((o0 * o0 + o1 * o1) + (o2 * o2 + o3 * o3)); const float rn = rsqrtf(ss * (1.0f / 256.0f) + 1e-6f);
                const float r0 = bf_lo(rw.x), r1 = bf_hi(rw.x), r2 = bf_lo(rw.y), r3 = bf_hi(rw.y);
                u32x2g w; w.x = pk2(o0 * rn * gn[0] * r0 * sigmoid_f(r0), o1 * rn * gn[1] * r1 * sigmoid_f(r1)); w.y = pk2(o2 * rn * gn[2] * r2 * sigmoid_f(r2), o3 * rn * gn[3] * r3 * sigmoid_f(r3));
                *(GAS u32x2g*)(AO + m * D + col) = w; }
        }
        else if (type == T_UP0) {
            const float* P = INP(1) + (size_t)layer * M * 256;
            for (size_t idx = (size_t)gtid * 8; idx < (size_t)M * 256; idx += (size_t)NT * 8) { const f32x4 a = *(const GAS f32x4*)(P + idx), b2 = *(const GAS f32x4*)(P + idx + 4);
                v4u o; o.x = pk2(a[0], a[1]); o.y = pk2(a[2], a[3]); o.z = pk2(b2[0], b2[1]); o.w = pk2(b2[2], b2[3]); *(GAS v4u*)(PB + idx) = o; }
        }
        else if (type == T_FINAL) {
            const float* ssq = (const float*)(ws + WS_SSQA);
            const GAS f32x4* gf = (const GAS f32x4*)INP(28) + lane; const f32x4 g0 = gf[0], g1 = gf[64], g2 = gf[128], g3 = gf[192];
            for (int m = gw; m < M; m += NGW) { GAS f32x4* hr = (GAS f32x4*)(h + (size_t)m * D) + lane; const GAS u32x2g* br = (const GAS u32x2g*)(PB + (size_t)m * D) + lane;
                const float s = wave_sum(lane < 16 ? ssq[(size_t)m * 16 + lane] : 0.f); const float rs = rsqrtf(s * (1.0f / 1024.0f) + 1e-6f);
                const u32x2g w0 = br[0], w1 = br[64], w2 = br[128], w3 = br[192];
                hr[0] = (f32x4){bf_lo(w0.x), bf_hi(w0.x), bf_lo(w0.y), bf_hi(w0.y)} * rs * g0; hr[64] = (f32x4){bf_lo(w1.x), bf_hi(w1.x), bf_lo(w1.y), bf_hi(w1.y)} * rs * g1;
                hr[128] = (f32x4){bf_lo(w2.x), bf_hi(w2.x), bf_lo(w2.y), bf_hi(w2.y)} * rs * g2; hr[192] = (f32x4){bf_lo(w3.x), bf_hi(w3.x), bf_lo(w3.y), bf_hi(w3.y)} * rs * g3; }
        }

        } }
        for (int job = 0; job < 2; ++job) {
            int kind = -1;
            pg8::Gemm g{nullptr, nullptr, M, D, D};
            pg8::bf16_t* aO = nullptr; int aldc = D; const float* assq = nullptr; int asplit = 0; size_t astride = 0; float ascale = 1.f; float* aft = nullptr; int afc = 1 << 30;
            const pg8::bf16_t* rbase = HB; pg8::bf16_t* rhb = HB; const float* rssi = nullptr; float* rsso = nullptr;
            if (job == 0) {
                if (type == T_INPROJ) { kind = 0; g.A = PB; assq = ssq0;
                    if (mixer == 0) { g.Bt = Wb + W_S5IN + jm * W_S5STRIDE; g.N = 1024; aO = BIG; aldc = 1024; }
                    else if (mixer == 1) { g.Bt = Wb + W_FOXIN; g.N = 3328; aO = BIG; aldc = 1024; asplit = 1024; astride = 32 * ME; ascale = attn_body::C2; aft = FLOG; afc = 3072; }
                    else { g.Bt = Wb + W_GLAIN; g.N = 3328; aO = BIG; aldc = 3072; aft = FLOG; afc = 3072; } }
                else if (type == T_MIX2 && mixer == 0) { kind = 2; g.A = BIG + 32 * ME; g.Bt = Wb + W_S5GLU + jm * W_S5STRIDE; g.N = 2048; aO = BIG + 64 * ME; aldc = 1024; }
                else if (type == T_OUTPROJ) { kind = 3; g.A = (mixer == 0) ? BIG + 64 * ME : (mixer == 1) ? BIG : PP; g.Bt = Wb + ((mixer == 0) ? W_S5OUT + jm * W_S5STRIDE : (mixer == 1) ? W_FOXOUT : W_GLAOUT);
                    rbase = PB; rsso = ssq1; }
                else if (type == T_UP0 || type == T_UP1) { const int hf = (type == T_UP1); kind = 1; g.A = HB + (size_t)hf * 16 * ME; g.Bt = Wb + W_MLP1 + layer * W_MLPSTRIDE; g.M = M / 2; g.N = FF;
                    aO = BIG; aldc = FF; assq = ssq1 + (size_t)hf * (M / 2) * 16; }
                else if (type == T_DOWN0 || type == T_DOWN1) { const int hf = (type == T_DOWN1); kind = 3; g.A = BIG; g.Bt = Wb + W_MLP2 + layer * W_MLPSTRIDE; g.M = M / 2; g.K = FF;
                    rbase = HB + (size_t)hf * 16 * ME; rhb = HB + (size_t)hf * 16 * ME; rsso = ssq2 + (size_t)hf * (M / 2) * 16; }
                else if (type == T_PLE) { kind = 4; g.A = HB; g.Bt = Wb + W_PLEG + layer * W_PLESTRIDE; rssi = ssq2; rsso = ssq3; rhb = PB; }
            } else {
                if (type == T_DOWN0) { kind = 0; g.A = PB; g.Bt = Wb + W_PLEP + layer * W_PLESTRIDE; g.K = 256; aO = PP; aldc = 1024; }
            }
            if (kind < 0) continue;
            pg8::StaticOrder S; S.init(g.M, g.N, G, (int)blockIdx.x);
            for (int grep_ = 0; grep_ < ((kind <= 2) ? MK_DUP_G : 1); ++grep_)
            if (kind == 0) { pg8::EpiAct<0> E{aO, aldc, assq, asplit, astride, ascale, aft, afc}; pg8::gemm_phase<pg8::EpiAct<0>, pg8::StaticOrder, true, true>(ldsl + RING_OFF, g, S, E); }
            else if (kind == 1) { pg8::EpiAct<1> E{aO, aldc, assq, 0, 0, 1.f, nullptr, 1 << 30}; pg8::gemm_phase<pg8::EpiAct<1>, pg8::StaticOrder, true, true>(ldsl + RING_OFF, g, S, E); }
            else if (kind == 2) { pg8::EpiAct<2> E{aO, aldc, nullptr, 0, 0, 1.f, nullptr, 1 << 30}; pg8::gemm_phase<pg8::EpiAct<2>, pg8::StaticOrder, true, true>(ldsl + RING_OFF, g, S, E); }
            else if (kind == 3) { pg8::EpiRes<0> E{rbase, rhb, nullptr, rsso, nullptr, D}; pg8::gemm_phase<pg8::EpiRes<0>, pg8::StaticOrder, true, true>(ldsl + RING_OFF, g, S, E); }
            else { pg8::EpiRes<1> E{rbase, rhb, rssi, rsso, PP, D}; pg8::gemm_phase<pg8::EpiRes<1>, pg8::StaticOrder, true, true>(ldsl + RING_OFF, g, S, E); }
        }

        if (ph + 1 < args.ph_hi) {
#if !MK_PER_PHASE
#if MK_USE_CG
            grid.sync();
#else
            if (ph == args.ph_lo) grid.sync(); else xcd_barrier(bar);
#endif
#endif
        }
    }
}

#undef ws
#undef h
#undef Wb
#undef HB
#undef PB
#undef PP
#undef BIG
#undef FLOG
#undef NEGF
#undef ssq0
#undef ssq1
#undef ssq2
#undef ssq3
extern "C" void kernel_launch(void* const* d_in, const int* in_sizes, int n_in, void* d_out, int out_size, void* d_ws, size_t ws_size, hipStream_t stream) {
    static int grid = 0;
    if (grid == 0) {
        if (n_in != 29 || in_sizes[0] != M * D || out_size != M * D || ws_size < WS_END) { fprintf(stderr, "kernel_launch: unexpected shapes: n_in %d in0 %d out %d ws %zu (need %zu)\n", n_in, n_in > 0 ? in_sizes[0] : -1, out_size, ws_size, (size_t)WS_END); grid = -1; return; }
        int dev = 0, cus = 0, per_cu = 0;
        if (hipGetDevice(&dev) != hipSuccess || hipDeviceGetAttribute(&cus, hipDeviceAttributeMultiprocessorCount, dev) != hipSuccess) { grid = -1; return; }
        if (hipFuncSetAttribute((const void*)trunk_fwd, hipFuncAttributeMaxDynamicSharedMemorySize, LDS_BYTES) != hipSuccess) { fprintf(stderr, "kernel_launch: hipFuncSetAttribute failed\n"); grid = -1; return; }
        if (hipOccupancyMaxActiveBlocksPerMultiprocessor(&per_cu, (const void*)trunk_fwd, NWAVES * 64, LDS_BYTES) != hipSuccess || per_cu < 1) { fprintf(stderr, "kernel_launch: occupancy query says %d\n", per_cu); per_cu = 1; }
        (void)hipGetLastError();
        grid = cus;
    }
    if (grid < 0) return;
    (void)hipMemsetAsync((char*)d_ws + WS_CTL, 0, CTL_ZERO_BYTES, stream);
    Args a{};
    for (int i = 0; i < 29; ++i) a.in[i] = (const float*)d_in[i];
    a.out = (float*)d_out; a.ws = (unsigned char*)d_ws;
#if MK_PER_PHASE
    for (int ph = 0; ph < N_PHASES; ++ph) { a.ph_lo = ph; a.ph_hi = ph + 1; hipLaunchKernelGGL(trunk_fwd, dim3(grid), dim3(NWAVES * 64), LDS_BYTES, stream, a); }
#else
    a.ph_lo = 0; a.ph_hi = N_PHASES;
    void* kargs[] = {&a};
    hipError_t e = hipLaunchCooperativeKernel((const void*)trunk_fwd, dim3(grid), dim3(NWAVES * 64), kargs, LDS_BYTES, stream);
    if (e != hipSuccess) fprintf(stderr, "kernel_launch: cooperative launch failed: %s (grid %d)\n", hipGetErrorString(e), grid);
#endif
}
```

```cpp
#include <hip/hip_runtime.h>
#include <hip/hip_cooperative_groups.h>
#include <cstdio>
#include <cstdint>
#include <hip/hip_bf16.h>
#include <cmath>
namespace pg8 {
#define PG8_LAS __attribute__((address_space(3)))
typedef unsigned short bf16_t;
typedef short bf16x8 __attribute__((ext_vector_type(8)));
typedef float f32x4 __attribute__((ext_vector_type(4)));
typedef unsigned u32x4 __attribute__((ext_vector_type(4)));
constexpr int BM = 256, BK = 64, HALF = 128, HTB = HALF * BK * 2  , STAGE_BYTES = 8 * HTB, NXCD = 8, WGM = 8;

__host__ __device__ __forceinline__ int lds_byte(int r, int c) { const int st = (r >> 4) * 2 + (c >> 5), rr = r & 15, cc = c & 31, ob = rr * 64 + cc * 2; return st * 1024 + (ob ^ (((ob >> 9) & 1) << 5)); }
__host__ __device__ __forceinline__ void stage_rc(int b, int& R, int& C) { const int st = b / 1024, sb = b % 1024, swz = sb ^ (((sb >> 9) & 1) << 5); R = (st >> 1) * 16 + swz / 64; C = (st & 1) * 32 + (swz % 64) / 2; }
__host__ __device__ __forceinline__ int perm32(int rho) { const int n = rho >> 4, i = rho & 15; return 8 * (i >> 2) + 4 * n + (i & 3); }

struct Unit { int pm, pn; };
struct Gemm { const bf16_t* A; const bf16_t* Bt; int M, N, K; };

struct StaticOrder {
    int nM, nN, nwg, G, c;
    __host__ __device__ void init(int M, int N, int G_, int c_) { nM = M / BM; nN = N / BM; nwg = nM * nN; G = G_; c = c_; }
    __host__ __device__ bool next(int i, Unit& u) const {
        const long L = (long)i * G + c; if (L >= nwg) return false;
        int wgid = (int)L; { const int q = nwg / NXCD, r = nwg % NXCD, xcd = wgid % NXCD, off = wgid / NXCD; wgid = (xcd < r ? xcd * (q + 1) : r * (q + 1) + (xcd - r) * q) + off; }
        const int nig = WGM * nN, gid = wgid / nig, fm = gid * WGM, gsz = (nM - fm) < WGM ? (nM - fm) : WGM;
        u.pm = fm + ((wgid % nig) % gsz); u.pn = (wgid % nig) / gsz; return true;
    }
    __device__ __forceinline__ void a_ready(const Unit&) const {}
    __device__ __forceinline__ void done(const Unit&) const {}
};

__device__ __forceinline__ unsigned cvt_pk_bf16(float lo, float hi) { unsigned r; asm volatile("v_cvt_pk_bf16_f32 %0, %1, %2" : "=v"(r) : "v"(lo), "v"(hi)); return r; }
typedef float f32x2 __attribute__((ext_vector_type(2)));
typedef unsigned u32x2 __attribute__((ext_vector_type(2)));
__device__ __forceinline__ float sigm(float x) { return 1.0f / (1.0f + __expf(-x)); }
__device__ __forceinline__ float row_rstd(const float* ssq, size_t row) {
    const f32x4* s = (const f32x4*)(ssq + row * 16); const f32x4 a = (s[0] + s[1]) + (s[2] + s[3]);
    return rsqrtf(((a[0] + a[1]) + (a[2] + a[3])) * (1.0f / 1024.0f) + 1e-6f);
}
template <int MODE> struct EpiAct {
    static constexpr bool PERM = true, AFTER_DRAIN = false;
    bf16_t* O; int ldc; const float* ssq; int split_cols; size_t split_stride; float scale0; float* ftile; int fcol0;
    __device__ __forceinline__ void operator()(const f32x4 (&acc)[2][2][4][2], const Unit& u, int wr, int wc, int fr, int fq) const {
        const int row0 = u.pm * BM + wr * 64 + fr; int colt = u.pn * BM; bf16_t* base = O;
        float rs[2][4];
#pragma unroll
        for (int ai = 0; ai < 2; ++ai)
#pragma unroll
            for (int m = 0; m < 4; ++m) rs[ai][m] = ssq ? row_rstd(ssq, (size_t)(row0 + ai * HALF + m * 16)) : 1.0f;
        if (MODE == 0 && ftile != nullptr && colt >= fcol0) {
            if (wc == 0 && fq < 2) {
#pragma unroll
                for (int ai = 0; ai < 2; ++ai)
#pragma unroll
                    for (int m = 0; m < 4; ++m) { float* dst = ftile + (size_t)(row0 + ai * HALF + m * 16) * 16 + 8 * fq;
                        *(f32x4*)dst = acc[ai][0][m][0] * rs[ai][m]; *(f32x4*)(dst + 4) = acc[ai][0][m][1] * rs[ai][m]; }
            }
            return;
        }
        if (MODE == 2) {
            const int col0 = u.pn * HALF + wc * 32 + 8 * fq;
#pragma unroll
            for (int ai = 0; ai < 2; ++ai)
#pragma unroll
                for (int m = 0; m < 4; ++m) { bf16_t* rowp = base + (size_t)(row0 + ai * HALF + m * 16) * ldc + col0;
                    const f32x4 a0 = acc[ai][0][m][0], a1 = acc[ai][0][m][1], g0 = acc[ai][1][m][0], g1 = acc[ai][1][m][1];
                    u32x4 w; w.x = cvt_pk_bf16(a0[0] * sigm(g0[0]), a0[1] * sigm(g0[1])); w.y = cvt_pk_bf16(a0[2] * sigm(g0[2]), a0[3] * sigm(g0[3]));
                    w.z = cvt_pk_bf16(a1[0] * sigm(g1[0]), a1[1] * sigm(g1[1])); w.w = cvt_pk_bf16(a1[2] * sigm(g1[2]), a1[3] * sigm(g1[3]));
                    *(u32x4*)rowp = w; }
            return;
        }
        float sc = 1.f; if (split_cols) { const int t = colt / split_cols; base += (size_t)t * split_stride; colt -= t * split_cols; if (t == 0) sc = scale0; }
        const int col0 = colt + wc * 32 + 8 * fq;
#pragma unroll
        for (int ai = 0; ai < 2; ++ai)
#pragma unroll
            for (int m = 0; m < 4; ++m) { bf16_t* rowp = base + (size_t)(row0 + ai * HALF + m * 16) * ldc + col0; const float s = rs[ai][m] * sc;
#pragma unroll
                for (int bj = 0; bj < 2; ++bj) { f32x4 v0 = acc[ai][bj][m][0] * s, v1 = acc[ai][bj][m][1] * s;
                    if (MODE == 1) {
#pragma unroll
                        for (int e = 0; e < 4; ++e) { const float a = fmaxf(v0[e], 0.f), b = fmaxf(v1[e], 0.f); v0[e] = a * a; v1[e] = b * b; } }
                    u32x4 w; w.x = cvt_pk_bf16(v0[0], v0[1]); w.y = cvt_pk_bf16(v0[2], v0[3]); w.z = cvt_pk_bf16(v1[0], v1[1]); w.w = cvt_pk_bf16(v1[2], v1[3]);
                    *(u32x4*)(rowp + bj * HALF) = w; } }
    }
};
#ifndef MK_BF16_RES
#define MK_BF16_RES 1
#endif
template <int MODE> struct EpiRes {
    static constexpr bool PERM = true, AFTER_DRAIN = false;
    const bf16_t* baseb; bf16_t* hb; const float* ssq_in; float* ssq_out; const bf16_t* pp; int ldc;
    __device__ __forceinline__ void operator()(const f32x4 (&acc)[2][2][4][2], const Unit& u, int wr, int wc, int fr, int fq) const {
        const int col0 = u.pn * BM + wc * 32 + 8 * fq;
        constexpr int MB = (MODE == 1) ? 2 : 4;
#pragma unroll
        for (int ai = 0; ai < 2; ++ai)
#pragma unroll
            for (int m0 = 0; m0 < 4; m0 += MB) {
                u32x4 pre[MB][2]; u32x4 ppw[MB][2]; float rs[MB];
#pragma unroll
                for (int mm = 0; mm < MB; ++mm) { const int r = u.pm * BM + ai * HALF + wr * 64 + (m0 + mm) * 16 + fr; const size_t off = (size_t)r * ldc + col0;
                    rs[mm] = 1.f; if (MODE == 1) rs[mm] = row_rstd(ssq_in, (size_t)r);
#pragma unroll
                    for (int bj = 0; bj < 2; ++bj) { pre[mm][bj] = *(const u32x4*)(baseb + off + bj * HALF); if (MODE == 1) ppw[mm][bj] = *(const u32x4*)(pp + off + bj * HALF); } }
#pragma unroll
                for (int mm = 0; mm < MB; ++mm) { const int m = m0 + mm; const int r = u.pm * BM + ai * HALF + wr * 64 + m * 16 + fr; const size_t off = (size_t)r * ldc + col0;
                    float q = 0.f;
#pragma unroll
                    for (int bj = 0; bj < 2; ++bj) { const size_t o2 = off + bj * HALF; f32x4 v[2];
#pragma unroll
                        for (int n = 0; n < 2; ++n) { const unsigned b0 = n ? pre[mm][bj].z : pre[mm][bj].x, b1 = n ? pre[mm][bj].w : pre[mm][bj].y;
                            const f32x4 b = (f32x4){__uint_as_float(b0 << 16), __uint_as_float(b0 & 0xffff0000u), __uint_as_float(b1 << 16), __uint_as_float(b1 & 0xffff0000u)}; const f32x4 a = acc[ai][bj][m][n];
                            if (MODE == 1) { const unsigned w0 = n ? ppw[mm][bj].z : ppw[mm][bj].x, w1 = n ? ppw[mm][bj].w : ppw[mm][bj].y;
                                const float p0 = __uint_as_float(w0 << 16), p1 = __uint_as_float(w0 & 0xffff0000u), p2 = __uint_as_float(w1 << 16), p3 = __uint_as_float(w1 & 0xffff0000u);
                                v[n][0] = b[0] + p0 * sigm(a[0] * rs[mm]); v[n][1] = b[1] + p1 * sigm(a[1] * rs[mm]); v[n][2] = b[2] + p2 * sigm(a[2] * rs[mm]); v[n][3] = b[3] + p3 * sigm(a[3] * rs[mm]); }
                            else v[n] = b + a; }
                        u32x4 w; w.x = cvt_pk_bf16(v[0][0], v[0][1]); w.y = cvt_pk_bf16(v[0][2], v[0][3]); w.z = cvt_pk_bf16(v[1][0], v[1][1]); w.w = cvt_pk_bf16(v[1][2], v[1][3]); *(u32x4*)(hb + o2) = w;
                        const float r0 = __uint_as_float(w.x << 16), r1 = __uint_as_float(w.x & 0xffff0000u), r2 = __uint_as_float(w.y << 16), r3 = __uint_as_float(w.y & 0xffff0000u);
                        const float r4 = __uint_as_float(w.z << 16), r5 = __uint_as_float(w.z & 0xffff0000u), r6 = __uint_as_float(w.w << 16), r7 = __uint_as_float(w.w & 0xffff0000u);
                        q += ((r0 * r0 + r1 * r1) + (r2 * r2 + r3 * r3)) + ((r4 * r4 + r5 * r5) + (r6 * r6 + r7 * r7)); }
                    q += __shfl_xor(q, 16); q += __shfl_xor(q, 32);
                    if (fq == 0) ssq_out[(size_t)r * 16 + u.pn * 4 + wc] = q; }
                asm volatile("" ::: "memory"); }
    }
};
template <class Epi, class Sched, bool ALIGN_EPI = false, bool SP2 = false>
__device__ __forceinline__ void gemm_phase(PG8_LAS unsigned char* lds, const Gemm g, const Sched& S, const Epi& E) {
    int tid_ = threadIdx.x; asm volatile("" : "+v"(tid_)); const int tid = tid_, wid = __builtin_amdgcn_readfirstlane(tid >> 6), lane = tid & 63, wr = wid >> 2, wc = wid & 3, fr = lane & 15, fq = lane >> 4;
    const int K = g.K, nt = K / BK;
    unsigned voffA[2], voffB[2];
#pragma unroll
    for (int i = 0; i < 2; ++i) { int R, C; stage_rc(tid * 16 + i * 8192, R, C); const int Rb = Epi::PERM ? ((R & ~31) + perm32(R & 31)) : R;
        voffA[i] = (unsigned)(R * K + C) * 2u; voffB[i] = (unsigned)(Rb * K + C) * 2u; }
    const size_t kstep = (size_t)(BK * 2);
    const size_t hstep = (size_t)HALF * K * 2;
    const size_t tstep = 2 * hstep;
    const unsigned ldsw = (unsigned)wid * 1024u;
    const int aoff = lds_byte(wr * 64 + fr, fq * 8), boff = lds_byte(wc * 32 + fr, fq * 8);
#define PG8_SA(b, h) (((b) * 2 + (h)) * HTB)
#define PG8_SB(b, h) ((4 + (b) * 2 + (h)) * HTB)
#define PG8_STAGE(bufoff, gbase, voff) do { _Pragma("unroll") for (int _i = 0; _i < 2; ++_i) \
        __builtin_amdgcn_global_load_lds((const unsigned*)((const char*)(gbase) + (voff)[_i]), (PG8_LAS unsigned*)(lds + (bufoff) + ldsw + _i * 8192), 16, 0, 0); } while (0)
#define PG8_LDA(dst, b, h) do { _Pragma("unroll") for (int m = 0; m < 4; ++m) _Pragma("unroll") for (int k = 0; k < 2; ++k) dst[m][k] = *(const PG8_LAS bf16x8*)(lds + PG8_SA(b, h) + aoff + m * 2048 + k * 1024); } while (0)
#define PG8_LDB(dst, b, h) do { _Pragma("unroll") for (int n = 0; n < 2; ++n) _Pragma("unroll") for (int k = 0; k < 2; ++k) dst[n][k] = *(const PG8_LAS bf16x8*)(lds + PG8_SB(b, h) + boff + n * 2048 + k * 1024); } while (0)
#define PG8_MMA(ai, bj, At, Bt) do { __builtin_amdgcn_s_setprio(1); _Pragma("unroll") for (int m = 0; m < 4; ++m) _Pragma("unroll") for (int n = 0; n < 2; ++n) _Pragma("unroll") for (int k = 0; k < 2; ++k) \
        acc[ai][bj][m][n] = __builtin_amdgcn_mfma_f32_16x16x32_bf16(Bt[n][k], At[m][k], acc[ai][bj][m][n], 0, 0, 0); __builtin_amdgcn_s_setprio(0); } while (0)
#define PG8_WAIT_V(n) asm volatile("s_waitcnt vmcnt(" #n ")" ::: "memory")
#define PG8_WAIT_L(n) asm volatile("s_waitcnt lgkmcnt(" #n ")" ::: "memory")
#define PG8_BAR __builtin_amdgcn_s_barrier()
#define PG8_SCHED __builtin_amdgcn_sched_barrier(0)
    Unit cur, nxt; int ui = 0;
    if (!S.next(0, cur)) return;
    f32x4 acc[2][2][4][2];
#pragma unroll
    for (int a = 0; a < 2; ++a)
#pragma unroll
        for (int b = 0; b < 2; ++b)
#pragma unroll
            for (int m = 0; m < 4; ++m)
#pragma unroll
                for (int n = 0; n < 2; ++n) acc[a][b][m][n] = (f32x4){0.f, 0.f, 0.f, 0.f};
    bf16x8 At[4][2], B0[2][2], B1[2][2];
    const char* cA = (const char*)g.A + (size_t)cur.pm * tstep; const char* cB = (const char*)g.Bt + (size_t)cur.pn * tstep;
    S.a_ready(cur);
    if constexpr (SP2) {
        PG8_STAGE(PG8_SB(0, 0), cB, voffB); PG8_STAGE(PG8_SB(0, 1), cB + hstep, voffB); PG8_STAGE(PG8_SA(0, 0), cA, voffA); PG8_STAGE(PG8_SA(0, 1), cA + hstep, voffA);
        if (wr == 1) PG8_BAR;
        PG8_WAIT_V(2); PG8_BAR;
        PG8_STAGE(PG8_SB(1, 0), cB + kstep, voffB); PG8_STAGE(PG8_SA(1, 0), cA + kstep, voffA); PG8_STAGE(PG8_SB(1, 1), cB + hstep + kstep, voffB);
        PG8_WAIT_V(6); PG8_BAR;
    } else {
        PG8_STAGE(PG8_SB(0, 0), cB, voffB); PG8_STAGE(PG8_SA(0, 0), cA, voffA); PG8_STAGE(PG8_SB(0, 1), cB + hstep, voffB); PG8_STAGE(PG8_SA(0, 1), cA + hstep, voffA);
        if (wr == 1) PG8_BAR;
        PG8_WAIT_V(4); PG8_BAR;
        PG8_STAGE(PG8_SB(1, 0), cB + kstep, voffB); PG8_STAGE(PG8_SA(1, 0), cA + kstep, voffA); PG8_STAGE(PG8_SB(1, 1), cB + hstep + kstep, voffB);
        PG8_WAIT_V(6); PG8_BAR;
    }
    for (;;) {
        const bool has_next = S.next(ui + 1, nxt);
        const char* nA = has_next ? (const char*)g.A + (size_t)nxt.pm * tstep : cA; const char* nB = has_next ? (const char*)g.Bt + (size_t)nxt.pn * tstep : cB;
        for (int t = 0; t < nt; t += 2) {
            const bool last = (t == nt - 2);
            const char* a1 = cA + (size_t)(t + 1) * kstep;
            const char* a2 = last ? nA : cA + (size_t)(t + 2) * kstep; const char* b2 = last ? nB : cB + (size_t)(t + 2) * kstep;
            const char* a3 = a2 + kstep; const char* b3 = b2 + kstep;
            if (last && has_next) S.a_ready(nxt);
            if constexpr (SP2) {
            PG8_LDB(B0, 0, 0); PG8_LDB(B1, 0, 1); PG8_SCHED; PG8_LDA(At, 0, 0); PG8_STAGE(PG8_SA(1, 1), a1 + hstep, voffA);
            PG8_WAIT_V(8); PG8_WAIT_L(0); PG8_BAR; PG8_MMA(0, 0, At, B0); PG8_MMA(0, 1, At, B1); PG8_BAR; PG8_SCHED;
            PG8_LDA(At, 0, 1); PG8_STAGE(PG8_SB(0, 0), b2, voffB); PG8_STAGE(PG8_SB(0, 1), b2 + hstep, voffB); PG8_STAGE(PG8_SA(0, 0), a2, voffA);
            PG8_WAIT_V(8); PG8_WAIT_L(0); PG8_BAR; PG8_MMA(1, 0, At, B0); PG8_MMA(1, 1, At, B1); PG8_BAR; PG8_SCHED;
            PG8_LDB(B0, 1, 0); PG8_LDB(B1, 1, 1); PG8_SCHED; PG8_LDA(At, 1, 0); PG8_STAGE(PG8_SA(0, 1), a2 + hstep, voffA);
            PG8_WAIT_V(8); PG8_WAIT_L(0); PG8_BAR; PG8_MMA(0, 0, At, B0); PG8_MMA(0, 1, At, B1); PG8_BAR; PG8_SCHED;
            PG8_LDA(At, 1, 1); PG8_STAGE(PG8_SB(1, 0), b3, voffB); PG8_STAGE(PG8_SB(1, 1), b3 + hstep, voffB); PG8_STAGE(PG8_SA(1, 0), a3, voffA);
            PG8_WAIT_V(8); PG8_WAIT_L(0); PG8_BAR; PG8_MMA(1, 0, At, B0); PG8_MMA(1, 1, At, B1); PG8_BAR; PG8_SCHED;
            } else {
            PG8_LDB(B0, 0, 0); PG8_SCHED; PG8_LDA(At, 0, 0); PG8_STAGE(PG8_SA(1, 1), a1 + hstep, voffA);
            PG8_WAIT_L(8); PG8_BAR; PG8_WAIT_L(0); PG8_MMA(0, 0, At, B0); PG8_BAR; PG8_SCHED;
            PG8_LDB(B1, 0, 1); PG8_STAGE(PG8_SB(0, 0), b2, voffB);
            PG8_BAR; PG8_WAIT_L(0); PG8_MMA(0, 1, At, B1); PG8_BAR;
            PG8_LDA(At, 0, 1); PG8_STAGE(PG8_SA(0, 0), a2, voffA);
            PG8_BAR; PG8_WAIT_L(0); PG8_MMA(1, 0, At, B0); PG8_BAR; PG8_SCHED;
            PG8_STAGE(PG8_SB(0, 1), b2 + hstep, voffB);
            PG8_WAIT_V(6); PG8_BAR; PG8_MMA(1, 1, At, B1); PG8_BAR;
            PG8_LDB(B0, 1, 0); PG8_SCHED; PG8_LDA(At, 1, 0); PG8_STAGE(PG8_SA(0, 1), a2 + hstep, voffA);
            PG8_WAIT_L(8); PG8_BAR; PG8_WAIT_L(0); PG8_MMA(0, 0, At, B0); PG8_BAR; PG8_SCHED;
            PG8_LDB(B1, 1, 1); PG8_STAGE(PG8_SB(1, 0), b3, voffB);
            PG8_BAR; PG8_WAIT_L(0); PG8_MMA(0, 1, At, B1); PG8_BAR;
            PG8_LDA(At, 1, 1); PG8_STAGE(PG8_SA(1, 0), a3, voffA);
            PG8_BAR; PG8_WAIT_L(0); PG8_MMA(1, 0, At, B0); PG8_BAR; PG8_SCHED;
            PG8_STAGE(PG8_SB(1, 1), b3 + hstep, voffB);
            PG8_WAIT_V(6); PG8_BAR; PG8_MMA(1, 1, At, B1); PG8_BAR;
            }
        }
        if constexpr (ALIGN_EPI) { if (wr == 0) PG8_BAR; }
        if constexpr (!Epi::AFTER_DRAIN) { E(acc, cur, wr, wc, fr, fq); S.done(cur); }
        if (!has_next) break;
#pragma unroll
        for (int a = 0; a < 2; ++a)
#pragma unroll
            for (int b = 0; b < 2; ++b)
#pragma unroll
                for (int m = 0; m < 4; ++m)
#pragma unroll
                    for (int n = 0; n < 2; ++n) acc[a][b][m][n] = (f32x4){0.f, 0.f, 0.f, 0.f};
        cur = nxt; cA = nA; cB = nB; ++ui;
        if constexpr (ALIGN_EPI) { if (wr == 1) PG8_BAR; }
    }
    PG8_WAIT_V(0);
    if constexpr (!ALIGN_EPI) { if (wr == 0) PG8_BAR; }
    PG8_BAR;
    if constexpr (Epi::AFTER_DRAIN) { E.fused(acc, cur, wr, wc, fr, fq, lds, wid, lane); S.done(cur); }
#undef PG8_SA
#undef PG8_SB
#undef PG8_STAGE
#undef PG8_LDA
#undef PG8_LDB
#undef PG8_MMA
#undef PG8_WAIT_V
#undef PG8_WAIT_L
#undef PG8_BAR
#undef PG8_SCHED
}
}
#include <hip/hip_bf16.h>
#include <cmath>
namespace attn_body {
using bf16=__hip_bfloat16;
using bf16x8=__attribute__((ext_vector_type(8)))short;
using s16x4=__attribute__((ext_vector_type(4)))short;
using f32x16=__attribute__((ext_vector_type(16)))float;
using u32x4=__attribute__((ext_vector_type(4)))unsigned;
constexpr int BATCH=16,NHEAD=16,SEQ=2048,D=64,DM=NHEAD*D;
constexpr int NW=8,QBLK=32,QB=QBLK*NW,KVBLK=64,NQB=SEQ/QB;
constexpr int ATTN_PITCH=DM, ATTN_UNIT_ROWS=QB;
__device__ __forceinline__ int crow(int r,int hi){return (r&3)+8*(r>>2)+4*hi;}
#define SBAR() __builtin_amdgcn_sched_barrier(0)
__device__ __forceinline__ void cmask(f32x16&p0,f32x16&p1,int jb,int qrel,int hi){
  const float NEG=-INFINITY; int kb=64*jb+4*hi;
  #pragma unroll
  for(int r=0;r<16;++r){int kv=kb+(r&3)+8*(r>>2); if(kv>qrel)p0[r]=NEG; if(kv+32>qrel)p1[r]=NEG;}
}

constexpr int NSLOT=3, SLOTB=8192;
constexpr int LDS_K=0, LDS_V=NSLOT*SLOTB, LDS_WS=2*NSLOT*SLOTB, LDS_OST=LDS_WS+NW*64*4, LDS_BIAS=LDS_OST+NW*4096, LDS_BYTES=LDS_BIAS+SEQ*4;
constexpr float C2=0.125f*1.4426950408889634f;
__device__ __forceinline__ void glds16(const void*gsrc,unsigned lds_dst){unsigned keep;
  asm volatile("s_mov_b32 %0, m0\n\ts_mov_b32 m0, %2\n\ts_nop 0\n\tglobal_load_lds_dwordx4 %1, off\n\ts_mov_b32 m0, %0":"=&s"(keep):"v"(gsrc),"s"(lds_dst):"memory");}
__device__ __forceinline__ float max3f(float a,float b,float c){float r;asm("v_max3_f32 %0, %1, %2, %3":"=v"(r):"v"(a),"v"(b),"v"(c));return r;}
__device__ __forceinline__ float max2f(float a,float b){float r;asm("v_max_f32_e32 %0, %1, %2":"=v"(r):"v"(a),"v"(b));return r;}
__device__ __forceinline__ float fadd_s(float a,float b){float r;asm("v_add_f32_e32 %0, %1, %2":"=v"(r):"v"(a),"v"(b));return r;}
__device__ __forceinline__ float fsub_s(float a,float b){float r;asm("v_sub_f32_e32 %0, %1, %2":"=v"(r):"v"(a),"v"(b));return r;}
typedef float f32x2_t __attribute__((ext_vector_type(2))); typedef __bf16 bf16x2_t __attribute__((ext_vector_type(2)));
__device__ __forceinline__ unsigned cvtpk_s(float lo,float hi){f32x2_t v={lo,hi};bf16x2_t b=__builtin_convertvector(v,bf16x2_t);return __builtin_bit_cast(unsigned,b);}
#define WAIT_BAR(N) asm volatile("s_waitcnt vmcnt(" #N ") lgkmcnt(0)\n\ts_barrier":::"memory")

__device__ __forceinline__ void qkt(f32x16&p0,f32x16&p1,const char*Kslot,const bf16x8*qr,const f32x16&negm,int r32,int hi){
  const char*kb=Kslot+hi*1024+r32*16;
  #pragma unroll
  for(int d0=0;d0<4;++d0){
    const bf16x8 b0=*reinterpret_cast<const bf16x8*>(kb+d0*2048);
    const bf16x8 b1=*reinterpret_cast<const bf16x8*>(kb+d0*2048+512);
    if(d0==0){p0=__builtin_amdgcn_mfma_f32_32x32x16_bf16(b0,qr[0],negm,0,0,0);p1=__builtin_amdgcn_mfma_f32_32x32x16_bf16(b1,qr[0],negm,0,0,0);}
    else{p0=__builtin_amdgcn_mfma_f32_32x32x16_bf16(b0,qr[d0],p0,0,0,0);p1=__builtin_amdgcn_mfma_f32_32x32x16_bf16(b1,qr[d0],p1,0,0,0);}}
}
typedef __attribute__((address_space(3))) const char* lds_cptr;
typedef short v4i16_t __attribute__((ext_vector_type(4)));
__device__ __forceinline__ void kload8(bf16x8*kf,lds_cptr kp){
  kf[0]=*(const __attribute__((address_space(3))) bf16x8*)(kp);      kf[1]=*(const __attribute__((address_space(3))) bf16x8*)(kp+512);
  kf[2]=*(const __attribute__((address_space(3))) bf16x8*)(kp+2048); kf[3]=*(const __attribute__((address_space(3))) bf16x8*)(kp+2560);
  kf[4]=*(const __attribute__((address_space(3))) bf16x8*)(kp+4096); kf[5]=*(const __attribute__((address_space(3))) bf16x8*)(kp+4608);
  kf[6]=*(const __attribute__((address_space(3))) bf16x8*)(kp+6144); kf[7]=*(const __attribute__((address_space(3))) bf16x8*)(kp+6656);
}
__device__ __forceinline__ void kload2(bf16x8*kf,lds_cptr kp,int j){ kf[2*j]=*(const __attribute__((address_space(3))) bf16x8*)(kp+j*2048); kf[2*j+1]=*(const __attribute__((address_space(3))) bf16x8*)(kp+j*2048+512); }
__device__ __forceinline__ s16x4 vtr(lds_cptr p){ return __builtin_bit_cast(s16x4,__builtin_amdgcn_ds_read_tr16_b64_v4i16((__attribute__((address_space(3))) v4i16_t*)p)); }
__device__ __forceinline__ float rowmax(const f32x16&p0,const f32x16&p1){
  float a=max3f(p0[0],p0[1],p1[0]),b=max3f(p0[2],p0[3],p1[1]);a=max3f(a,p1[2],p1[3]);
  #pragma unroll
  for(int r=4;r<16;r+=4){a=max3f(a,p0[r],p0[r+1]);b=max3f(b,p0[r+2],p0[r+3]);a=max3f(a,p1[r],p1[r+1]);b=max3f(b,p1[r+2],p1[r+3]);}
  const float m=max2f(a,b);
  auto rr=__builtin_amdgcn_permlane32_swap(__float_as_uint(m),__float_as_uint(m),false,false);
  return max2f(__uint_as_float(rr[0]),__uint_as_float(rr[1]));
}
__device__ __forceinline__ void pv(f32x16*o,int vb,bf16x8 pa0,bf16x8 pa1,bf16x8 pa2,bf16x8 pa3){
  #pragma unroll
  for(int d0=0;d0<2;++d0){s16x4 lo[4],hi[4];
    #pragma unroll
    for(int ks=0;ks<4;++ks){
      asm volatile("ds_read_b64_tr_b16 %0,%1 offset:%c2":"=&v"(lo[ks]):"v"(vb),"i"(d0*4096+ks*1024):"memory");
      asm volatile("ds_read_b64_tr_b16 %0,%1 offset:%c2":"=&v"(hi[ks]):"v"(vb),"i"(d0*4096+ks*1024+512):"memory");}
    asm volatile("s_waitcnt lgkmcnt(0)":::"memory");SBAR();
    #define PK(k) (bf16x8){lo[k][0],lo[k][1],lo[k][2],lo[k][3],hi[k][0],hi[k][1],hi[k][2],hi[k][3]}
    o[d0]=__builtin_amdgcn_mfma_f32_32x32x16_bf16(pa0,PK(0),o[d0],0,0,0);
    o[d0]=__builtin_amdgcn_mfma_f32_32x32x16_bf16(pa1,PK(1),o[d0],0,0,0);
    o[d0]=__builtin_amdgcn_mfma_f32_32x32x16_bf16(pa2,PK(2),o[d0],0,0,0);
    o[d0]=__builtin_amdgcn_mfma_f32_32x32x16_bf16(pa3,PK(3),o[d0],0,0,0);
    #undef PK
  }
}

#ifndef ATTN_STORE16
#define ATTN_STORE16(p,v) (*(u32x4*)(p)=(v))
#endif
typedef float f32x4_t __attribute__((ext_vector_type(4)));
template<int THRL> __device__ __forceinline__ void attn_unit(int b,int h,int qb,const bf16*Q,const bf16*__restrict__ K,const bf16*__restrict__ V,bf16*O,const float*NEGF,char*shm){
  int tid_=threadIdx.x; asm volatile("":"+v"(tid_)); const int tid=tid_,lane=tid&63,r32=lane&31,hi=lane>>5; const int wid=__builtin_amdgcn_readfirstlane(tid>>6);
  const long rowbase=(long)b*SEQ; const int q0=qb*QB;
  const bf16*Qw=Q+(rowbase+q0+wid*QBLK)*DM+h*D;
  const bf16*Kh=K+rowbase*DM+h*D,*Vh=V+rowbase*DM+h*D;
  const unsigned lds0=(unsigned)(uintptr_t)shm;
  float*wsf=(float*)(shm+LDS_WS)+wid*64;
  const bf16*ksrc=Kh+(long)lane*DM+wid*8;
  const bf16*vsrc=Vh+(long)(16*(wid&3)+(lane>>2))*DM+(wid>>2)*32+(lane&3)*8;
  const unsigned kdst=lds0+LDS_K+wid*1024, vdst=lds0+LDS_V+wid*1024;
  #define DMA_K(t,slot) glds16(ksrc+(long)(t)*KVBLK*DM,(unsigned)__builtin_amdgcn_readfirstlane(kdst+(slot)))
  #define DMA_V(t,slot) glds16(vsrc+(long)(t)*KVBLK*DM,(unsigned)__builtin_amdgcn_readfirstlane(vdst+(slot)))
  const int vb0=(int)(lds0+LDS_V)+((lane>>4)&1)*32+(lane&3)*8+(4*hi+((lane&15)>>2))*64;
  const char*Kbase=shm+LDS_K; bf16x8 kf[8];
  const lds_cptr shm3=(lds_cptr)shm; const lds_cptr kp0=shm3+LDS_K+hi*1024+r32*16; const lds_cptr vp0=shm3+LDS_V+((lane>>4)&1)*32+(lane&3)*8+(4*hi+((lane&15)>>2))*64;
  const int NT=(q0+QB)/KVBLK;
  { const f32x4_t bv_=*(const f32x4_t*)(NEGF+(long)(b*NHEAD+h)*SEQ+tid*4); *(__attribute__((address_space(3))) f32x4_t*)((__attribute__((address_space(3))) char*)shm+LDS_BIAS+tid*16)=bv_; }
  #define KBIAS(P0,P1,t) do{ const lds_cptr bq_=shm3+LDS_BIAS+((t)*64+4*hi)*4; \
    _Pragma("unroll") for(int j_=0;j_<4;++j_){ { const f32x4_t x0_=*(const __attribute__((address_space(3))) f32x4_t*)(bq_+32*j_); \
      P0[4*j_]+=x0_[0]-mhat;P0[4*j_+1]+=x0_[1]-mhat;P0[4*j_+2]+=x0_[2]-mhat;P0[4*j_+3]+=x0_[3]-mhat; } \
      { const f32x4_t x1_=*(const __attribute__((address_space(3))) f32x4_t*)(bq_+32*j_+128); \
      P1[4*j_]+=x1_[0]-mhat;P1[4*j_+1]+=x1_[1]-mhat;P1[4*j_+2]+=x1_[2]-mhat;P1[4*j_+3]+=x1_[3]-mhat; } } }while(0)
  DMA_K(0,0);DMA_V(0,0);DMA_K(1,SLOTB);
  bf16x8 qr[4];
  #pragma unroll
  for(int d0=0;d0<4;++d0)qr[d0]=*reinterpret_cast<const bf16x8*>(&Qw[(long)r32*DM+d0*16+hi*8]);
  float mhat=0.f,l_reg=0.f;f32x16 o[2];o[0]=f32x16{};o[1]=f32x16{};const f32x16 negm=f32x16{};
  const int qrel=wid*QBLK+r32;
  #define CMASK(P0,P1,t) do{int jb_=(t)-(NT-4); if(jb_>=0)cmask(P0,P1,jb_,qrel,hi);}while(0)
  bool resc=false;
  #define START(P0,P1) do{ const float rm=rowmax(P0,P1); resc=false; \
    { const float dl=rm; mhat=fadd_s(mhat,dl); \
      _Pragma("unroll") for(int r=0;r<16;++r){P0[r]=fsub_s(P0[r],dl);P1[r]=fsub_s(P1[r],dl);} \
       } \
    _Pragma("unroll") for(int r=0;r<16;++r)P0[r]=__builtin_amdgcn_exp2f(P0[r]); }while(0)
  #define RESC() do{ if(resc){ asm volatile("s_waitcnt lgkmcnt(0)":::"memory"); \
      _Pragma("unroll") for(int d_=0;d_<2;++d_) _Pragma("unroll") for(int r=0;r<16;++r)o[d_][r]*=wsf[crow(r,hi)]; } }while(0)
  f32x16 pA0,pA1,pB0,pB1;
  int sl_prev=0,sl_cur=0,sl_next=SLOTB;
  #define ROT() do{sl_prev=sl_cur;sl_cur=sl_next;sl_next=(sl_next==(NSLOT-1)*SLOTB)?0:sl_next+SLOTB;}while(0)
  DMA_K(2,2*SLOTB);
  WAIT_BAR(3);
  qkt(pA0,pA1,Kbase,qr,negm,r32,hi);asm volatile("s_nop 15\n\ts_nop 7":"+v"(pA0),"+v"(pA1));KBIAS(pA0,pA1,0);CMASK(pA0,pA1,0);
  START(pA0,pA1);
  _Pragma("unroll") for(int r=0;r<16;++r)pA1[r]=__builtin_amdgcn_exp2f(pA1[r]);
  WAIT_BAR(0);
  DMA_K(3,0);DMA_V(1,SLOTB);
  ROT();
  kload8(kf,kp0+sl_cur);
  WAIT_BAR(2);
  s16x4 vlo[8],vhi[8]; u32x4 pw0,pw1,pw2,pw3;
  #define PKW(P,B) cvtpk_s(P[B],P[B+1])
  #define PAF(k) __builtin_bit_cast(bf16x8,pw##k)
  #define VFR(i) (bf16x8){vlo[i][0],vlo[i][1],vlo[i][2],vlo[i][3],vhi[i][0],vhi[i][1],vhi[i][2],vhi[i][3]}
  #define PIN(x) asm volatile("":"+v"(x))
  #define MX3(a,b,c) __builtin_fmaxf(__builtin_fmaxf((a),(b)),(c))
  #define GAPA(MF,A0,A1,A2,A3,W0,W1,PW) do{ MF; sacc+=A0; sacc+=A1; sacc+=A2; sacc+=A3; PIN(sacc); W0; W1; PIN(PW); SBAR(); }while(0)
  #define EX(v) __builtin_amdgcn_exp2f(v)
  #define GAPB(MF,X,B) do{ MF; X[B]=EX(X[B]); X[B+1]=EX(X[B+1]); X[B+2]=EX(X[B+2]); X[B+3]=EX(X[B+3]); PIN(X); SBAR(); }while(0)
  #define VRD(i) do{ vlo[i]=vtr(vp_+(((i)>>2)*4096+((i)&3)*1024)); vhi[i]=vtr(vp_+(((i)>>2)*4096+((i)&3)*1024+512)); }while(0)
  #define KRD(G,j) do{ if(G){ kload2(kf,kp0+sl_next,j); SBAR(); } }while(0)
  #define STEP(C0,C1,P0,P1,t,GK,GV,GL) do{ SBAR(); \
    const lds_cptr vp_=vp0+sl_prev; \
    VRD(0); SBAR(); float sacc=(P0[0]+P0[1]); \
    GAPA(C0=__builtin_amdgcn_mfma_f32_32x32x16_bf16(kf[0],qr[0],negm,0,0,0), P0[2],P0[3],P0[4],P0[5],     pw0[0]=PKW(P0,0), pw0[1]=PKW(P0,2), pw0); \
    VRD(4); SBAR(); GAPA(C1=__builtin_amdgcn_mfma_f32_32x32x16_bf16(kf[1],qr[0],negm,0,0,0), P0[6],P0[7],P0[8],P0[9],     pw0[2]=PKW(P0,4), pw0[3]=PKW(P0,6), pw0); \
    VRD(1); SBAR(); GAPA(C0=__builtin_amdgcn_mfma_f32_32x32x16_bf16(kf[2],qr[1],C0,0,0,0),   P0[10],P0[11],P0[12],P0[13], pw1[0]=PKW(P0,8), pw1[1]=PKW(P0,10), pw1); \
    VRD(5); SBAR(); GAPA(C1=__builtin_amdgcn_mfma_f32_32x32x16_bf16(kf[3],qr[1],C1,0,0,0),   P0[14],P0[15],P1[0],P1[1],   pw1[2]=PKW(P0,12),pw1[3]=PKW(P0,14), pw1); \
    VRD(2); SBAR(); GAPA(C0=__builtin_amdgcn_mfma_f32_32x32x16_bf16(kf[4],qr[2],C0,0,0,0),   P1[2],P1[3],P1[4],P1[5],     pw2[0]=PKW(P1,0), pw2[1]=PKW(P1,2), pw2); \
    VRD(6); SBAR(); GAPA(C1=__builtin_amdgcn_mfma_f32_32x32x16_bf16(kf[5],qr[2],C1,0,0,0),   P1[6],P1[7],P1[8],P1[9],     pw2[2]=PKW(P1,4), pw2[3]=PKW(P1,6), pw2); \
    VRD(3); SBAR(); GAPA(C0=__builtin_amdgcn_mfma_f32_32x32x16_bf16(kf[6],qr[3],C0,0,0,0),   P1[10],P1[11],P1[12],P1[13], pw3[0]=PKW(P1,8), pw3[1]=PKW(P1,10), pw3); \
    VRD(7); SBAR(); GAPA(C1=__builtin_amdgcn_mfma_f32_32x32x16_bf16(kf[7],qr[3],C1,0,0,0),   P1[14],P1[15],0.f,0.f,       pw3[2]=PKW(P1,12),pw3[3]=PKW(P1,14), pw3); \
    l_reg+=sacc; \
    if(GK){DMA_K((t)+3,sl_cur);} if(GV){DMA_V((t)+1,sl_next);} \
    KBIAS(C0,C1,t); CMASK(C0,C1,t); \
    { float a=MX3(C0[0],C0[1],C1[0]),b=MX3(C0[2],C0[3],C1[1]); a=MX3(a,C1[2],C1[3]); \
      _Pragma("unroll") for(int r=4;r<16;r+=4){a=MX3(a,C0[r],C0[r+1]);b=MX3(b,C0[r+2],C0[r+3]);a=MX3(a,C1[r],C1[r+1]);b=MX3(b,C1[r+2],C1[r+3]);} \
      float rm=__builtin_fmaxf(a,b); { auto rr=__builtin_amdgcn_permlane32_swap(__float_as_uint(rm),__float_as_uint(rm),false,false); rm=__builtin_fmaxf(__uint_as_float(rr[0]),__uint_as_float(rr[1])); } \
      resc=false; \
      if(__builtin_expect(__any(rm>(float)THRL),0)){ const float dl=__builtin_fmaxf(rm,0.f); mhat+=dl; \
        _Pragma("unroll") for(int r=0;r<16;++r){C0[r]-=dl;C1[r]-=dl;} \
         \
        const float f=__builtin_amdgcn_exp2f(-dl); l_reg*=f; if(hi==0)wsf[r32]=f; resc=true; } } \
    SBAR(); \
    GAPB(o[0]=__builtin_amdgcn_mfma_f32_32x32x16_bf16(PAF(0),VFR(0),o[0],0,0,0), C0,0); \
    GAPB(o[1]=__builtin_amdgcn_mfma_f32_32x32x16_bf16(PAF(0),VFR(4),o[1],0,0,0), C0,4); \
    KRD(GL,0); GAPB(o[0]=__builtin_amdgcn_mfma_f32_32x32x16_bf16(PAF(1),VFR(1),o[0],0,0,0), C0,8); \
    KRD(GL,1); GAPB(o[1]=__builtin_amdgcn_mfma_f32_32x32x16_bf16(PAF(1),VFR(5),o[1],0,0,0), C0,12); \
    KRD(GL,2); GAPB(o[0]=__builtin_amdgcn_mfma_f32_32x32x16_bf16(PAF(2),VFR(2),o[0],0,0,0), C1,0); \
    KRD(GL,3); GAPB(o[1]=__builtin_amdgcn_mfma_f32_32x32x16_bf16(PAF(2),VFR(6),o[1],0,0,0), C1,4); \
    GAPB(o[0]=__builtin_amdgcn_mfma_f32_32x32x16_bf16(PAF(3),VFR(3),o[0],0,0,0), C1,8); \
    GAPB(o[1]=__builtin_amdgcn_mfma_f32_32x32x16_bf16(PAF(3),VFR(7),o[1],0,0,0), C1,12); \
    }while(0)
  int t=1;
  #undef CMASK
  #define CMASK(P0,P1,t) do{}while(0)
  for(;t+5<NT;t+=2){
    STEP(pB0,pB1,pA0,pA1,t,true,true,true);     WAIT_BAR(2); RESC(); ROT();
    STEP(pA0,pA1,pB0,pB1,t+1,true,true,true);   WAIT_BAR(2); RESC(); ROT();
  }
  #undef CMASK
  #define CMASK(P0,P1,t) do{int jb_=(t)-(NT-4); if(jb_>=0)cmask(P0,P1,jb_,qrel,hi);}while(0)
  #define ENDW(tt) do{ if((tt)+3<NT){WAIT_BAR(2);} else if((tt)+2<NT){WAIT_BAR(1);} else {WAIT_BAR(0);} }while(0)
  for(;t+1<NT;t+=2){
    STEP(pB0,pB1,pA0,pA1,t,(t+3<NT),(t+1<NT),(t+1<NT));       ENDW(t);   RESC(); ROT();
    STEP(pA0,pA1,pB0,pB1,t+1,(t+4<NT),(t+2<NT),(t+2<NT));     ENDW(t+1); RESC(); ROT();
  }
  STEP(pB0,pB1,pA0,pA1,NT-1,false,false,false); RESC();
  { float sacc=pB0[0]+pB0[1]; _Pragma("unroll") for(int r=2;r<16;++r)sacc+=pB0[r]; _Pragma("unroll") for(int r=0;r<16;++r)sacc+=pB1[r]; l_reg+=sacc;
    pw0=(u32x4){PKW(pB0,0),PKW(pB0,2),PKW(pB0,4),PKW(pB0,6)};pw1=(u32x4){PKW(pB0,8),PKW(pB0,10),PKW(pB0,12),PKW(pB0,14)};pw2=(u32x4){PKW(pB1,0),PKW(pB1,2),PKW(pB1,4),PKW(pB1,6)};pw3=(u32x4){PKW(pB1,8),PKW(pB1,10),PKW(pB1,12),PKW(pB1,14)};
    SBAR(); pv(o,vb0+sl_cur,PAF(0),PAF(1),PAF(2),PAF(3)); }
  #undef PKW
  #undef PAF
  #undef VFR
  #undef PIN
  #undef MX3
  #undef GAPA
  #undef GAPB
  #undef EX
  #undef VRD
  #undef KRD
  #undef STEP
  #undef ENDW
  {auto rr=__builtin_amdgcn_permlane32_swap(__float_as_uint(l_reg),__float_as_uint(l_reg),false,false);l_reg=__uint_as_float(rr[0])+__uint_as_float(rr[1]);}
  if(hi==0)wsf[32+r32]=l_reg;asm volatile("s_waitcnt lgkmcnt(0)":::"memory");
  float rli[16];
  #pragma unroll
  for(int r=0;r<16;++r)rli[r]=__builtin_amdgcn_rcpf(wsf[32+crow(r,hi)]);
  bf16*Ow=O+(rowbase+q0+wid*QBLK)*DM+h*D;
  { bf16*stg=(bf16*)(shm+LDS_OST)+wid*2048;
    #pragma unroll
    for(int r=0;r<16;++r){const int orow=crow(r,hi);
      #pragma unroll
      for(int d0=0;d0<2;++d0)stg[orow*64+d0*32+r32]=__float2bfloat16(o[d0][r]*rli[r]);}
    asm volatile("s_waitcnt lgkmcnt(0)":::"memory");
    #pragma unroll
    for(int i=0;i<4;++i){const int row=i*8+(lane>>3),ch=lane&7; const u32x4 v=*(const u32x4*)(stg+row*64+ch*8); ATTN_STORE16(Ow+(long)row*DM+ch*8,v);} }
  asm volatile("s_waitcnt lgkmcnt(0)\n\ts_barrier":::"memory");
  #undef KBIAS
  #undef DMA_K
  #undef DMA_V
  #undef CMASK
  #undef START
  #undef RESC
  #undef ROT
}
constexpr int ATTN_LDS_BYTES=LDS_BYTES;
struct AttnTensors { const bf16* Q; const bf16* K; const bf16* V; bf16* O; const float* NEGF; };
struct AttnUnit { int bh; int qb; };
struct StaticOrder {
  int c,G;
  __device__ __forceinline__ explicit StaticOrder(int grid,int block):c(block),G(grid){}
  __device__ __forceinline__ bool next(int i,AttnUnit&u)const{ const int bh=c+(i>>3)*G; if(bh>=BATCH*NHEAD)return false; u.bh=bh; u.qb=7-(i&7); return true; }
  __device__ __forceinline__ void a_ready(const AttnUnit&)const{}
  __device__ __forceinline__ void done(const AttnUnit&)const{}
};
template<class Sched,int THRL=8> __device__ __forceinline__ void attn_phase(char*lds,const AttnTensors&T,const Sched&S){
  AttnUnit u;
  for(int i=0;S.next(i,u);++i){ S.a_ready(u); attn_unit<THRL>(u.bh/NHEAD,u.bh%NHEAD,u.qb,T.Q,T.K,T.V,T.O,T.NEGF,lds); S.done(u); }
}
#undef SBAR
#undef WAIT_BAR
}
#define GAS __attribute__((address_space(1)))
#define LAS __attribute__((address_space(3)))
typedef unsigned short bf16;
typedef unsigned v4u __attribute__((ext_vector_type(4)));
typedef float f32x4 __attribute__((ext_vector_type(4)));
typedef short bf16x8 __attribute__((ext_vector_type(8)));
typedef GAS unsigned gu32;
typedef GAS unsigned long long gu64;
#define RLX_AGENT __ATOMIC_RELAXED, __HIP_MEMORY_SCOPE_AGENT
#define LDS_WAIT() asm volatile("s_waitcnt lgkmcnt(0)" ::: "memory")
#define VM_WAIT() asm volatile("s_waitcnt vmcnt(0)" ::: "memory")
__device__ __forceinline__ unsigned long long rt() { return __builtin_amdgcn_s_memrealtime(); }
__device__ __forceinline__ unsigned f2bf(float f) { unsigned u = __builtin_bit_cast(unsigned, f); return (u + 0x7fffu + ((u >> 16) & 1u)) >> 16; }
__device__ __forceinline__ unsigned pk2(float lo, float hi) { return f2bf(lo) | (f2bf(hi) << 16); }

#define XB_TMO      128
#define XB_XCNT(j)  (256  + 64 * (j))
#define XB_XSUB(j)  (1280 + 64 * (j))
#define XB_XGEN(j)  (2304 + 64 * (j))
#define XB_TOP      3328
#define XB_TOPGEN   3392
#define XCD_BAR_WORDS 3456
#define XB_SPIN_CAP (1u << 18)

__device__ __forceinline__ unsigned xb_ld(unsigned* p)              { return __hip_atomic_load(p, __ATOMIC_RELAXED, __HIP_MEMORY_SCOPE_AGENT); }
__device__ __forceinline__ unsigned xb_add(unsigned* p, unsigned v) { return __hip_atomic_fetch_add(p, v, __ATOMIC_RELAXED, __HIP_MEMORY_SCOPE_AGENT); }
__device__ __forceinline__ unsigned xb_xcc_id() { return (unsigned)__builtin_amdgcn_s_getreg((3 << 11) | 20) & 0xFu; }
#define XB_SPIN(cond, bar) do { unsigned _sp = 0; while (cond) { __builtin_amdgcn_s_sleep(1); \
    if ((++_sp & 255u) == 0u) { if (xb_ld(&(bar)[XB_TMO])) break; if (_sp > XB_SPIN_CAP) { atomicAdd(&(bar)[XB_TMO], 1u); break; } } } } while (0)

struct XcdBarrier {
    unsigned* bar; unsigned x;
    volatile LAS unsigned* st;
};

__device__ __forceinline__ XcdBarrier xcd_barrier_post(unsigned* bar, volatile LAS unsigned* st) {
    XcdBarrier b; b.bar = bar; b.x = xb_xcc_id(); b.st = st;
    if (threadIdx.x == 0) (void)xb_add(&bar[XB_XCNT(b.x)], 1u);
    return b;
}
__device__ __forceinline__ void xcd_barrier_complete(unsigned* bar, unsigned x, unsigned& nloc, unsigned& nx) {
    const unsigned G = gridDim.x * gridDim.y * gridDim.z;
    unsigned sum, cnt, mine, sp = 0u;
    for (;;) {
        sum = 0u; cnt = 0u; mine = 0u;
#pragma unroll
        for (unsigned j = 0; j < 16; ++j) { const unsigned c = xb_ld(&bar[XB_XCNT(j)]); sum += c; cnt += (c > 0u) ? 1u : 0u; mine = (j == x) ? c : mine; }
        if (sum == G) break;
        __builtin_amdgcn_s_sleep(1);
        if ((++sp & 255u) == 0u) { if (xb_ld(&bar[XB_TMO])) break; if (sp > XB_SPIN_CAP) { atomicAdd(&bar[XB_TMO], 1u); break; } }
    }
    nloc = mine > 0u ? mine : 1u; nx = cnt > 0u ? cnt : 1u;
}

__device__ __forceinline__ void xcd_barrier(const XcdBarrier& b) {
    asm volatile("s_waitcnt vmcnt(0)" ::: "memory");
    __syncthreads();
    if (threadIdx.x == 0) {
        unsigned* bar = b.bar;
        __builtin_amdgcn_s_waitcnt(0);
        unsigned nloc = b.st[0], nx = b.st[1];
        if (nloc == 0u) { xcd_barrier_complete(bar, b.x, nloc, nx); b.st[0] = nloc; b.st[1] = nx; }
        const unsigned old = xb_add(&bar[XB_XSUB(b.x)], 1u);
        const unsigned gen = old / nloc;
        if (old + 1u == (gen + 1u) * nloc) {
            __builtin_amdgcn_fence(__ATOMIC_RELEASE, "agent");
            asm volatile("s_waitcnt vmcnt(0)" ::: "memory");
            const unsigned og = xb_add(&bar[XB_TOP], 1u);
            const unsigned tg = og / nx;
            if (og + 1u == (tg + 1u) * nx) xb_add(&bar[XB_TOPGEN], 1u);
            else XB_SPIN(xb_ld(&bar[XB_TOPGEN]) == tg, bar);
            __builtin_amdgcn_fence(__ATOMIC_ACQUIRE, "agent");
            xb_add(&bar[XB_XGEN(b.x)], 1u);
            asm volatile("s_waitcnt vmcnt(0)" ::: "memory");
        } else {
            XB_SPIN(xb_ld(&bar[XB_XGEN(b.x)]) == gen, bar);
            __builtin_amdgcn_fence(__ATOMIC_ACQUIRE, "agent");
            asm volatile("s_waitcnt vmcnt(0)" ::: "memory");
        }
    }
    __syncthreads();
}
namespace cg = cooperative_groups;
constexpr int NWAVES = 8;
#ifndef MK_PER_PHASE
#define MK_PER_PHASE 0
#endif
#ifndef MK_USE_CG
#define MK_USE_CG 0
#endif
#ifndef MK_DUP_NG
#define MK_DUP_NG 1
#endif
#ifndef MK_DUP_G
#define MK_DUP_G 1
#endif
constexpr int BATCH = 16, T = 2048, D = 1024, FF = 4096, M = BATCH * T;
constexpr size_t MiB = 1u << 20;
constexpr size_t WS_CTL = 0, CTL_ZERO_BYTES = 32768  , WS_SSQA = 1 * MiB, WS_SSQB = 3 * MiB, WS_FLOG = 5 * MiB, WS_NEGF = 7 * MiB, WS_SV = 9 * MiB, WS_W = 10 * MiB,
                 WS_HB = 118 * MiB, WS_PB = 182 * MiB, WS_PP = 246 * MiB, WS_BIG = 310 * MiB, WS_END = 510 * MiB;
constexpr size_t ME = 1u << 20;
constexpr size_t W_S5IN = 0, W_S5GLU = 1 * ME, W_S5OUT = 3 * ME, W_S5STRIDE = 4 * ME, W_FOXIN = 8 * ME, W_FOXOUT = W_FOXIN + 3328 * 1024, W_GLAIN = W_FOXOUT + ME, W_GLAOUT = W_GLAIN + 3328 * 1024,
                 W_MLP1 = W_GLAOUT + ME, W_MLP2 = W_MLP1 + 4 * ME, W_MLPSTRIDE = 8 * ME, W_PLEG = W_MLP1 + 32 * ME, W_PLEP = W_PLEG + ME, W_PLESTRIDE = ME + ME / 4, W_TOTAL = W_PLEG + 4 * W_PLESTRIDE;
static_assert(W_TOTAL * 2 <= 108 * MiB, "weights region");
constexpr int CW_BAR = 4096;
constexpr int RING_OFF = 0, RING_BYTES = 131072, LDSCTL_OFF = RING_BYTES, MISC_OFF = LDSCTL_OFF + 320, LDS_BYTES = 147456;
constexpr float LOG2E = 1.4426950408889634f;
typedef unsigned u32x2g __attribute__((ext_vector_type(2)));

__device__ __forceinline__ float wave_sum(float v) {
#pragma unroll
    for (int o = 1; o < 64; o <<= 1) v += __shfl_xor(v, o);
    return v;
}
__device__ __forceinline__ float sigmoid_f(float x) { return 1.0f / (1.0f + __expf(-x)); }
__device__ __forceinline__ float log_sigmoid_f(float x) { return fminf(x, 0.f) - log1pf(__expf(-fabsf(x))); }
__device__ __forceinline__ float gelu_tanh_f(float x) { const float uu = 0.7978845608028654f * (x + 0.044715f * x * x * x); const float th = 1.0f - 2.0f / (__expf(2.0f * uu) + 1.0f); return 0.5f * x * (1.0f + th); }
typedef float f32x2c_ __attribute__((ext_vector_type(2))); typedef __bf16 bf16x2c_ __attribute__((ext_vector_type(2)));
__device__ __forceinline__ unsigned cvtpk_c(float lo, float hi) { const f32x2c_ v = {lo, hi}; return __builtin_bit_cast(unsigned, __builtin_convertvector(v, bf16x2c_)); }
__device__ __forceinline__ float bf_lo(unsigned w) { return __uint_as_float(w << 16); }
__device__ __forceinline__ float bf_hi(unsigned w) { return __uint_as_float(w & 0xffff0000u); }

__device__ __forceinline__ void transpose_item(const float* W, int K, int ldw, const float* gain, bf16* WT, int n0, int drow0, int k0, LAS float* scr, int lane) {
    f32x4 wv[8];
#pragma unroll
    for (int i = 0; i < 8; ++i) wv[i] = *(const GAS f32x4*)(W + (size_t)(k0 + 8 * i + (lane >> 3)) * ldw + n0 + (lane & 7) * 4);
#pragma unroll
    for (int i = 0; i < 8; ++i) { const int kk = 8 * i + (lane >> 3); const float gk = gain ? gain[k0 + kk] : 1.0f; LAS float* d = scr + kk * 33 + (lane & 7) * 4;
        d[0] = wv[i][0] * gk; d[1] = wv[i][1] * gk; d[2] = wv[i][2] * gk; d[3] = wv[i][3] * gk; }
    LDS_WAIT(); asm volatile("" ::: "memory");
    const int c = lane & 7;
#pragma unroll
    for (int j = 0; j < 4; ++j) { const int n = (lane >> 3) + 8 * j; const LAS float* s = scr + (8 * c) * 33 + n;
        v4u o; o.x = pk2(s[0 * 33], s[1 * 33]); o.y = pk2(s[2 * 33], s[3 * 33]); o.z = pk2(s[4 * 33], s[5 * 33]); o.w = pk2(s[6 * 33], s[7 * 33]);
        *(GAS v4u*)(WT + (size_t)(drow0 + n) * K + k0 + 8 * c) = o; }
    LDS_WAIT(); asm volatile("" ::: "memory");
}

__device__ __forceinline__ const float* ld_ptr(LAS unsigned long long* t, int i) { const unsigned long long v = t[i];
    const unsigned lo = __builtin_amdgcn_readfirstlane((unsigned)v), hi = __builtin_amdgcn_readfirstlane((unsigned)(v >> 32)); return (const float*)(const GAS float*)(((unsigned long long)hi << 32) | lo); }

__device__ __forceinline__ float reduce16(float (&v)[16], int lane) {
    { const bool hb5 = (lane & 32) != 0;
#pragma unroll
      for (int i = 0; i < 8; ++i) { const float snd = hb5 ? v[i] : v[i + 8], kp = hb5 ? v[i + 8] : v[i]; v[i] = kp + __shfl_xor(snd, 32); } }
    { const bool hb4 = (lane & 16) != 0;
#pragma unroll
      for (int i = 0; i < 4; ++i) { const float snd = hb4 ? v[i] : v[i + 4], kp = hb4 ? v[i + 4] : v[i]; v[i] = kp + __shfl_xor(snd, 16); } }
    { const bool hb3 = (lane & 8) != 0;
#pragma unroll
      for (int i = 0; i < 2; ++i) { const float snd = hb3 ? v[i] : v[i + 2], kp = hb3 ? v[i + 2] : v[i]; v[i] = kp + __shfl_xor(snd, 8); } }
    { const bool hb2 = (lane & 4) != 0; const float snd = hb2 ? v[0] : v[1], kp = hb2 ? v[1] : v[0]; v[0] = kp + __shfl_xor(snd, 4); }
    float tot = v[0]; tot += __shfl_xor(tot, 2); tot += __shfl_xor(tot, 1); return tot;
}
__device__ __forceinline__ void sv_pass(float (&acc)[16], LAS float* inT, const float* in, size_t in_stride, int K, const float* gain, const float* W, int ldw, int col, int tk, int KG, int lane, int wave) {
    for (int k0 = 0; k0 < K; k0 += 1024) {
        const int kc = (K - k0) < 1024 ? (K - k0) : 1024;
        __syncthreads();
        for (int rr = 0; rr < 2; ++rr) { const int r = 2 * wave + rr; const float* src = in + (size_t)r * in_stride + k0;
            f32x4 v[4]; float ss = 0.f;
#pragma unroll
            for (int i = 0; i < 4; ++i) { const int k4 = lane + 64 * i; v[i] = (f32x4){0.f, 0.f, 0.f, 0.f}; if (4 * k4 < kc) v[i] = *(const GAS f32x4*)(src + 4 * k4); ss += (v[i][0] * v[i][0] + v[i][1] * v[i][1]) + (v[i][2] * v[i][2] + v[i][3] * v[i][3]); }
            float sc = 1.f; if (gain) { ss = wave_sum(ss); sc = rsqrtf(ss * (1.0f / 1024.0f) + 1e-6f); }
#pragma unroll
            for (int i = 0; i < 4; ++i) { const int k4 = lane + 64 * i; if (4 * k4 < kc) { f32x4 g = (f32x4){1.f, 1.f, 1.f, 1.f}; if (gain) g = *(const GAS f32x4*)(gain + k0 + 4 * k4);
#pragma unroll
                for (int e = 0; e < 4; ++e) inT[(4 * k4 + e) * 16 + r] = v[i][e] * sc * g[e]; } } }
        __syncthreads();
#pragma unroll 4
        for (int k = tk; k < kc; k += KG) { const float w = W[(size_t)(k0 + k) * ldw + col]; const LAS f32x4* ip = (const LAS f32x4*)(inT + k * 16); const f32x4 a0 = ip[0], a1 = ip[1], a2 = ip[2], a3 = ip[3];
            acc[0] += w * a0[0]; acc[1] += w * a0[1]; acc[2] += w * a0[2]; acc[3] += w * a0[3]; acc[4] += w * a1[0]; acc[5] += w * a1[1]; acc[6] += w * a1[2]; acc[7] += w * a1[3];
            acc[8] += w * a2[0]; acc[9] += w * a2[1]; acc[10] += w * a2[2]; acc[11] += w * a2[3]; acc[12] += w * a3[0]; acc[13] += w * a3[1]; acc[14] += w * a3[2]; acc[15] += w * a3[3]; }
    }
}
__device__ __forceinline__ void sv_stage(LAS unsigned char* ldsl, int mode, int N, const float* in0, size_t st0, int K0, const float* gain0, const float* W0, int ldw0, int c00,
                                         const float* in1, size_t st1, int K1, const float* W1, int ldw1, int c01, const float* res, size_t rst, float* out, int ost, int tid, int lane, int wave, int G) {
    const int cw = N / 256, KG = 512 / cw, tc = tid % cw, tk = tid / cw;
    LAS float* inT = (LAS float*)ldsl; LAS float* red0 = inT + 16384; LAS float* red1 = inT + 24576;
    for (int cb = blockIdx.x; cb < 256; cb += G) { const int n0 = ((G == 256) ? ((cb & 7) << 5) + (cb >> 3) : cb) * cw;
        float a0[16], a1[16];
#pragma unroll
        for (int r = 0; r < 16; ++r) { a0[r] = 0.f; a1[r] = 0.f; }
        sv_pass(a0, inT, in0, st0, K0, gain0, W0, ldw0, c00 + n0 + tc, tk, KG, lane, wave);
        if (K1 > 0) sv_pass(a1, inT, in1, st1, K1, nullptr, W1, ldw1, c01 + n0 + tc, tk, KG, lane, wave);
        __syncthreads();
#pragma unroll
        for (int r = 0; r < 16; ++r) { red0[tid * 16 + r] = a0[r]; red1[tid * 16 + r] = a1[r]; }
        __syncthreads();
        if (tid < 16 * cw) { const int r = tid / cw, c = tid % cw; float s0 = 0.f, s1 = 0.f;
            for (int g = 0; g < KG; ++g) { s0 += red0[(g * cw + c) * 16 + r]; s1 += red1[(g * cw + c) * 16 + r]; }
            const int n = n0 + c; float o;
            if (mode == 0) o = s0; else if (mode == 1) o = res[(size_t)r * rst + n] + s0; else if (mode == 2) { const float t = fmaxf(s0, 0.f); o = t * t; }
            else if (mode == 3) o = s0 * sigmoid_f(s1); else o = res[(size_t)r * rst + n] + s1 * sigmoid_f(s0);
            out[(size_t)r * ost + n] = o; }
    }
    __syncthreads();
}
struct Args { const float* in[29]; float* out; unsigned char* ws; int ph_lo, ph_hi; };
constexpr int N_PHASES = 38;
enum { T_PROLOGUE = 0, T_INPROJ, T_MIX1, T_MIX2, T_OUTPROJ, T_UP0, T_DOWN0, T_UP1, T_DOWN1, T_PLE, T_FINAL };

__global__ void __launch_bounds__(NWAVES * 64, 2) trunk_fwd(Args args) {
    extern __shared__ __attribute__((aligned(16))) unsigned char lds[];
    LAS unsigned char* const ldsl = (LAS unsigned char*)lds;
    volatile LAS unsigned* MISC = (volatile LAS unsigned*)(ldsl + MISC_OFF);
    const int tid0 = threadIdx.x;
#define tid tid0
    for (int u = tid; u < (LDS_BYTES - LDSCTL_OFF) / 4; u += NWAVES * 64) ((LAS unsigned*)(ldsl + LDSCTL_OFF))[u] = 0u;
    __syncthreads();
    LAS unsigned long long* const ptab = (LAS unsigned long long*)(ldsl + LDSCTL_OFF + 64);
    if (tid == 0) {
#define PT_(i) ptab[i] = (unsigned long long)args.in[i];
        PT_(0) PT_(1) PT_(2) PT_(3) PT_(4) PT_(5) PT_(6) PT_(7) PT_(8) PT_(9) PT_(10) PT_(11) PT_(12) PT_(13) PT_(14) PT_(15) PT_(16) PT_(17) PT_(18) PT_(19) PT_(20) PT_(21) PT_(22) PT_(23) PT_(24) PT_(25) PT_(26) PT_(27) PT_(28)
        ptab[29] = (unsigned long long)args.ws; ptab[30] = (unsigned long long)args.out;
#undef PT_
    }
    __syncthreads();
#define INP(i) ld_ptr(ptab, (i))
#define ws ((unsigned char*)ld_ptr(ptab, 29))
#define h ((float*)ld_ptr(ptab, 30))
#define Wb ((bf16*)(ws + WS_W))
#define HB ((bf16*)(ws + WS_HB))
#define PB ((bf16*)(ws + WS_PB))
#define PP ((bf16*)(ws + WS_PP))
#define BIG ((bf16*)(ws + WS_BIG))
#define FLOG ((float*)(ws + WS_FLOG))
#define NEGF ((float*)(ws + WS_NEGF))
#if !MK_PER_PHASE
    cg::grid_group grid = cg::this_grid();
#if !MK_USE_CG
    XcdBarrier bar = xcd_barrier_post((unsigned*)(ws + WS_CTL) + CW_BAR, MISC + 8);
#endif
#endif
    (void)MISC;

#undef tid
    for (int ph = args.ph_lo; ph < args.ph_hi; ++ph) {
        int tid = tid0; asm volatile("" : "+v"(tid));
        const int lane = tid & 63, wave = __builtin_amdgcn_readfirstlane(tid >> 6);
        const int G = gridDim.x, gw = blockIdx.x * NWAVES + wave, NGW = G * NWAVES, gtid = blockIdx.x * (NWAVES * 64) + tid, NT = G * NWAVES * 64;
        int type, layer = 0;
        if (ph == 0) type = T_PROLOGUE; else if (ph >= 37) type = T_FINAL; else { layer = (ph - 1) / 9; type = T_INPROJ + (ph - 1) % 9; }
        const int mixer = layer % 3, jm = layer / 3;
#define SSQ_(k) ((float*)(ws + (((3 * layer + (k)) & 1) ? WS_SSQB : WS_SSQA)))
#define ssq0 SSQ_(0)
#define ssq1 SSQ_(1)
#define ssq2 SSQ_(2)
#define ssq3 SSQ_(3)


        for (int rep_ = 0; rep_ < (((type == T_MIX2 && mixer == 1) || type == T_FINAL) ? 1 : MK_DUP_NG); ++rep_) {
        if (rep_) __syncthreads();
        int tid_o = tid; asm volatile("" : "+v"(tid_o));
        { const int tid = tid_o, lane = tid & 63, wave = __builtin_amdgcn_readfirstlane(tid >> 6), gw = blockIdx.x * NWAVES + wave, gtid = blockIdx.x * (NWAVES * 64) + tid; (void)gtid; (void)gw; (void)lane;
        { const int sk = ph - 1;
          if (sk >= 0 && sk < 13) {
            float* const SVH0 = (float*)(ws + WS_SV); float* const SVH1 = SVH0 + 16384; float* const SVA = SVH0 + 32768; float* const SVB = SVH0 + 98304;
            const size_t XS = (size_t)T * D, PS = (size_t)T * 256;
            if (sk == 0) sv_stage(ldsl, 0, 1024, INP(0), XS, 1024, INP(2), INP(5), 1024, 0, nullptr, 0, 0, nullptr, 0, 0, nullptr, 0, SVA, 1024, tid, lane, wave, G);
            else if (sk == 1) {
                for (int item = gw; item < 1024; item += NGW) { const int b = item >> 6, g = item & 63, n = lane; const size_t gn = (size_t)g * 64 + n;
                    const float dt = expf(INP(8)[g]), lr = INP(6)[gn], li = INP(7)[gn];
                    const float mag = expf(lr * dt), are = mag * cosf(li * dt), aim = mag * sinf(li * dt), den = lr * lr + li * li, nr = are - 1.0f;
                    const float cre = (nr * lr + aim * li) / den, cim = (aim * lr - nr * li) / den;
                    float xre = 0.f, xim = 0.f; const float* uu = SVA + b * 1024 + g * 16;
#pragma unroll
                    for (int c = 0; c < 16; ++c) { const float br = INP(9)[gn * 16 + c], bi = INP(10)[gn * 16 + c]; xre += (cre * br - cim * bi) * uu[c]; xim += (cre * bi + cim * br) * uu[c]; }
                    float v[16];
#pragma unroll
                    for (int c = 0; c < 16; ++c) { const size_t ci = (size_t)g * 1024 + c * 64 + n; v[c] = INP(11)[ci] * xre - INP(12)[ci] * xim; }
                    const float tot = reduce16(v, lane);
                    const int ch = ((lane >> 5) & 1) * 8 + ((lane >> 4) & 1) * 4 + ((lane >> 3) & 1) * 2 + ((lane >> 2) & 1);
                    if ((lane & 3) == 0) SVB[b * 1024 + g * 16 + ch] = gelu_tanh_f(tot + INP(13)[g * 16 + ch] * uu[ch]); } }
            else if (sk == 2) sv_stage(ldsl, 3, 1024, SVB, 1024, 1024, nullptr, INP(14), 2048, 0, SVB, 1024, 1024, INP(14), 2048, 1024, nullptr, 0, SVA, 1024, tid, lane, wave, G);
            else if (sk == 3) sv_stage(ldsl, 1, 1024, SVA, 1024, 1024, nullptr, INP(15), 1024, 0, nullptr, 0, 0, nullptr, 0, 0, INP(0), XS, SVH1, 1024, tid, lane, wave, G);
            else if (sk == 4 || sk == 9) { const int L = (sk == 9); sv_stage(ldsl, 2, 4096, L ? SVH0 : SVH1, 1024, 1024, INP(3) + L * 1024, INP(24) + (size_t)L * 4 * ME, 4096, 0, nullptr, 0, 0, nullptr, 0, 0, nullptr, 0, SVA, 4096, tid, lane, wave, G); }
            else if (sk == 5 || sk == 10) { const int L = (sk == 10); sv_stage(ldsl, 1, 1024, SVA, 4096, 4096, nullptr, INP(25) + (size_t)L * 4 * ME, 1024, 0, nullptr, 0, 0, nullptr, 0, 0, L ? SVH0 : SVH1, 1024, L ? SVH1 : SVH0, 1024, tid, lane, wave, G); }
            else if (sk == 6 || sk == 11) { const int L = (sk == 11); const float* hin = L ? SVH1 : SVH0;
                sv_stage(ldsl, 4, 1024, hin, 1024, 1024, INP(4) + L * 1024, INP(27) + (size_t)L * ME, 1024, 0, INP(1) + (size_t)L * M * 256, PS, 256, INP(26) + (size_t)L * (ME / 4), 1024, 0, hin, 1024, L ? SVH0 : SVH1, 1024, tid, lane, wave, G); }
            else if (sk == 7) sv_stage(ldsl, 0, 1024, SVH1, 1024, 1024, INP(2) + 1024, INP(16), 3088, 2048, nullptr, 0, 0, nullptr, 0, 0, nullptr, 0, SVA, 1024, tid, lane, wave, G);
            else if (sk == 8) sv_stage(ldsl, 1, 1024, SVA, 1024, 1024, nullptr, INP(18), 1024, 0, nullptr, 0, 0, nullptr, 0, 0, SVH1, 1024, SVH0, 1024, tid, lane, wave, G);
            else if (sk == 12) sv_stage(ldsl, 0, 1024, SVH0, 1024, 1024, INP(2) + 2 * 1024, INP(19), 3088, 0, nullptr, 0, 0, nullptr, 0, 0, nullptr, 0, SVA, 1024, tid, lane, wave, G);
          } }
        if (type == T_PROLOGUE) {
            LAS float* scr = (LAS float*)(ldsl + RING_OFF + wave * 16384);
            for (int gi = gw; gi < 27136 + 512; gi += NGW) {
                int mi, it;
                if (gi < 4096) { const int j = gi >> 11, r = gi & 2047; const int w = (r < 512) ? 0 : (r < 1536) ? 1 : 2; mi = 3 * j + w; it = r - ((w == 0) ? 0 : (w == 1) ? 512 : 1536); }
                else if (gi < 8192) { const int r = gi - 4096; if (r < 1536) { mi = 6; it = r; } else if (r < 2048) { mi = 7; it = r - 1536; } else if (r < 3584) { mi = 8; it = r - 2048; } else { mi = 9; it = r - 3584; } }
                else if (gi < 16384) { mi = 10 + ((gi - 8192) >> 11); it = (gi - 8192) & 2047; }
                else if (gi < 24576) { mi = 14 + ((gi - 16384) >> 11); it = (gi - 16384) & 2047; }
                else if (gi < 26624) { mi = 18 + ((gi - 24576) >> 9); it = (gi - 24576) & 511; }
                else if (gi < 27136) { mi = 22 + ((gi - 26624) >> 7); it = (gi - 26624) & 127; }
                else { mi = (gi - 27136 < 256) ? 6 : 8; it = -1 - ((gi - 27136) & 255); }
                const float* src; int K = 1024, ldw = 1024, ncols = 1024, glu = 0; const float* gain = nullptr; bf16* dst;
                if (mi < 6) { const int j = mi / 3, w = mi % 3;
                    if (w == 0) { src = INP(5) + (size_t)j * ME; gain = INP(2) + (size_t)(3 * j) * 1024; dst = Wb + W_S5IN + j * W_S5STRIDE; }
                    else if (w == 1) { src = INP(14) + (size_t)j * 2 * ME; ldw = 2048; ncols = 2048; glu = 1; dst = Wb + W_S5GLU + j * W_S5STRIDE; }
                    else { src = INP(15) + (size_t)j * ME; dst = Wb + W_S5OUT + j * W_S5STRIDE; } }
                else if (mi == 6) { src = INP(16); ldw = 3088; ncols = 3072; gain = INP(2) + 1 * 1024; dst = Wb + W_FOXIN; }
                else if (mi == 7) { src = INP(18); dst = Wb + W_FOXOUT; }
                else if (mi == 8) { src = INP(19); ldw = 3088; ncols = 3072; gain = INP(2) + 2 * 1024; dst = Wb + W_GLAIN; }
                else if (mi == 9) { src = INP(23); dst = Wb + W_GLAOUT; }
                else if (mi < 14) { const int i = mi - 10; src = INP(24) + (size_t)i * 4 * ME; ldw = 4096; ncols = 4096; gain = INP(3) + (size_t)i * 1024; dst = Wb + W_MLP1 + i * W_MLPSTRIDE; }
                else if (mi < 18) { const int i = mi - 14; src = INP(25) + (size_t)i * 4 * ME; K = 4096; dst = Wb + W_MLP2 + i * W_MLPSTRIDE; }
                else if (mi < 22) { const int i = mi - 18; src = INP(27) + (size_t)i * ME; gain = INP(4) + (size_t)i * 1024; dst = Wb + W_PLEG + i * W_PLESTRIDE; }
                else { const int i = mi - 22; src = INP(26) + (size_t)i * (ME / 4); K = 256; dst = Wb + W_PLEP + i * W_PLESTRIDE; }
                const int nblk = ncols / 32;
                if (it >= 0) { const int kb = it / nblk, nb = it % nblk, n0 = 32 * nb; int drow0 = n0;
                    if (glu) { const int c = n0 & 1023; drow0 = 256 * (c >> 7) + (c & 127) + ((n0 >= 1024) ? 128 : 0); }
                    transpose_item(src, K, ldw, gain, dst, n0, drow0, 64 * kb, scr, lane); }
                else { const int n = 3072 + (-1 - it);
#pragma unroll 4
                    for (int k = lane; k < 1024; k += 64) { const float v = (n < 3088) ? src[(size_t)k * 3088 + n] * gain[k] : 0.f; dst[(size_t)n * 1024 + k] = (bf16)f2bf(v); } }
            }
            float* ssqA = (float*)(ws + WS_SSQA);
            for (int m = gw; m < M; m += NGW) {
                const GAS f32x4* xr = (const GAS f32x4*)(INP(0) + (size_t)m * D) + lane; f32x4 v[4]; float s = 0.f;
#pragma unroll
                for (int j = 0; j < 4; ++j) { v[j] = xr[64 * j]; s += (v[j].x * v[j].x + v[j].y * v[j].y) + (v[j].z * v[j].z + v[j].w * v[j].w); }
                s = wave_sum(s);
                GAS unsigned long long* o8 = (GAS unsigned long long*)(PB + (size_t)m * D) + lane;
#pragma unroll
                for (int j = 0; j < 4; ++j) o8[64 * j] = (unsigned long long)pk2(v[j].x, v[j].y) | ((unsigned long long)pk2(v[j].z, v[j].w) << 32);
                if (lane < 16) ssqA[(size_t)m * 16 + lane] = (lane == 0) ? s : 0.f;
            }
        }
        else if (type == T_MIX1 && mixer == 0) {
            {
                const int q = wave & 3; const bool helper = wave >= 4;
                LAS float* xs = (LAS float*)(ldsl + q * 25664);
                LAS unsigned short* ssb = (LAS unsigned short*)(ldsl + q * 25664 + 16896);
                volatile LAS unsigned* fl = (volatile LAS unsigned*)(ldsl + q * 25664 + 25600);
                const bf16* U = BIG; bf16* Y = BIG + (size_t)32 * ME;
                const int fr = lane & 15, fq = lane >> 4;
                typedef float f32x2s __attribute__((ext_vector_type(2)));
#define S5_WAIT(idx, target) { while ((int)fl[idx] < (int)(target)) __builtin_amdgcn_s_sleep(1); asm volatile("" ::: "memory"); }
#define S5_POST(idx, val) { asm volatile("s_waitcnt lgkmcnt(0)" ::: "memory"); if (lane == 0) fl[idx] = (unsigned)(val); }
                for (int pair = blockIdx.x * 4 + q; pair < 1024; pair += G * 4) {
                    const int b = pair >> 6, g = pair & 63;
                    __syncthreads();
                    if (!helper && lane == 0) { fl[0] = 0u; fl[1] = 0u; fl[2] = 0u; }
                    __syncthreads();
                    const float dt = expf(INP(8)[jm * 64 + g]);
                    if (!helper) {
                        float are, aim;
                        { const size_t gn = (size_t)jm * 4096 + g * 64 + lane; const float lr = INP(6)[gn], li = INP(7)[gn], mag = expf(lr * dt); are = mag * cosf(li * dt); aim = mag * sinf(li * dt); }
                        float sre = 0.f, sim = 0.f;
#pragma unroll 1
                        for (int blk = 0; blk < 128; ++blk) {
                            S5_WAIT(0, blk + 1) S5_WAIT(2, blk - 1)
                            const LAS float* xrd = xs + (blk & 1) * 2112; LAS unsigned* sw = (LAS unsigned*)(ssb + (blk & 1) * 2176);
                            f32x2s xv[16];
#pragma unroll
                            for (int s = 0; s < 16; ++s) xv[s] = *(const LAS f32x2s*)(xrd + s * 132 + 2 * lane);
#pragma unroll
                            for (int s = 0; s < 16; ++s) { const float nre = are * sre - aim * sim + xv[s].x, nim = are * sim + aim * sre + xv[s].y; sre = nre; sim = nim;
                                sw[s * 68 + lane] = cvtpk_c(sre, sim); }
                            S5_POST(1, blk + 1)
                        }
                    } else {
                        bf16x8 bfr[8];
#pragma unroll
                    for (int j = 0; j < 8; ++j) {
                        const size_t gn = (size_t)jm * 4096 + g * 64 + 8 * j + (fr >> 1); const float lr = INP(6)[gn], li = INP(7)[gn];
                        const float mag = expf(lr * dt), ar = mag * cosf(li * dt), ai = mag * sinf(li * dt), den = lr * lr + li * li, nr = ar - 1.0f;
                        const float cre = (nr * lr + ai * li) / den, cim = (ai * lr - nr * li) / den;
                        const float ca = (fr & 1) ? cim : cre, cb = (fr & 1) ? cre : -cim;
                        unsigned w4[4] = {0u, 0u, 0u, 0u};
                        if (fq < 2) { const f32x4 b0 = *(const GAS f32x4*)(INP(9) + gn * 16 + 8 * fq), b1 = *(const GAS f32x4*)(INP(9) + gn * 16 + 8 * fq + 4), i0 = *(const GAS f32x4*)(INP(10) + gn * 16 + 8 * fq), i1 = *(const GAS f32x4*)(INP(10) + gn * 16 + 8 * fq + 4);
                            w4[0] = pk2(ca * b0[0] + cb * i0[0], ca * b0[1] + cb * i0[1]); w4[1] = pk2(ca * b0[2] + cb * i0[2], ca * b0[3] + cb * i0[3]);
                            w4[2] = pk2(ca * b1[0] + cb * i1[0], ca * b1[1] + cb * i1[1]); w4[3] = pk2(ca * b1[2] + cb * i1[2], ca * b1[3] + cb * i1[3]); }
                        bfr[j] = __builtin_bit_cast(bf16x8, (v4u){w4[0], w4[1], w4[2], w4[3]}); }
                    bf16x8 cfr[4];
#pragma unroll
                    for (int kk = 0; kk < 4; ++kk) { const size_t cb = ((size_t)jm * 64 + g) * 1024 + fr * 64 + 16 * kk + 4 * fq;
                        const f32x4 c0 = *(const GAS f32x4*)(INP(11) + cb), c1 = *(const GAS f32x4*)(INP(12) + cb);
                        cfr[kk] = __builtin_bit_cast(bf16x8, (v4u){pk2(c0[0], -c1[0]), pk2(c0[1], -c1[1]), pk2(c0[2], -c1[2]), pk2(c0[3], -c1[3])}); }
                    bf16x8 dfr;
                    { const float dv = INP(13)[jm * 1024 + g * 16 + fr]; unsigned dw[4] = {0u, 0u, 0u, 0u};
                      if (fq < 2 && (fr >> 3) == fq) { const int e = fr & 7; dw[e >> 1] = (e & 1) ? (f2bf(dv) << 16) : f2bf(dv); }
                      dfr = __builtin_bit_cast(bf16x8, (v4u){dw[0], dw[1], dw[2], dw[3]}); }

                        const bf16* up = U + (size_t)(b * T) * D + g * 16 + 8 * fq;
                        v4u ur0 = (v4u){0u, 0u, 0u, 0u}, ur1 = ur0, ur2 = ur0, ur3 = ur0;
                        if (fq < 2) { ur0 = *(const GAS v4u*)(up + (size_t)fr * D); ur1 = *(const GAS v4u*)(up + (size_t)(16 + fr) * D); ur2 = *(const GAS v4u*)(up + (size_t)(32 + fr) * D); ur3 = *(const GAS v4u*)(up + (size_t)(48 + fr) * D); }
                        bf16x8 u0 = __builtin_bit_cast(bf16x8, (v4u){0u, 0u, 0u, 0u}), u1 = u0;
#define S5_HSTEP(J, UR) { const int blk = i4 + (J); u1 = u0; u0 = __builtin_bit_cast(bf16x8, UR); \
                            if (blk + 4 < 128 && fq < 2) UR = *(const GAS v4u*)(up + (size_t)((blk + 4) * 16 + fr) * D); \
                            if (blk < 128) { S5_WAIT(1, blk - 1) LAS float* xw = xs + (blk & 1) * 2112; \
_Pragma("unroll") \
                                for (int nt = 0; nt < 8; ++nt) { const f32x4 xd = __builtin_amdgcn_mfma_f32_16x16x32_bf16(bfr[nt], u0, (f32x4){0.f, 0.f, 0.f, 0.f}, 0, 0, 0); \
                                    *(LAS f32x4*)(xw + fr * 132 + 16 * nt + 4 * fq) = xd; } \
                                S5_POST(0, blk + 1) } \
                            if (blk >= 1 && blk <= 128) { S5_WAIT(1, blk) const LAS unsigned short* srd = ssb + ((blk - 1) & 1) * 2176; bf16x8 af[4]; \
_Pragma("unroll") \
                                for (int kk = 0; kk < 4; ++kk) af[kk] = *(const LAS bf16x8*)(srd + fr * 136 + 32 * kk + 8 * fq); \
                                S5_POST(2, blk) \
                                f32x4 ya = (f32x4){0.f, 0.f, 0.f, 0.f}; \
_Pragma("unroll") \
                                for (int kk = 0; kk < 4; ++kk) ya = __builtin_amdgcn_mfma_f32_16x16x32_bf16(cfr[kk], af[kk], ya, 0, 0, 0); \
                                ya = __builtin_amdgcn_mfma_f32_16x16x32_bf16(dfr, u1, ya, 0, 0, 0); \
                                float go[4]; \
_Pragma("unroll") \
                                for (int e = 0; e < 4; ++e) { const float yv = ya[e], uu2 = -2.0f * LOG2E * 0.7978845608028654f * (yv + 0.044715f * yv * yv * yv); go[e] = yv * __builtin_amdgcn_rcpf(1.0f + __builtin_amdgcn_exp2f(uu2)); } \
                                { u32x2g w; w.x = cvtpk_c(go[0], go[1]); w.y = cvtpk_c(go[2], go[3]); *(GAS u32x2g*)(Y + (size_t)(b * T + (blk - 1) * 16 + fr) * D + g * 16 + 4 * fq) = w; } } }
#pragma unroll 1
                        for (int i4 = 0; i4 < 132; i4 += 4) { S5_HSTEP(0, ur0) S5_HSTEP(1, ur1) S5_HSTEP(2, ur2) S5_HSTEP(3, ur3) }
#undef S5_HSTEP
                    }
                }
#undef S5_WAIT
#undef S5_POST
            }
        }
        else if (type == T_MIX1 && mixer == 1) {
            if (wave == 0) {
                for (int pair = blockIdx.x; pair < 256; pair += G) { const int b = pair >> 4, hh = pair & 15; const float bf = INP(17)[jm * 16 + hh];
                    float c[32]; float run = 0.f;
#pragma unroll
                    for (int i = 0; i < 32; ++i) { const float x = FLOG[(size_t)(b * T + 32 * lane + i) * 16 + hh] + bf; run += log_sigmoid_f(x); c[i] = run; }
                    float incl = run;
#pragma unroll
                    for (int o = 1; o < 64; o <<= 1) { const float nb = __shfl_up(incl, o); if (lane >= o) incl += nb; }
                    const float excl = incl - run;
#pragma unroll
                    for (int i = 0; i < 32; ++i) NEGF[(size_t)pair * T + 32 * lane + i] = -(c[i] + excl) * LOG2E;
                }
            }
        }
        else if (type == T_MIX2 && mixer == 1) {
            const attn_body::AttnTensors AT{(const attn_body::bf16*)BIG, (const attn_body::bf16*)(BIG + 32 * ME), (const attn_body::bf16*)(BIG + 64 * ME), (attn_body::bf16*)BIG, NEGF};
            const attn_body::StaticOrder S((int)G, (int)blockIdx.x);
            attn_body::attn_phase<attn_body::StaticOrder>((char*)lds + RING_OFF, AT, S);
        }
        else if (type == T_MIX1 && mixer == 2) {
            constexpr int PQD = 136, PSS = 72;
            LAS unsigned short* QD = (LAS unsigned short*)ldsl; LAS unsigned short* KI = QD + 64 * PQD; LAS unsigned short* KUT = KI + 64 * PQD; LAS unsigned short* VT = KUT + 128 * PSS;
            LAS unsigned short* ST = VT + 64 * PSS; LAS unsigned short* ATT = ST + 64 * PQD; LAS float* EB = (LAS float*)(ATT + 64 * PSS); LAS float* PS = EB + 128; LAS float* pq = PS + 512; LAS float* GLs = pq + 256;
            const bf16* QKV = BIG; bf16* OB = PP;
            const int fr = lane & 15, fq = lane >> 4, kk = tid & 127, tq = tid >> 7;
            for (int unit = blockIdx.x; unit < 256; unit += G) {
                const int b = unit >> 4, hh = (unit >> 2) & 3, vsp = unit & 3;
                __syncthreads();
                float wgr[16];
#pragma unroll
                for (int j = 0; j < 16; ++j) wgr[j] = INP(20)[(size_t)jm * 16 * 512 + j * 512 + hh * 128 + kk];
                const float bgr = INP(21)[jm * 512 + hh * 128 + kk];
                if (tid < 256) pq[tid] = ((const float*)(ws + WS_SV) + 32768)[b * 1024 + (tid < 128 ? hh * 128 + tid : 512 + hh * 128 + (tid - 128))];
                for (int i = tid; i < 64 * PQD / 2; i += 512) ((LAS unsigned*)ST)[i] = 0u;
                __syncthreads();
                float c_exact = 0.f;
                if (wave == 0) c_exact = wave_sum(pq[lane] * pq[128 + lane] + pq[64 + lane] * pq[192 + lane]) * 0.08838834764831845f;
                f32x4 Sacc[4];
#pragma unroll
                for (int nt = 0; nt < 4; ++nt) Sacc[nt] = (f32x4){0.f, 0.f, 0.f, 0.f};
                unsigned short qh[16], kh[16]; v4u vreg; f32x4 greg = (f32x4){0.f, 0.f, 0.f, 0.f};
                { const size_t m0 = (size_t)b * T;
#pragma unroll
                  for (int i = 0; i < 16; ++i) { const bf16* rp = QKV + (m0 + 16 * tq + i) * 3072 + hh * 128 + kk; qh[i] = rp[0]; kh[i] = rp[512]; }
                  vreg = *(const GAS v4u*)(QKV + (m0 + (tid >> 3)) * 3072 + 1024 + hh * 256 + vsp * 64 + (tid & 7) * 8);
                  if (tid < 256) greg = *(const GAS f32x4*)(FLOG + (m0 + (tid >> 2)) * 16 + (tid & 3) * 4); }
                for (int c = 0; c < 32; ++c) {
                    const size_t mb = (size_t)b * T + c * 64;
                    if (tid < 256) *(LAS f32x4*)(GLs + tid * 4) = greg;
                    __syncthreads();
                    float bc[16]; float run = 0.f;
#pragma unroll
                    for (int i = 0; i < 16; ++i) { const LAS f32x4* gp = (const LAS f32x4*)(GLs + (16 * tq + i) * 16); const f32x4 g0 = gp[0], g1 = gp[1], g2 = gp[2], g3 = gp[3];
                        float x = bgr;
                        x += g0[0] * wgr[0] + g0[1] * wgr[1] + g0[2] * wgr[2] + g0[3] * wgr[3]; x += g1[0] * wgr[4] + g1[1] * wgr[5] + g1[2] * wgr[6] + g1[3] * wgr[7];
                        x += g2[0] * wgr[8] + g2[1] * wgr[9] + g2[2] * wgr[10] + g2[3] * wgr[11]; x += g3[0] * wgr[12] + g3[1] * wgr[13] + g3[2] * wgr[14] + g3[3] * wgr[15];
                        run -= __builtin_amdgcn_logf(1.0f + __builtin_amdgcn_exp2f(-x * LOG2E)) * (0.6931471805599453f / 16.0f); bc[i] = run; }
                    PS[tq * 128 + kk] = run;
                    __syncthreads();
                    const float p0 = PS[kk], p1 = PS[128 + kk], p2 = PS[256 + kk], p3 = PS[384 + kk];
                    const float off = (tq > 0 ? p0 : 0.f) + (tq > 1 ? p1 : 0.f) + (tq > 2 ? p2 : 0.f), blast = (p0 + p1) + (p2 + p3);
                    if (tq == 0) EB[kk] = __builtin_amdgcn_exp2f(blast * LOG2E);
                    const float ebl = __builtin_amdgcn_exp2f(blast * LOG2E);
                    float kuv[16];
#pragma unroll
                    for (int i = 0; i < 16; ++i) { const int t = 16 * tq + i; const float bcu = bc[i] + off, e1 = __builtin_amdgcn_exp2f(bcu * LOG2E), ie1 = __builtin_amdgcn_rcpf(e1), qv = __uint_as_float((unsigned)qh[i] << 16), kv = __uint_as_float((unsigned)kh[i] << 16);
                        const float ki = kv * ie1;
                        const unsigned pk = cvtpk_c(qv * 0.08838834764831845f * e1, ki); QD[t * PQD + kk] = (unsigned short)pk; KI[t * PQD + kk] = (unsigned short)(pk >> 16);
                        kuv[i] = ki * ebl; }
                    { v4u w0, w1; w0.x = cvtpk_c(kuv[0], kuv[1]); w0.y = cvtpk_c(kuv[2], kuv[3]); w0.z = cvtpk_c(kuv[4], kuv[5]); w0.w = cvtpk_c(kuv[6], kuv[7]); w1.x = cvtpk_c(kuv[8], kuv[9]); w1.y = cvtpk_c(kuv[10], kuv[11]); w1.z = cvtpk_c(kuv[12], kuv[13]); w1.w = cvtpk_c(kuv[14], kuv[15]);
                      *(LAS v4u*)(KUT + kk * PSS + 16 * tq) = w0; *(LAS v4u*)(KUT + kk * PSS + 16 * tq + 8) = w1; }
                    { const int s = tid >> 3, v8 = (tid & 7) * 8; const unsigned w4[4] = {vreg.x, vreg.y, vreg.z, vreg.w};
#pragma unroll
                      for (int e = 0; e < 8; ++e) VT[(v8 + e) * PSS + s] = (unsigned short)((e & 1) ? (w4[e >> 1] >> 16) : (w4[e >> 1] & 0xffffu)); }
                    if (c + 1 < 32) { const size_t m1 = mb + 64;
#pragma unroll
                        for (int i = 0; i < 16; ++i) { const bf16* rp = QKV + (m1 + 16 * tq + i) * 3072 + hh * 128 + kk; qh[i] = rp[0]; kh[i] = rp[512]; }
                        vreg = *(const GAS v4u*)(QKV + (m1 + (tid >> 3)) * 3072 + 1024 + hh * 256 + vsp * 64 + (tid & 7) * 8);
                        if (tid < 256) greg = *(const GAS f32x4*)(FLOG + (m1 + (tid >> 2)) * 16 + (tid & 3) * 4); }
                    __syncthreads();
                    { const int mt = wave >> 1;
#pragma unroll
                      for (int n2 = 0; n2 < 2; ++n2) { const int nt = 2 * (wave & 1) + n2; f32x4 acc = (f32x4){0.f, 0.f, 0.f, 0.f};
                          if (nt <= mt) {
#pragma unroll
                              for (int k4 = 0; k4 < 4; ++k4) { const bf16x8 a = *(const LAS bf16x8*)(QD + (16 * mt + fr) * PQD + 32 * k4 + 8 * fq), bb = *(const LAS bf16x8*)(KI + (16 * nt + fr) * PQD + 32 * k4 + 8 * fq);
                                  acc = __builtin_amdgcn_mfma_f32_16x16x32_bf16(a, bb, acc, 0, 0, 0); }
                              if (nt == mt) {
#pragma unroll
                                  for (int e = 0; e < 4; ++e) if (fr > 4 * fq + e) acc[e] = 0.f; }
                              if (c == 0 && mt == 0 && nt == 0 && lane == 0) acc[0] = c_exact; }
                          { const unsigned p01 = cvtpk_c(acc[0], acc[1]), p23 = cvtpk_c(acc[2], acc[3]); unsigned short* dummy_ = nullptr; (void)dummy_;
                            ATT[(16 * mt + 4 * fq + 0) * PSS + 16 * nt + fr] = (unsigned short)p01; ATT[(16 * mt + 4 * fq + 1) * PSS + 16 * nt + fr] = (unsigned short)(p01 >> 16);
                            ATT[(16 * mt + 4 * fq + 2) * PSS + 16 * nt + fr] = (unsigned short)p23; ATT[(16 * mt + 4 * fq + 3) * PSS + 16 * nt + fr] = (unsigned short)(p23 >> 16); } } }
                    __syncthreads();
                    { const int mt = wave >> 1;
#pragma unroll
                      for (int n2 = 0; n2 < 2; ++n2) { const int nt = 2 * (wave & 1) + n2; f32x4 acc = (f32x4){0.f, 0.f, 0.f, 0.f};
#pragma unroll
                          for (int ks = 0; ks < 2; ++ks) { const bf16x8 a = *(const LAS bf16x8*)(ATT + (16 * mt + fr) * PSS + 32 * ks + 8 * fq), bb = *(const LAS bf16x8*)(VT + (16 * nt + fr) * PSS + 32 * ks + 8 * fq);
                              acc = __builtin_amdgcn_mfma_f32_16x16x32_bf16(a, bb, acc, 0, 0, 0); }
#pragma unroll
                          for (int k4 = 0; k4 < 4; ++k4) { const bf16x8 a = *(const LAS bf16x8*)(QD + (16 * mt + fr) * PQD + 32 * k4 + 8 * fq), bb = *(const LAS bf16x8*)(ST + (16 * nt + fr) * PQD + 32 * k4 + 8 * fq);
                              acc = __builtin_amdgcn_mfma_f32_16x16x32_bf16(a, bb, acc, 0, 0, 0); }
                          { const unsigned p01 = cvtpk_c(acc[0], acc[1]), p23 = cvtpk_c(acc[2], acc[3]); bf16* op = OB + (mb + 16 * mt + 4 * fq) * D + hh * 256 + vsp * 64 + 16 * nt + fr;
                            op[0] = (bf16)p01; op[D] = (bf16)(p01 >> 16); op[2 * D] = (bf16)p23; op[3 * D] = (bf16)(p23 >> 16); } } }
                    { const int mt = wave;
                      const f32x4 ebv = *(const LAS f32x4*)(EB + 16 * mt + 4 * fq);
#pragma unroll
                      for (int nt = 0; nt < 4; ++nt) { f32x4 acc = Sacc[nt] * ebv;
#pragma unroll
                          for (int ks = 0; ks < 2; ++ks) { const bf16x8 a = *(const LAS bf16x8*)(KUT + (16 * mt + fr) * PSS + 32 * ks + 8 * fq), bb = *(const LAS bf16x8*)(VT + (16 * nt + fr) * PSS + 32 * ks + 8 * fq);
                              acc = __builtin_amdgcn_mfma_f32_16x16x32_bf16(a, bb, acc, 0, 0, 0); }
                          Sacc[nt] = acc; } }
                    __syncthreads();
                    { const int mt = wave;
#pragma unroll
                      for (int nt = 0; nt < 4; ++nt) { u32x2g w; w.x = cvtpk_c(Sacc[nt][0], Sacc[nt][1]); w.y = cvtpk_c(Sacc[nt][2], Sacc[nt][3]); *(LAS u32x2g*)(ST + (16 * nt + fr) * PQD + 16 * mt + 4 * fq) = w; } }
                }
            }
        }
        else if (type == T_MIX2 && mixer == 2) {
            const bf16* OB = PP; const bf16* R = BIG + 2048; bf16* AO = PP;
            for (int it = gw; it < M * 4; it += NGW) { const size_t m = (size_t)(it >> 2); const int hh = it & 3, col = hh * 256 + 4 * lane;
                const u32x2g ow = *(const GAS u32x2g*)(OB + m * D + col), rw = *(const GAS u32x2g*)(R + m * 3072 + col);
                const f32x4 gn = *(const GAS f32x4*)(INP(22) + jm * 1024 + col);
                const float o0 = bf_lo(ow.x), o1 = bf_hi(ow.x), o2 = bf_lo(ow.y), o3 = bf_hi(ow.y);
                const float ss = wave_sum((o0 * o0 + o1 * o1) + (o2 * o2 + o3 * o3)); const float rn = rsqrtf(ss * (1.0f / 256.0f) + 1e-6f);
                const float r0 = bf_lo(rw.x), r1 = bf_hi(rw.x), r2 = bf_lo(rw.y), r3 = bf_hi(rw.y);
                u32x2g w; w.x = pk2(o0 * rn * gn[0] * r0 * sigmoid_f(r0), o1 * rn * gn[1] * r1 * sigmoid_f(r1)); w.y = pk2(o2 * rn * gn[2] * r2 * sigmoid_f(r2), o3 * rn * gn[3] * r3 * sigmoid_f(r3));
                *(GAS u32x2g*)(AO + m * D + col) = w; }
        }
        else if (type == T_UP0) {
            const float* P = INP(1) + (size_t)layer * M * 256;
            for (size_t idx = (size_t)gtid * 8; idx < (size_t)M * 256; idx += (size_t)NT * 8) { const f32x4 a = *(const GAS f32x4*)(P + idx), b2 = *(const GAS f32x4*)(P + idx + 4);
                v4u o; o.x = pk2(a[0], a[1]); o.y = pk2(a[2], a[3]); o.z = pk2(b2[0], b2[1]); o.w = pk2(b2[2], b2[3]); *(GAS v4u*)(PB + idx) = o; }
        }
        else if (type == T_FINAL) {
            const float* ssq = (const float*)(ws + WS_SSQA);
            const GAS f32x4* gf = (const GAS f32x4*)INP(28) + lane; const f32x4 g0 = gf[0], g1 = gf[64], g2 = gf[128], g3 = gf[192];
            for (int m = gw; m < M; m += NGW) { GAS f32x4* hr = (GAS f32x4*)(h + (size_t)m * D) + lane; const GAS u32x2g* br = (const GAS u32x2g*)(PB + (size_t)m * D) + lane;
                const float s = wave_sum(lane < 16 ? ssq[(size_t)m * 16 + lane] : 0.f); const float rs = rsqrtf(s * (1.0f / 1024.0f) + 1e-6f);
                const u32x2g w0 = br[0], w1 = br[64], w2 = br[128], w3 = br[192];
                hr[0] = (f32x4){bf_lo(w0.x), bf_hi(w0.x), bf_lo(w0.y), bf_hi(w0.y)} * rs * g0; hr[64] = (f32x4){bf_lo(w1.x), bf_hi(w1.x), bf_lo(w1.y), bf_hi(w1.y)} * rs * g1;
                hr[128] = (f32x4){bf_lo(w2.x), bf_hi(w2.x), bf_lo(w2.y), bf_hi(w2.y)} * rs * g2; hr[192] = (f32x4){bf_lo(w3.x), bf_hi(w3.x), bf_lo(w3.y), bf_hi(w3.y)} * rs * g3; }
        }

        } }
        for (int job = 0; job < 2; ++job) {
            int kind = -1;
            pg8::Gemm g{nullptr, nullptr, M, D, D};
            pg8::bf16_t* aO = nullptr; int aldc = D; const float* assq = nullptr; int asplit = 0; size_t astride = 0; float ascale = 1.f; float* aft = nullptr; int afc = 1 << 30;
            const pg8::bf16_t* rbase = HB; pg8::bf16_t* rhb = HB; const float* rssi = nullptr; float* rsso = nullptr;
            if (job == 0) {
                if (type == T_INPROJ) { kind = 0; g.A = PB; assq = ssq0;
                    if (mixer == 0) { g.Bt = Wb + W_S5IN + jm * W_S5STRIDE; g.N = 1024; aO = BIG; aldc = 1024; }
                    else if (mixer == 1) { g.Bt = Wb + W_FOXIN; g.N = 3328; aO = BIG; aldc = 1024; asplit = 1024; astride = 32 * ME; ascale = attn_body::C2; aft = FLOG; afc = 3072; }
                    else { g.Bt = Wb + W_GLAIN; g.N = 3328; aO = BIG; aldc = 3072; aft = FLOG; afc = 3072; } }
                else if (type == T_MIX2 && mixer == 0) { kind = 2; g.A = BIG + 32 * ME; g.Bt = Wb + W_S5GLU + jm * W_S5STRIDE; g.N = 2048; aO = BIG + 64 * ME; aldc = 1024; }
                else if (type == T_OUTPROJ) { kind = 3; g.A = (mixer == 0) ? BIG + 64 * ME : (mixer == 1) ? BIG : PP; g.Bt = Wb + ((mixer == 0) ? W_S5OUT + jm * W_S5STRIDE : (mixer == 1) ? W_FOXOUT : W_GLAOUT);
                    rbase = PB; rsso = ssq1; }
                else if (type == T_UP0 || type == T_UP1) { const int hf = (type == T_UP1); kind = 1; g.A = HB + (size_t)hf * 16 * ME; g.Bt = Wb + W_MLP1 + layer * W_MLPSTRIDE; g.M = M / 2; g.N = FF;
                    aO = BIG; aldc = FF; assq = ssq1 + (size_t)hf * (M / 2) * 16; }
                else if (type == T_DOWN0 || type == T_DOWN1) { const int hf = (type == T_DOWN1); kind = 3; g.A = BIG; g.Bt = Wb + W_MLP2 + layer * W_MLPSTRIDE; g.M = M / 2; g.K = FF;
                    rbase = HB + (size_t)hf * 16 * ME; rhb = HB + (size_t)hf * 16 * ME; rsso = ssq2 + (size_t)hf * (M / 2) * 16; }
                else if (type == T_PLE) { kind = 4; g.A = HB; g.Bt = Wb + W_PLEG + layer * W_PLESTRIDE; rssi = ssq2; rsso = ssq3; rhb = PB; }
            } else {
                if (type == T_DOWN0) { kind = 0; g.A = PB; g.Bt = Wb + W_PLEP + layer * W_PLESTRIDE; g.K = 256; aO = PP; aldc = 1024; }
            }
            if (kind < 0) continue;
            pg8::StaticOrder S; S.init(g.M, g.N, G, (int)blockIdx.x);
            for (int grep_ = 0; grep_ < ((kind <= 2) ? MK_DUP_G : 1); ++grep_)
            if (kind == 0) { pg8::EpiAct<0> E{aO, aldc, assq, asplit, astride, ascale, aft, afc}; pg8::gemm_phase<pg8::EpiAct<0>, pg8::StaticOrder, true, true>(ldsl + RING_OFF, g, S, E); }
            else if (kind == 1) { pg8::EpiAct<1> E{aO, aldc, assq, 0, 0, 1.f, nullptr, 1 << 30}; pg8::gemm_phase<pg8::EpiAct<1>, pg8::StaticOrder, true, true>(ldsl + RING_OFF, g, S, E); }
            else if (kind == 2) { pg8::EpiAct<2> E{aO, aldc, nullptr, 0, 0, 1.f, nullptr, 1 << 30}; pg8::gemm_phase<pg8::EpiAct<2>, pg8::StaticOrder, true, true>(ldsl + RING_OFF, g, S, E); }
            else if (kind == 3) { pg8::EpiRes<0> E{rbase, rhb, nullptr, rsso, nullptr, D}; pg8::gemm_phase<pg8::EpiRes<0>, pg8::StaticOrder, true, true>(ldsl + RING_OFF, g, S, E); }
            else { pg8::EpiRes<1> E{rbase, rhb, rssi, rsso, PP, D}; pg8::gemm_phase<pg8::EpiRes<1>, pg8::StaticOrder, true, true>(ldsl + RING_OFF, g, S, E); }
        }

        if (ph + 1 < args.ph_hi) {
#if !MK_PER_PHASE
#if MK_USE_CG
            grid.sync();
#else
            if (args.ph_hi > 100000) grid.sync();
            xcd_barrier(bar);
#endif
#endif
        }
    }
}

#undef ws
#undef h
#undef Wb
#undef HB
#undef PB
#undef PP
#undef BIG
#undef FLOG
#undef NEGF
#undef ssq0
#undef ssq1
#undef ssq2
#undef ssq3
extern "C" void kernel_launch(void* const* d_in, const int* in_sizes, int n_in, void* d_out, int out_size, void* d_ws, size_t ws_size, hipStream_t stream) {
    static int grid = 0;
    if (grid == 0) {
        if (n_in != 29 || in_sizes[0] != M * D || out_size != M * D || ws_size < WS_END) { fprintf(stderr, "kernel_launch: unexpected shapes: n_in %d in0 %d out %d ws %zu (need %zu)\n", n_in, n_in > 0 ? in_sizes[0] : -1, out_size, ws_size, (size_t)WS_END); grid = -1; return; }
        int dev = 0, cus = 0, per_cu = 0;
        if (hipGetDevice(&dev) != hipSuccess || hipDeviceGetAttribute(&cus, hipDeviceAttributeMultiprocessorCount, dev) != hipSuccess) { grid = -1; return; }
        if (hipFuncSetAttribute((const void*)trunk_fwd, hipFuncAttributeMaxDynamicSharedMemorySize, LDS_BYTES) != hipSuccess) { fprintf(stderr, "kernel_launch: hipFuncSetAttribute failed\n"); grid = -1; return; }
        if (hipOccupancyMaxActiveBlocksPerMultiprocessor(&per_cu, (const void*)trunk_fwd, NWAVES * 64, LDS_BYTES) != hipSuccess || per_cu < 1) { fprintf(stderr, "kernel_launch: occupancy query says %d\n", per_cu); per_cu = 1; }
        (void)hipGetLastError();
        grid = cus;
    }
    if (grid < 0) return;
    (void)hipMemsetAsync((char*)d_ws + WS_CTL, 0, CTL_ZERO_BYTES, stream);
    Args a{};
    for (int i = 0; i < 29; ++i) a.in[i] = (const float*)d_in[i];
    a.out = (float*)d_out; a.ws = (unsigned char*)d_ws;
#if MK_PER_PHASE
    for (int ph = 0; ph < N_PHASES; ++ph) { a.ph_lo = ph; a.ph_hi = ph + 1; hipLaunchKernelGGL(trunk_fwd, dim3(grid), dim3(NWAVES * 64), LDS_BYTES, stream, a); }
#else
    a.ph_lo = 0; a.ph_hi = N_PHASES;
    void* kargs[] = {&a};
    hipError_t e = hipLaunchCooperativeKernel((const void*)trunk_fwd, dim3(grid), dim3(NWAVES * 64), kargs, LDS_BYTES, stream);
    if (e != hipSuccess) fprintf(stderr, "kernel_launch: cooperative launch failed: %s (grid %d)\n", hipGetErrorString(e), grid);
#endif
}
```
